# Optimizing an MI355X kernel written in HIP

```python
import math
import jax, jax.numpy as jnp
from jax import lax
import numpy as np

D_MODEL = 1024
BATCH = 8
SEQ = 2048
DEPTH = 1

EPS = 1e-6
PLE_DIM = 256
S5_GROUP_CH = 16
S5_GROUPS = D_MODEL // 32
S5_WIDTH = S5_GROUPS * S5_GROUP_CH
S5_STATE = 64
LRU_HEAD_DIM = 64
LRU_WIDTH = D_MODEL
LRU_HEADS = LRU_WIDTH // LRU_HEAD_DIM
LRU_C = 8.0
CONV_WIDTH = 4
FFN_HIDDEN = -(-8 * D_MODEL // (3 * 256)) * 256
IN_COLS = S5_WIDTH + LRU_WIDTH + 2 * D_MODEL

kernel_name = "hybrid_s5_rglru_gated_block"


def rms_norm(x, g):
    xf = x.astype(jnp.float32)
    y = xf * lax.rsqrt(jnp.mean(xf * xf, axis=-1, keepdims=True) + EPS)
    return (y * g.astype(jnp.float32)).astype(x.dtype)


def s5_mixer(u, lam_re, lam_im, log_dt, b_re, b_im, c_re, c_im, d_skip, w_glu, b_glu):
    f32 = jnp.float32
    bsz, L, _ = u.shape
    uf = u.astype(f32).reshape(bsz, L, S5_GROUPS, S5_GROUP_CH)
    lr = lam_re.astype(f32)
    li = lam_im.astype(f32)
    dt = jnp.exp(log_dt.astype(f32))[:, None]
    mag = jnp.exp(lr * dt)
    ar = mag * jnp.cos(li * dt)
    ai = mag * jnp.sin(li * dt)
    den = lr * lr + li * li
    nr = ar - 1.0
    fr = (nr * lr + ai * li) / den
    fi = (ai * lr - nr * li) / den
    br = b_re.astype(f32)
    bi = b_im.astype(f32)
    bbr = fr[..., None] * br - fi[..., None] * bi
    bbi = fr[..., None] * bi + fi[..., None] * br
    xr = jnp.einsum('blgp,gnp->blgn', uf, bbr)
    xi = jnp.einsum('blgp,gnp->blgn', uf, bbi)
    a_r = jnp.broadcast_to(ar, (1, L) + ar.shape)
    a_i = jnp.broadcast_to(ai, (1, L) + ai.shape)

    def combine(e1, e2):
        a1r, a1i, b1r, b1i = e1
        a2r, a2i, b2r, b2i = e2
        return (a2r * a1r - a2i * a1i,
                a2r * a1i + a2i * a1r,
                a2r * b1r - a2i * b1i + b2r,
                a2r * b1i + a2i * b1r + b2i)

    _, _, sr, si = lax.associative_scan(combine, (a_r, a_i, xr, xi), axis=1)
    y = (jnp.einsum('blgn,gpn->blgp', sr, c_re.astype(f32))
         - jnp.einsum('blgn,gpn->blgp', si, c_im.astype(f32))
         + d_skip.astype(f32) * uf)
    y = y.reshape(bsz, L, S5_WIDTH)
    z = jax.nn.gelu(y)
    out = z * jax.nn.sigmoid(z @ w_glu.astype(f32) + b_glu.astype(f32))
    return out.astype(u.dtype)


def rglru_mixer(u, conv_w, conv_b, w_r, b_r, w_i, b_i, lru_lambda):
    f32 = jnp.float32
    xc = lax.conv_general_dilated(
        u, conv_w[:, None, :].astype(u.dtype), window_strides=(1,),
        padding=[(CONV_WIDTH - 1, 0)], dimension_numbers=('NWC', 'WIO', 'NWC'),
        feature_group_count=LRU_WIDTH) + conv_b
    bsz, L, _ = xc.shape
    xh = xc.astype(f32).reshape(bsz, L, LRU_HEADS, LRU_HEAD_DIM)
    r = jax.nn.sigmoid(jnp.einsum('blhi,hij->blhj', xh, w_r.astype(f32)) + b_r.astype(f32))
    ig = jax.nn.sigmoid(jnp.einsum('blhi,hij->blhj', xh, w_i.astype(f32)) + b_i.astype(f32))
    log_a = -LRU_C * r * jax.nn.softplus(-lru_lambda.astype(f32).reshape(LRU_HEADS, LRU_HEAD_DIM))
    a = jnp.exp(log_a)
    mult = jnp.sqrt(-jnp.expm1(2.0 * log_a))
    bx = mult * ig * xh

    def combine(e1, e2):
        a1, b1 = e1
        a2, b2 = e2
        return a2 * a1, a2 * b1 + b2

    _, h = lax.associative_scan(combine, (a, bx), axis=1)
    return h.reshape(bsz, L, LRU_WIDTH).astype(u.dtype)


def setup_inputs(seed: int = 0) -> dict:
    key = jax.random.key(seed)
    ks = jax.random.split(key, 40)
    f32 = jnp.float32

    def nrm(k, shape, scale):
        return jax.random.normal(k, shape, f32) * scale

    def gain(k, shape):
        return 1.0 + 0.01 * jax.random.normal(k, shape, f32)

    G, N, P = S5_GROUPS, S5_STATE, S5_GROUP_CH
    lam_re = -0.5 + 0.01 * jax.random.normal(ks[3], (DEPTH, G, N), f32)
    lam_im = jnp.pi * jnp.arange(N, dtype=f32)[None, None, :] + 0.01 * jax.random.normal(ks[4], (DEPTH, G, N), f32)
    log_dt = jax.random.uniform(ks[5], (DEPTH, G), f32, math.log(1e-3), math.log(1e-1))
    u_a = jax.random.uniform(ks[16], (DEPTH, LRU_WIDTH), f32, 0.9, 0.999)
    a_base = u_a ** (1.0 / LRU_C)
    lru_lambda = jnp.log(a_base) - jnp.log1p(-a_base)

    return {
        "x": nrm(ks[0], (BATCH, SEQ, D_MODEL), 1.0),
        "p": nrm(ks[1], (DEPTH, BATCH, SEQ, PLE_DIM), 1.0),
        "g_mix": gain(ks[2], (DEPTH, D_MODEL)),
        "w_in": nrm(ks[6], (DEPTH, D_MODEL, IN_COLS), D_MODEL ** -0.5),
        "b_in": nrm(ks[7], (DEPTH, IN_COLS), 0.01),
        "lam_re": lam_re,
        "lam_im": lam_im,
        "log_dt": log_dt,
        "s5_b_re": nrm(ks[8], (DEPTH, G, N, P), (2 * P) ** -0.5),
        "s5_b_im": nrm(ks[9], (DEPTH, G, N, P), (2 * P) ** -0.5),
        "s5_c_re": nrm(ks[10], (DEPTH, G, P, N), N ** -0.5),
        "s5_c_im": nrm(ks[11], (DEPTH, G, P, N), N ** -0.5),
        "s5_d": nrm(ks[12], (DEPTH, G, P), 1.0),
        "w_glu": nrm(ks[13], (DEPTH, S5_WIDTH, S5_WIDTH), S5_WIDTH ** -0.5),
        "b_glu": nrm(ks[14], (DEPTH, S5_WIDTH), 0.01),
        "conv_w": nrm(ks[15], (DEPTH, CONV_WIDTH, LRU_WIDTH), CONV_WIDTH ** -0.5),
        "conv_b": nrm(ks[17], (DEPTH, LRU_WIDTH), 0.01),
        "w_r": nrm(ks[18], (DEPTH, LRU_HEADS, LRU_HEAD_DIM, LRU_HEAD_DIM), LRU_HEAD_DIM ** -0.5),
        "b_r": nrm(ks[19], (DEPTH, LRU_HEADS, LRU_HEAD_DIM), 0.01),
        "w_i": nrm(ks[20], (DEPTH, LRU_HEADS, LRU_HEAD_DIM, LRU_HEAD_DIM), LRU_HEAD_DIM ** -0.5),
        "b_i": nrm(ks[21], (DEPTH, LRU_HEADS, LRU_HEAD_DIM), 0.01),
        "lru_lambda": lru_lambda,
        "w_a_out": nrm(ks[22], (DEPTH, S5_WIDTH, D_MODEL), S5_WIDTH ** -0.5),
        "w_b_out": nrm(ks[23], (DEPTH, LRU_WIDTH, D_MODEL), LRU_WIDTH ** -0.5),
        "w_o": nrm(ks[24], (DEPTH, D_MODEL, D_MODEL), D_MODEL ** -0.5),
        "g_ffn": gain(ks[25], (DEPTH, D_MODEL)),
        "w_ffn_gate": nrm(ks[26], (DEPTH, D_MODEL, FFN_HIDDEN), D_MODEL ** -0.5),
        "w_ffn_up": nrm(ks[27], (DEPTH, D_MODEL, FFN_HIDDEN), D_MODEL ** -0.5),
        "w_ffn_down": nrm(ks[28], (DEPTH, FFN_HIDDEN, D_MODEL), FFN_HIDDEN ** -0.5),
        "g_ple_gate": gain(ks[29], (DEPTH, D_MODEL)),
        "w_ple_gate": nrm(ks[30], (DEPTH, D_MODEL, D_MODEL), D_MODEL ** -0.5),
        "b_ple_gate": nrm(ks[31], (DEPTH, D_MODEL), 0.01),
        "w_ple": nrm(ks[32], (DEPTH, PLE_DIM, D_MODEL), PLE_DIM ** -0.5),
        "g_ple": gain(ks[33], (DEPTH, D_MODEL)),
        "g_final": gain(ks[34], (D_MODEL,)),
    }


def reference(x, p, g_mix, w_in, b_in, lam_re, lam_im, log_dt, s5_b_re, s5_b_im,
              s5_c_re, s5_c_im, s5_d, w_glu, b_glu, conv_w, conv_b, w_r, b_r, w_i, b_i,
              lru_lambda, w_a_out, w_b_out, w_o, g_ffn, w_ffn_gate, w_ffn_up, w_ffn_down,
              g_ple_gate, w_ple_gate, b_ple_gate, w_ple, g_ple, g_final):
    s_a = S5_WIDTH
    s_b = S5_WIDTH + LRU_WIDTH
    s_g = s_b + D_MODEL
    for i in range(DEPTH):
        h = rms_norm(x, g_mix[i])
        z = h @ w_in[i] + b_in[i]
        u_a = z[..., :s_a]
        u_b = z[..., s_a:s_b]
        gate_a = jax.nn.sigmoid(z[..., s_b:s_g])
        gate_b = jax.nn.sigmoid(z[..., s_g:])
        y_a = s5_mixer(u_a, lam_re[i], lam_im[i], log_dt[i], s5_b_re[i], s5_b_im[i],
                       s5_c_re[i], s5_c_im[i], s5_d[i], w_glu[i], b_glu[i])
        y_b = rglru_mixer(u_b, conv_w[i], conv_b[i], w_r[i], b_r[i], w_i[i], b_i[i],
                          lru_lambda[i])
        merged = gate_a * (y_a @ w_a_out[i]) + gate_b * (y_b @ w_b_out[i])
        x = x + merged @ w_o[i]
        h2 = rms_norm(x, g_ffn[i])
        x = x + (jax.nn.silu(h2 @ w_ffn_gate[i]) * (h2 @ w_ffn_up[i])) @ w_ffn_down[i]
        gate_p = jax.nn.sigmoid(rms_norm(x, g_ple_gate[i]) @ w_ple_gate[i] + b_ple_gate[i])
        e = rms_norm(p[i] @ w_ple[i], g_ple[i])
        x = x + gate_p * e
    return rms_norm(x, g_final)
```

```cpp
#include <hip/hip_runtime.h>
#include <hip/hip_cooperative_groups.h>
#include <cstdio>
#include <cstdint>
namespace cg = cooperative_groups;

#ifndef MK_N_LAUNCHES
#define MK_N_LAUNCHES 12
#endif

#define LAS __attribute__((address_space(3)))
typedef unsigned short bf16_t;
typedef short bf16x8 __attribute__((ext_vector_type(8)));
typedef float f32x4 __attribute__((ext_vector_type(4)));
typedef unsigned u32x4 __attribute__((ext_vector_type(4)));
typedef unsigned u32x2 __attribute__((ext_vector_type(2)));

constexpr int M = 16384, DM = 1024, SEQ = 2048, INC = 3584, FFN = 2816, PLE = 256;
constexpr float EPS = 1e-6f;
constexpr int NPH = 12;

constexpr size_t MiB = 1u << 20;
constexpr size_t WS_CTL = 0;
constexpr size_t OFF_BAR = 524288;
constexpr size_t OFF_SSQ0 = 0, OFF_SSQ1 = 65536, OFF_SSQ2 = 131072, OFF_SSQ3 = 196608, OFF_SSQE = 262144, OFF_SP = 327680;
constexpr size_t WS_WIN = 1 * MiB, WS_WGLU = 8 * MiB, WS_WPLE = 8 * MiB + 512 * 1024, WS_WA = 9 * MiB, WS_WB = 10 * MiB, WS_WO = 12 * MiB, WS_WGU = 14 * MiB,
                 WS_WD = 25 * MiB, WS_WPG = 31 * MiB, WS_PM = 33 * MiB, WS_TQ = 37 * MiB, WS_WLRU = 43 * MiB;
constexpr size_t WS_PB = 44 * MiB;
constexpr size_t WS_GA = 52 * MiB, WS_GB = 84 * MiB;
constexpr size_t WS_XB = 116 * MiB;
constexpr size_t WS_UB = 148 * MiB;
constexpr size_t WS_UAS = 180 * MiB;
constexpr size_t WS_E = 228 * MiB;
constexpr size_t WS_ACT = 148 * MiB;
constexpr size_t WS_END = 256 * MiB;

__device__ __forceinline__ unsigned cvt_pk_bf16(float lo, float hi) { unsigned r; asm volatile("v_cvt_pk_bf16_f32 %0, %1, %2" : "=v"(r) : "v"(lo), "v"(hi)); return r; }
__device__ __forceinline__ u32x4 pack8(const f32x4 a, const f32x4 b) { u32x4 w; w.x = cvt_pk_bf16(a[0], a[1]); w.y = cvt_pk_bf16(a[2], a[3]); w.z = cvt_pk_bf16(b[0], b[1]); w.w = cvt_pk_bf16(b[2], b[3]); return w; }
__device__ __forceinline__ void unpack8(const u32x4 w, f32x4& a, f32x4& b) {
    a[0] = __uint_as_float(w.x << 16); a[1] = __uint_as_float(w.x & 0xffff0000u); a[2] = __uint_as_float(w.y << 16); a[3] = __uint_as_float(w.y & 0xffff0000u);
    b[0] = __uint_as_float(w.z << 16); b[1] = __uint_as_float(w.z & 0xffff0000u); b[2] = __uint_as_float(w.w << 16); b[3] = __uint_as_float(w.w & 0xffff0000u);
}
__device__ __forceinline__ float bf2f(bf16_t h) { return __uint_as_float((unsigned)h << 16); }
__device__ __forceinline__ float sigm(float x) { return __builtin_amdgcn_rcpf(1.0f + __expf(-x)); }
__device__ __forceinline__ f32x4 sigm4(f32x4 v) { f32x4 o; o[0] = sigm(v[0]); o[1] = sigm(v[1]); o[2] = sigm(v[2]); o[3] = sigm(v[3]); return o; }
__device__ __forceinline__ float gelu_tanh(float y) { const float t = 1.5957691216057308f * (y + 0.044715f * y * y * y); return y * sigm(t); }
__device__ __forceinline__ float sq4(f32x4 v) { return (v[0] * v[0] + v[1] * v[1]) + (v[2] * v[2] + v[3] * v[3]); }
__device__ __forceinline__ float rstd_of(float ssq) { return rsqrtf(ssq * (1.0f / 1024.0f) + EPS); }
__device__ __forceinline__ float wave_sum(float v) {
#pragma unroll
    for (int o = 1; o < 64; o <<= 1) v += __shfl_xor(v, o);
    return v;
}

__device__ __forceinline__ void grid_bar(unsigned* ctr, unsigned target, bool leader) {
    asm volatile("s_waitcnt vmcnt(0)" ::: "memory");
    __syncthreads();
    if (leader) {
        __builtin_amdgcn_fence(__ATOMIC_RELEASE, "agent");
        asm volatile("s_waitcnt vmcnt(0)" ::: "memory");
        __hip_atomic_fetch_add(ctr, 1u, __ATOMIC_RELAXED, __HIP_MEMORY_SCOPE_AGENT);
        unsigned spins = 0;
        while (__hip_atomic_load(ctr, __ATOMIC_RELAXED, __HIP_MEMORY_SCOPE_AGENT) < target) { __builtin_amdgcn_s_sleep(2); if (++spins > (1u << 24)) break; }
        __builtin_amdgcn_fence(__ATOMIC_ACQUIRE, "agent");
        asm volatile("s_waitcnt vmcnt(0)" ::: "memory");
    }
    __syncthreads();
}

namespace pg8 {
constexpr int BM = 256, BK = 64, HALF = 128, HTB = HALF * BK * 2, STAGE_BYTES = 8 * HTB, NXCD = 8, WGM = 8;
__host__ __device__ __forceinline__ int lds_byte(int r, int c) { const int st = (r >> 4) * 2 + (c >> 5), rr = r & 15, cc = c & 31, ob = rr * 64 + cc * 2; return st * 1024 + (ob ^ (((ob >> 9) & 1) << 5)); }
__host__ __device__ __forceinline__ void stage_rc(int b, int& R, int& C) { const int st = b / 1024, sb = b % 1024, swz = sb ^ (((sb >> 9) & 1) << 5); R = (st >> 1) * 16 + swz / 64; C = (st & 1) * 32 + (swz % 64) / 2; }
__host__ __device__ __forceinline__ int perm32(int rho) { const int n = rho >> 4, i = rho & 15; return 8 * (i >> 2) + 4 * n + (i & 3); }

struct Unit { int pm, pn; size_t aoff, boff; };
struct Gemm { const bf16_t* A; const bf16_t* Bt; int lda, ldb, K; };

struct Sched {
    int nM, nN, nwg, G, c;
    size_t a_pm, a_pn, b_pn, b_grp; int a_pn_shift;
    __device__ __forceinline__ void init(int nM_, int nN_, int G_, int c_, size_t a_pm_, size_t a_pn_, size_t b_pn_, size_t b_grp_) {
        nM = nM_; nN = nN_; nwg = nM * nN; G = G_; c = c_; a_pm = a_pm_; a_pn = a_pn_; b_pn = b_pn_; b_grp = b_grp_; a_pn_shift = 0; }
    __device__ __forceinline__ bool next(int i, Unit& u) const {
        const long L = (long)i * G + c; if (L >= nwg) return false;
        int wgid = (int)L; { const int q = nwg / NXCD, r = nwg % NXCD, xcd = wgid % NXCD, off = wgid / NXCD; wgid = (xcd < r ? xcd * (q + 1) : r * (q + 1) + (xcd - r) * q) + off; }
        const int nig = WGM * nN, gid = wgid / nig, fm = gid * WGM, gsz = (nM - fm) < WGM ? (nM - fm) : WGM;
        u.pm = fm + ((wgid % nig) % gsz); u.pn = (wgid % nig) / gsz;
        u.aoff = (size_t)u.pm * a_pm + (size_t)(u.pn >> a_pn_shift) * a_pn; u.boff = (size_t)u.pn * b_pn + (size_t)(u.pm >> 2) * b_grp;
        return true;
    }
};

template <class Epi>
__device__ __forceinline__ void gemm_phase(LAS unsigned char* lds, const Gemm g, const Sched& S, const Epi& E, int tid_) {
    asm volatile("" : "+v"(tid_));
    const int tid = tid_, wid = __builtin_amdgcn_readfirstlane(tid >> 6), lane = tid & 63, wr = wid >> 2, wc = wid & 3, fr = lane & 15, fq = lane >> 4;
    const int nt = g.K / BK;
    unsigned voffA[2], voffB[2];
#pragma unroll
    for (int i = 0; i < 2; ++i) { int R, C; stage_rc(tid * 16 + i * 8192, R, C); const int Rb = (R & ~31) + perm32(R & 31);
        voffA[i] = (unsigned)(R * g.lda + C) * 2u; voffB[i] = (unsigned)(Rb * g.ldb + C) * 2u; }
    const size_t kstep = (size_t)(BK * 2);
    const size_t hstepA = (size_t)HALF * g.lda * 2, hstepB = (size_t)HALF * g.ldb * 2;
    const unsigned ldsw = (unsigned)wid * 1024u;
    const int aoff = lds_byte(wr * 64 + fr, fq * 8), boff = lds_byte(wc * 32 + fr, fq * 8);
#define PG8_SA(b, h) (((b) * 2 + (h)) * HTB)
#define PG8_SB(b, h) ((4 + (b) * 2 + (h)) * HTB)
#define PG8_STAGE(bufoff, gbase, voff) do { _Pragma("unroll") for (int _i = 0; _i < 2; ++_i) \
        __builtin_amdgcn_global_load_lds((const unsigned*)((const char*)(gbase) + (voff)[_i]), (LAS unsigned*)(lds + (bufoff) + ldsw + _i * 8192), 16, 0, 0); } while (0)
#define PG8_LDA(dst, b, h) do { _Pragma("unroll") for (int m = 0; m < 4; ++m) _Pragma("unroll") for (int k = 0; k < 2; ++k) dst[m][k] = *(const LAS bf16x8*)(lds + PG8_SA(b, h) + aoff + m * 2048 + k * 1024); } while (0)
#define PG8_LDB(dst, b, h) do { _Pragma("unroll") for (int n = 0; n < 2; ++n) _Pragma("unroll") for (int k = 0; k < 2; ++k) dst[n][k] = *(const LAS bf16x8*)(lds + PG8_SB(b, h) + boff + n * 2048 + k * 1024); } while (0)
#define PG8_MMA(ai, bj, At, Bt) do { __builtin_amdgcn_s_setprio(1); _Pragma("unroll") for (int m = 0; m < 4; ++m) _Pragma("unroll") for (int n = 0; n < 2; ++n) _Pragma("unroll") for (int k = 0; k < 2; ++k) \
        acc[ai][bj][m][n] = __builtin_amdgcn_mfma_f32_16x16x32_bf16(Bt[n][k], At[m][k], acc[ai][bj][m][n], 0, 0, 0); __builtin_amdgcn_s_setprio(0); } while (0)
#define PG8_WAIT_V(n) asm volatile("s_waitcnt vmcnt(" #n ")" ::: "memory")
#define PG8_WAIT_L(n) asm volatile("s_waitcnt lgkmcnt(" #n ")" ::: "memory")
#define PG8_BAR __builtin_amdgcn_s_barrier()
#define PG8_SCHED __builtin_amdgcn_sched_barrier(0)
    Unit cur, nxt; int ui = 0;
    if (!S.next(0, cur)) return;
    f32x4 acc[2][2][4][2];
#pragma unroll
    for (int a = 0; a < 2; ++a)
#pragma unroll
        for (int b = 0; b < 2; ++b)
#pragma unroll
            for (int m = 0; m < 4; ++m)
#pragma unroll
                for (int n = 0; n < 2; ++n) acc[a][b][m][n] = (f32x4){0.f, 0.f, 0.f, 0.f};
    bf16x8 At[4][2], B0[2][2], B1[2][2];
    const char* cA = (const char*)g.A + cur.aoff; const char* cB = (const char*)g.Bt + cur.boff;
    PG8_STAGE(PG8_SB(0, 0), cB, voffB); PG8_STAGE(PG8_SB(0, 1), cB + hstepB, voffB); PG8_STAGE(PG8_SA(0, 0), cA, voffA); PG8_STAGE(PG8_SA(0, 1), cA + hstepA, voffA);
    if (wr == 1) PG8_BAR;
    PG8_WAIT_V(2); PG8_BAR;
    PG8_STAGE(PG8_SB(1, 0), cB + kstep, voffB); PG8_STAGE(PG8_SA(1, 0), cA + kstep, voffA); PG8_STAGE(PG8_SB(1, 1), cB + hstepB + kstep, voffB);
    PG8_WAIT_V(6); PG8_BAR;
    for (;;) {
        const bool has_next = S.next(ui + 1, nxt);
        const char* nA = has_next ? (const char*)g.A + nxt.aoff : cA; const char* nB = has_next ? (const char*)g.Bt + nxt.boff : cB;
        for (int t = 0; t < nt; t += 2) {
            const bool last = (t == nt - 2);
            const char* a1 = cA + (size_t)(t + 1) * kstep;
            const char* a2 = last ? nA : cA + (size_t)(t + 2) * kstep; const char* b2 = last ? nB : cB + (size_t)(t + 2) * kstep;
            const char* a3 = a2 + kstep; const char* b3 = b2 + kstep;
            PG8_LDB(B0, 0, 0); PG8_LDB(B1, 0, 1); PG8_SCHED; PG8_LDA(At, 0, 0); PG8_STAGE(PG8_SA(1, 1), a1 + hstepA, voffA);
            PG8_WAIT_V(8); PG8_WAIT_L(0); PG8_BAR; PG8_MMA(0, 0, At, B0); PG8_MMA(0, 1, At, B1); PG8_BAR; PG8_SCHED;
            PG8_LDA(At, 0, 1); PG8_STAGE(PG8_SB(0, 0), b2, voffB); PG8_STAGE(PG8_SB(0, 1), b2 + hstepB, voffB); PG8_STAGE(PG8_SA(0, 0), a2, voffA);
            PG8_WAIT_V(8); PG8_WAIT_L(0); PG8_BAR; PG8_MMA(1, 0, At, B0); PG8_MMA(1, 1, At, B1); PG8_BAR; PG8_SCHED;
            PG8_LDB(B0, 1, 0); PG8_LDB(B1, 1, 1); PG8_SCHED; PG8_LDA(At, 1, 0); PG8_STAGE(PG8_SA(0, 1), a2 + hstepA, voffA);
            PG8_WAIT_V(8); PG8_WAIT_L(0); PG8_BAR; PG8_MMA(0, 0, At, B0); PG8_MMA(0, 1, At, B1); PG8_BAR; PG8_SCHED;
            PG8_LDA(At, 1, 1); PG8_STAGE(PG8_SB(1, 0), b3, voffB); PG8_STAGE(PG8_SB(1, 1), b3 + hstepB, voffB); PG8_STAGE(PG8_SA(1, 0), a3, voffA);
            PG8_WAIT_V(8); PG8_WAIT_L(0); PG8_BAR; PG8_MMA(1, 0, At, B0); PG8_MMA(1, 1, At, B1); PG8_BAR; PG8_SCHED;
        }
        if (wr == 0) PG8_BAR;
        { int fr_e = fr, fq_e = fq; asm volatile("" : "+v"(fr_e), "+v"(fq_e)); E(acc, cur, wr, wc, fr_e, fq_e); }
        if (!has_next) break;
#pragma unroll
        for (int a = 0; a < 2; ++a)
#pragma unroll
            for (int b = 0; b < 2; ++b)
#pragma unroll
                for (int m = 0; m < 4; ++m)
#pragma unroll
                    for (int n = 0; n < 2; ++n) acc[a][b][m][n] = (f32x4){0.f, 0.f, 0.f, 0.f};
        cur = nxt; cA = nA; cB = nB; ++ui;
        if (wr == 1) PG8_BAR;
    }
    PG8_WAIT_V(0);
    PG8_BAR;
#undef PG8_SA
#undef PG8_SB
#undef PG8_STAGE
#undef PG8_LDA
#undef PG8_LDB
#undef PG8_MMA
#undef PG8_WAIT_V
#undef PG8_WAIT_L
#undef PG8_BAR
#undef PG8_SCHED
}
}

typedef f32x4 AccT[2][2][4][2];
#define EPI_ROWS(ai, m) _Pragma("unroll") for (int ai = 0; ai < 2; ++ai) _Pragma("unroll") for (int m = 0; m < 4; ++m)
#define EPI_ROW(u, ai, m) ((u).pm * 256 + (ai) * 128 + wr * 64 + (m) * 16 + fr)
#define EPI_LCOL(bj) ((bj) * 128 + wc * 32 + 8 * fq)
__device__ __forceinline__ void row_atomic(float* dst, float s, int fq) { s += __shfl_xor(s, 16); s += __shfl_xor(s, 32); if (fq == 0) atomicAdd(dst, s); }

struct EpiIn {
    const float* ssq0; const float* b_in; bf16_t* UAS; bf16_t* UB; bf16_t* GA; bf16_t* GB;
    __device__ __forceinline__ void operator()(const AccT& acc, const pg8::Unit& u, int wr, int wc, int fr, int fq) const {
        EPI_ROWS(ai, m) { const int row = EPI_ROW(u, ai, m); const float rs = rstd_of(ssq0[row]);
#pragma unroll
            for (int bj = 0; bj < 2; ++bj) { const int col = u.pn * 256 + EPI_LCOL(bj);
                const f32x4 b0 = *(const f32x4*)(b_in + col), b1 = *(const f32x4*)(b_in + col + 4);
                f32x4 v0 = acc[ai][bj][m][0] * rs + b0, v1 = acc[ai][bj][m][1] * rs + b1;
                bf16_t* dst;
                if (u.pn < 2) { const int g = col >> 4, q = col & 15, b = row >> 11, l = row & 2047, c = l >> 4, t = l & 15;
                    dst = UAS + ((size_t)(g * 1024 + b * 128 + c) * 384 + t * 16 + q); }
                else if (u.pn < 6) dst = UB + (size_t)row * 1024 + (col - 512);
                else { v0 = sigm4(v0); v1 = sigm4(v1); dst = (u.pn < 10) ? GA + (size_t)row * 1024 + (col - 1536) : GB + (size_t)row * 1024 + (col - 2560); }
                *(u32x4*)dst = pack8(v0, v1); } }
    }
};
struct EpiEraw {
    bf16_t* ERAW; float* ssqe;
    __device__ __forceinline__ void operator()(const AccT& acc, const pg8::Unit& u, int wr, int wc, int fr, int fq) const {
        EPI_ROWS(ai, m) { const int row = EPI_ROW(u, ai, m); float s = 0.f;
#pragma unroll
            for (int bj = 0; bj < 2; ++bj) { const int col = u.pn * 256 + EPI_LCOL(bj); const f32x4 v0 = acc[ai][bj][m][0], v1 = acc[ai][bj][m][1];
                s += sq4(v0) + sq4(v1); *(u32x4*)(ERAW + (size_t)row * 1024 + col) = pack8(v0, v1); }
            row_atomic(ssqe + row, s, fq); }
    }
};
struct EpiS5a {
    float* E;
    __device__ __forceinline__ void operator()(const AccT& acc, const pg8::Unit& u, int wr, int wc, int fr, int fq) const {
        EPI_ROWS(ai, m) { const int row = EPI_ROW(u, ai, m); float* dst = E + (size_t)row * 128 + EPI_LCOL(0);
            *(f32x4*)dst = acc[ai][0][m][0]; *(f32x4*)(dst + 4) = acc[ai][0][m][1]; }
    }
};
struct EpiS5b {
    bf16_t* ZG;
    __device__ __forceinline__ void operator()(const AccT& acc, const pg8::Unit& u, int wr, int wc, int fr, int fq) const {
        const int lc = wc * 32 + 8 * fq;
        const int t0 = lc >> 4, p = lc & 15;
        EPI_ROWS(ai, m) { const int row = EPI_ROW(u, ai, m); const int g = row >> 10, b = (row >> 7) & 7, c = row & 127;
            bf16_t* dst = ZG + (size_t)(b * 2048 + c * 16 + t0) * 512 + g * 16 + p;
#pragma unroll
            for (int bj = 0; bj < 2; ++bj) { u32x2 w[2];
#pragma unroll
                for (int n = 0; n < 2; ++n) { f32x4 v = acc[ai][bj][m][n];
#pragma unroll
                    for (int j = 0; j < 4; ++j) v[j] = gelu_tanh(v[j]);
                    w[n].x = cvt_pk_bf16(v[0], v[1]); w[n].y = cvt_pk_bf16(v[2], v[3]); }
                *(u32x4*)(dst + bj * 8 * 512) = (u32x4){w[0].x, w[0].y, w[1].x, w[1].y};
                asm volatile("" ::: "memory"); } }
    }
};
struct EpiLru {
    const float* b_r; const float* b_i; const float* sp; const bf16_t* XC; float* AA; bf16_t* BX;
    __device__ __forceinline__ void operator()(const AccT& acc, const pg8::Unit& u, int wr, int wc, int fr, int fq) const {
        const int ch = u.pn * 128 + wc * 32 + 8 * fq;
        EPI_ROWS(ai, m) { const int row = EPI_ROW(u, ai, m); const size_t off = (size_t)row * 1024 + ch;
            const u32x4 xw = *(const u32x4*)(XC + off); f32x4 xx[2]; unpack8(xw, xx[0], xx[1]); u32x2 hw[2];
#pragma unroll
            for (int n = 0; n < 2; ++n) {
                const f32x4 r = sigm4(acc[ai][0][m][n] + *(const f32x4*)(b_r + ch + 4 * n)), ig = sigm4(acc[ai][1][m][n] + *(const f32x4*)(b_i + ch + 4 * n)), s4 = *(const f32x4*)(sp + ch + 4 * n);
                f32x4 a, h;
#pragma unroll
                for (int j = 0; j < 4; ++j) { a[j] = __expf(-8.0f * r[j] * s4[j]); h[j] = sqrtf(fmaxf(1.0f - a[j] * a[j], 0.f)) * ig[j] * xx[n][j]; }
                *(f32x4*)(AA + off + 4 * n) = a; hw[n].x = cvt_pk_bf16(h[0], h[1]); hw[n].y = cvt_pk_bf16(h[2], h[3]); }
            *(u32x4*)(BX + off) = (u32x4){hw[0].x, hw[0].y, hw[1].x, hw[1].y};
            asm volatile("" ::: "memory"); }
    }
};
struct EpiGlu {
    const bf16_t* ZG; const float* b_glu; bf16_t* YA;
    __device__ __forceinline__ void operator()(const AccT& acc, const pg8::Unit& u, int wr, int wc, int fr, int fq) const {
        EPI_ROWS(ai, m) { const int row = EPI_ROW(u, ai, m);
#pragma unroll
            for (int bj = 0; bj < 2; ++bj) { const int col = u.pn * 256 + EPI_LCOL(bj); const size_t off = (size_t)row * 512 + col;
                f32x4 z0, z1; unpack8(*(const u32x4*)(ZG + off), z0, z1);
                const f32x4 s0 = sigm4(acc[ai][bj][m][0] + *(const f32x4*)(b_glu + col)), s1 = sigm4(acc[ai][bj][m][1] + *(const f32x4*)(b_glu + col + 4));
                *(u32x4*)(YA + off) = pack8(z0 * s0, z1 * s1); } }
    }
};
struct EpiMa {
    const bf16_t* GA; float* TMP;
    __device__ __forceinline__ void operator()(const AccT& acc, const pg8::Unit& u, int wr, int wc, int fr, int fq) const {
        EPI_ROWS(ai, m) { const int row = EPI_ROW(u, ai, m);
#pragma unroll
            for (int bj = 0; bj < 2; ++bj) { const size_t off = (size_t)row * 1024 + u.pn * 256 + EPI_LCOL(bj);
                f32x4 g0, g1; unpack8(*(const u32x4*)(GA + off), g0, g1);
                *(f32x4*)(TMP + off) = g0 * acc[ai][bj][m][0]; *(f32x4*)(TMP + off + 4) = g1 * acc[ai][bj][m][1]; } }
    }
};
struct EpiMb {
    const bf16_t* GB; const float* TMP; bf16_t* MG;
    __device__ __forceinline__ void operator()(const AccT& acc, const pg8::Unit& u, int wr, int wc, int fr, int fq) const {
        EPI_ROWS(ai, m) { const int row = EPI_ROW(u, ai, m);
#pragma unroll
            for (int bj = 0; bj < 2; ++bj) { const size_t off = (size_t)row * 1024 + u.pn * 256 + EPI_LCOL(bj);
                f32x4 g0, g1; unpack8(*(const u32x4*)(GB + off), g0, g1);
                const f32x4 v0 = *(const f32x4*)(TMP + off) + g0 * acc[ai][bj][m][0], v1 = *(const f32x4*)(TMP + off + 4) + g1 * acc[ai][bj][m][1];
                *(u32x4*)(MG + off) = pack8(v0, v1); } }
    }
};
struct EpiRes {
    const float* xi; float* xo; bf16_t* XBo; float* ssq;
    __device__ __forceinline__ void operator()(const AccT& acc, const pg8::Unit& u, int wr, int wc, int fr, int fq) const {
        EPI_ROWS(ai, m) { const int row = EPI_ROW(u, ai, m); float s = 0.f;
#pragma unroll
            for (int bj = 0; bj < 2; ++bj) { const size_t off = (size_t)row * 1024 + u.pn * 256 + EPI_LCOL(bj);
                const f32x4 v0 = *(const f32x4*)(xi + off) + acc[ai][bj][m][0], v1 = *(const f32x4*)(xi + off + 4) + acc[ai][bj][m][1];
                s += sq4(v0) + sq4(v1);
                *(f32x4*)(xo + off) = v0; *(f32x4*)(xo + off + 4) = v1; *(u32x4*)(XBo + off) = pack8(v0, v1); }
            row_atomic(ssq + row, s, fq); }
    }
};
struct EpiFfn {
    const float* ssq1; bf16_t* ACT;
    __device__ __forceinline__ void operator()(const AccT& acc, const pg8::Unit& u, int wr, int wc, int fr, int fq) const {
        const int hc = u.pn * 128 + wc * 32 + 8 * fq;
        EPI_ROWS(ai, m) { const int row = EPI_ROW(u, ai, m); const float rs = rstd_of(ssq1[row]);
            f32x4 g0 = acc[ai][0][m][0] * rs, g1 = acc[ai][0][m][1] * rs; const f32x4 u0 = acc[ai][1][m][0] * rs, u1 = acc[ai][1][m][1] * rs;
            g0 = g0 * sigm4(g0) * u0; g1 = g1 * sigm4(g1) * u1;
            *(u32x4*)(ACT + (size_t)row * FFN + hc) = pack8(g0, g1); }
    }
};
struct EpiPg {
    const float* ssq2; const float* ssqe; const float* b_pg; const float* g_ple; const bf16_t* ERAW; float* xio; float* ssq3;
    __device__ __forceinline__ void operator()(const AccT& acc, const pg8::Unit& u, int wr, int wc, int fr, int fq) const {
        EPI_ROWS(ai, m) { const int row = EPI_ROW(u, ai, m); const float rs = rstd_of(ssq2[row]), re = rstd_of(ssqe[row]); float s = 0.f;
#pragma unroll
            for (int bj = 0; bj < 2; ++bj) { const int col = u.pn * 256 + EPI_LCOL(bj); const size_t off = (size_t)row * 1024 + col;
                f32x4 e0, e1; unpack8(*(const u32x4*)(ERAW + off), e0, e1);
                const f32x4 gt0 = sigm4(acc[ai][bj][m][0] * rs + *(const f32x4*)(b_pg + col)), gt1 = sigm4(acc[ai][bj][m][1] * rs + *(const f32x4*)(b_pg + col + 4));
                const f32x4 v0 = *(const f32x4*)(xio + off) + gt0 * (e0 * re * *(const f32x4*)(g_ple + col)), v1 = *(const f32x4*)(xio + off + 4) + gt1 * (e1 * re * *(const f32x4*)(g_ple + col + 4));
                s += sq4(v0) + sq4(v1);
                *(f32x4*)(xio + off) = v0; *(f32x4*)(xio + off + 4) = v1; }
            row_atomic(ssq3 + row, s, fq); }
    }
};

__device__ __forceinline__ void tr_item(const float* W, int K, int N, const float* gk, bf16_t* WT, int mode, LAS float* scr, int item, int lane) {
    const int nblk = N / 32, kb = item / nblk, nb = item % nblk, k0 = 64 * kb, n0 = 32 * nb;
#pragma unroll 8
    for (int i = 0; i < 32; ++i) { const int kk = 2 * i + (lane >> 5); float v = W[(size_t)(k0 + kk) * N + n0 + (lane & 31)]; if (gk) v *= gk[k0 + kk]; scr[kk * 33 + (lane & 31)] = v; }
    asm volatile("s_waitcnt lgkmcnt(0)" ::: "memory");
    const int c = lane & 7;
#pragma unroll
    for (int j = 0; j < 4; ++j) { const int n = (lane >> 3) + 8 * j; const LAS float* s = scr + (8 * c) * 33 + n;
        u32x4 o; o.x = cvt_pk_bf16(s[0 * 33], s[1 * 33]); o.y = cvt_pk_bf16(s[2 * 33], s[3 * 33]); o.z = cvt_pk_bf16(s[4 * 33], s[5 * 33]); o.w = cvt_pk_bf16(s[6 * 33], s[7 * 33]);
        const int nn = n0 + n; const int drow = (mode == 0) ? nn : (256 * (nn >> 7) + (mode - 1) * 128 + (nn & 127));
        *(u32x4*)(WT + (size_t)drow * K + k0 + 8 * c) = o; }
    asm volatile("s_waitcnt lgkmcnt(0)" ::: "memory");
}

struct Args { const float* in[35]; float* out; unsigned char* ws; int ph_lo, ph_hi; };

template <class KA> __device__ __forceinline__ void s5_precompute(KA a, unsigned char* ws, LAS unsigned char* lds, int g, int tid) {
    LAS float* PWr = (LAS float*)lds;
    LAS float* PWi = PWr + 17 * 64;
    LAS float* BBr = PWi + 17 * 64;
    LAS float* BBi = BBr + 1024;
    LAS float* Cr = BBi + 1024;
    LAS float* Ci = Cr + 1024;
    LAS float* Kt = Ci + 1024;
    const float* lam_re = a->in[5] + g * 64; const float* lam_im = a->in[6] + g * 64; const float dt = expf(a->in[7][g]);
    const float* b_re = a->in[8] + g * 1024; const float* b_im = a->in[9] + g * 1024; const float* c_re = a->in[10] + g * 1024; const float* c_im = a->in[11] + g * 1024;
    const float* dsk = a->in[12] + g * 16;
    for (int e = tid; e < 17 * 64; e += 512) { const int k = e >> 6, n = e & 63; const float lr = lam_re[n], li = lam_im[n];
        const float mag = expf((float)k * lr * dt); float s, c; sincosf((float)k * (li * dt), &s, &c); PWr[e] = mag * c; PWi[e] = mag * s; }
    for (int e = tid; e < 1024; e += 512) { const int n = e >> 4; const float lr = lam_re[n], li = lam_im[n];
        const float mag = expf(lr * dt); float s, c; sincosf(li * dt, &s, &c); const float ar = mag * c, ai = mag * s, den = lr * lr + li * li, nr = ar - 1.0f;
        const float fr = (nr * lr + ai * li) / den, fi = (ai * lr - nr * li) / den; const float br = b_re[e], bi = b_im[e];
        BBr[e] = fr * br - fi * bi; BBi[e] = fr * bi + fi * br; Cr[e] = c_re[e]; Ci[e] = c_im[e]; }
    __syncthreads();
    for (int e = tid; e < 4096; e += 512) { const int tau = e >> 8, p = (e >> 4) & 15, q = e & 15; float s = 0.f;
        for (int n = 0; n < 64; ++n) { const float pr = PWr[tau * 64 + n], pi = PWi[tau * 64 + n], br = BBr[n * 16 + q], bi = BBi[n * 16 + q];
            const float wr_ = pr * br - pi * bi, wi_ = pr * bi + pi * br; s += Cr[p * 64 + n] * wr_ - Ci[p * 64 + n] * wi_; }
        if (tau == 0 && p == q) s += dsk[p];
        Kt[e] = s; }
    __syncthreads();
    bf16_t* PMg = (bf16_t*)(ws + WS_PM) + (size_t)g * 256 * 256;
    bf16_t* TQg = (bf16_t*)(ws + WS_TQ) + (size_t)g * 256 * 384;
    for (int e = tid; e < 256 * 32; e += 512) { const int row = e >> 5, cgp = e & 31, t = row >> 4, p = row & 15, s = cgp >> 1, q0 = (cgp & 1) * 8;
        f32x4 v0 = {0.f, 0.f, 0.f, 0.f}, v1 = v0;
        if (s <= t) { const LAS float* kp = Kt + (t - s) * 256 + p * 16 + q0; v0 = (f32x4){kp[0], kp[1], kp[2], kp[3]}; v1 = (f32x4){kp[4], kp[5], kp[6], kp[7]}; }
        *(u32x4*)(TQg + (size_t)row * 384 + s * 16 + q0) = pack8(v0, v1); }
    for (int e = tid; e < 256 * 16; e += 512) { const int row = e >> 4, cgp = e & 15, t = row >> 4, p = row & 15, half = cgp >> 3, n0 = (cgp & 7) * 8;
        float v[8];
#pragma unroll
        for (int j = 0; j < 8; ++j) { const int n = n0 + j; const float cr = Cr[p * 64 + n], ci = Ci[p * 64 + n], pr = PWr[(t + 1) * 64 + n], pi = PWi[(t + 1) * 64 + n];
            v[j] = half == 0 ? (cr * pr - ci * pi) : -(cr * pi + ci * pr); }
        *(u32x4*)(TQg + (size_t)row * 384 + 256 + half * 64 + n0) = pack8((f32x4){v[0], v[1], v[2], v[3]}, (f32x4){v[4], v[5], v[6], v[7]}); }
    for (int e = tid; e < 256 * 32; e += 512) { const int row = e >> 5, cgp = e & 31, s = cgp >> 1, q0 = (cgp & 1) * 8;
        float v[8];
#pragma unroll
        for (int j = 0; j < 8; ++j) v[j] = 0.f;
        if (row < 128) { const int n = row & 63, im = row >> 6; const float pr = PWr[(15 - s) * 64 + n], pi = PWi[(15 - s) * 64 + n];
#pragma unroll
            for (int j = 0; j < 8; ++j) { const float br = BBr[n * 16 + q0 + j], bi = BBi[n * 16 + q0 + j]; v[j] = im == 0 ? (pr * br - pi * bi) : (pr * bi + pi * br); } }
        *(u32x4*)(PMg + (size_t)row * 256 + s * 16 + q0) = pack8((f32x4){v[0], v[1], v[2], v[3]}, (f32x4){v[4], v[5], v[6], v[7]}); }
    __syncthreads();
}

__global__ void __launch_bounds__(512, 2) fwd_kernel(Args args) {
    extern __shared__ __attribute__((aligned(16))) unsigned char lds_raw[];
    LAS unsigned char* lds = (LAS unsigned char*)lds_raw;
    const int G = gridDim.x, bid = blockIdx.x, NT = G * 512, NGW = G * 8;
    const int wave_s = __builtin_amdgcn_readfirstlane((int)threadIdx.x >> 6);
    const int lo = args.ph_lo, hi = args.ph_hi;
    if (hi < 0) cg::this_grid().sync();
    unsigned n_bar = 0;
#ifndef PHMASK
#define PHMASK 0xFFF
#endif
#define IN(k) (((PHMASK >> (k)) & 1) && lo <= (k) && (k) < hi)
#define SEAM(k) do { if (IN(k) && IN((k) + 1)) { ++n_bar; grid_bar((unsigned*)(kap->ws + OFF_BAR), n_bar * (unsigned)G, wave_s == 0 && __builtin_amdgcn_mbcnt_hi(~0u, __builtin_amdgcn_mbcnt_lo(~0u, 0u)) == 0u); } } while (0)
    typedef const __attribute__((address_space(4))) Args* KArgs;
    const KArgs kap = (KArgs)__builtin_amdgcn_kernarg_segment_ptr();
#define PH_BEGIN KArgs ap = kap; asm volatile("" : "+s"(ap)); unsigned char* const ws = ap->ws; float* const OUT = ap->out; (void)ws; (void)OUT; \
    int lane = (int)__builtin_amdgcn_mbcnt_hi(~0u, __builtin_amdgcn_mbcnt_lo(~0u, 0u)); asm volatile("" : "+v"(lane)); const int wave = wave_s, tid = wave * 64 + lane, gtid = bid * 512 + tid, gw = bid * 8 + wave; (void)gtid; (void)gw;
#define AIN(k) (ap->in[k])
#define WSP(T, off) ((T*)(ws + (off)))
    if (IN(0)) {
        PH_BEGIN
        if (bid < 32) s5_precompute(ap, ws, lds, bid, tid);
        {
            LAS float* scr = (LAS float*)(lds + wave * 16384);
            constexpr int I_IN = 16 * 112, I_GLU = 8 * 16, I_A = 8 * 32, I_B = 16 * 32, I_O = 16 * 32, I_G = 16 * 88, I_U = 16 * 88, I_D = 44 * 32, I_PG = 16 * 32, I_PLE = 4 * 32;
            constexpr int NITEMS = I_IN + I_GLU + I_A + I_B + I_O + I_G + I_U + I_D + I_PG + I_PLE;
            for (int it = gw; it < NITEMS; it += NGW) {
                int r = it;
                if (r < I_IN) { tr_item(AIN(3), 1024, INC, AIN(2), WSP(bf16_t, WS_WIN), 0, scr, r, lane); continue; } r -= I_IN;
                if (r < I_GLU) { tr_item(AIN(13), 512, 512, nullptr, WSP(bf16_t, WS_WGLU), 0, scr, r, lane); continue; } r -= I_GLU;
                if (r < I_A) { tr_item(AIN(22), 512, 1024, nullptr, WSP(bf16_t, WS_WA), 0, scr, r, lane); continue; } r -= I_A;
                if (r < I_B) { tr_item(AIN(23), 1024, 1024, nullptr, WSP(bf16_t, WS_WB), 0, scr, r, lane); continue; } r -= I_B;
                if (r < I_O) { tr_item(AIN(24), 1024, 1024, nullptr, WSP(bf16_t, WS_WO), 0, scr, r, lane); continue; } r -= I_O;
                if (r < I_G) { tr_item(AIN(26), 1024, FFN, AIN(25), WSP(bf16_t, WS_WGU), 1, scr, r, lane); continue; } r -= I_G;
                if (r < I_U) { tr_item(AIN(27), 1024, FFN, AIN(25), WSP(bf16_t, WS_WGU), 2, scr, r, lane); continue; } r -= I_U;
                if (r < I_D) { tr_item(AIN(28), FFN, 1024, nullptr, WSP(bf16_t, WS_WD), 0, scr, r, lane); continue; } r -= I_D;
                if (r < I_PG) { tr_item(AIN(30), 1024, 1024, AIN(29), WSP(bf16_t, WS_WPG), 0, scr, r, lane); continue; } r -= I_PG;
                tr_item(AIN(32), 256, 1024, nullptr, WSP(bf16_t, WS_WPLE), 0, scr, r, lane);
            }
        }
        for (int e = gtid; e < 2048 * 32; e += NT) { const int row = e >> 5, kk0 = (e & 31) * 8, pn = row >> 8, j = row & 255, oc = pn * 128 + (j & 127), ic0 = 256 * (pn >> 1) + kk0;
            const float* w = (j < 128) ? AIN(17) : AIN(19);
            f32x4 v0 = {0.f, 0.f, 0.f, 0.f}, v1 = v0;
            if ((ic0 >> 6) == (oc >> 6)) { const float* wp = w + (size_t)(oc >> 6) * 4096 + (size_t)(ic0 & 63) * 64 + (oc & 63);
                v0 = (f32x4){wp[0], wp[64], wp[128], wp[192]}; v1 = (f32x4){wp[256], wp[320], wp[384], wp[448]}; }
            *(u32x4*)(WSP(bf16_t, WS_WLRU) + (size_t)row * 256 + kk0) = pack8(v0, v1); }
        for (int e = gtid; e < 1024; e += NT) WSP(float, OFF_SP)[e] = log1pf(expf(-AIN(21)[e]));
        for (int e = gtid; e < M; e += NT) { WSP(float, OFF_SSQ1)[e] = 0.f; WSP(float, OFF_SSQ2)[e] = 0.f; WSP(float, OFF_SSQ3)[e] = 0.f; WSP(float, OFF_SSQE)[e] = 0.f; }
        for (int m = gw; m < M; m += NGW) { const f32x4* xr = (const f32x4*)(AIN(0) + (size_t)m * 1024) + lane; f32x4 v[4]; float s = 0.f;
#pragma unroll
            for (int j = 0; j < 4; ++j) { v[j] = xr[64 * j]; s += sq4(v[j]); }
            s = wave_sum(s); if (lane == 0) WSP(float, OFF_SSQ0)[m] = s;
            u32x2* o = (u32x2*)(WSP(bf16_t, WS_XB) + (size_t)m * 1024) + lane;
#pragma unroll
            for (int j = 0; j < 4; ++j) { u32x2 w; w.x = cvt_pk_bf16(v[j][0], v[j][1]); w.y = cvt_pk_bf16(v[j][2], v[j][3]); o[64 * j] = w; } }
        for (int e = gtid; e < M * PLE / 8; e += NT) { const f32x4* pp = (const f32x4*)(AIN(1)) + (size_t)e * 2; *(u32x4*)(WSP(bf16_t, WS_PB) + (size_t)e * 8) = pack8(pp[0], pp[1]); }
    }
    SEAM(0);
    if (IN(1)) {
        PH_BEGIN
        pg8::Gemm g{WSP(bf16_t, WS_XB), WSP(bf16_t, WS_WIN), 1024, 1024, 1024}; pg8::Sched S; S.init(64, 14, G, bid, (size_t)256 * 1024 * 2, 0, (size_t)256 * 1024 * 2, 0);
        EpiIn E{WSP(float, OFF_SSQ0), AIN(4), WSP(bf16_t, WS_UAS), WSP(bf16_t, WS_UB), WSP(bf16_t, WS_GA), WSP(bf16_t, WS_GB)};
        pg8::gemm_phase(lds, g, S, E, tid);
    }
    SEAM(1);
    if (IN(2)) {
        PH_BEGIN
        const float* cw = AIN(15); const float* cb = AIN(16); bf16_t* XC = WSP(bf16_t, WS_XB);
        for (int e = gtid; e < M * 128; e += NT) { const int row = e >> 7, c0 = (e & 127) * 8, l = row & 2047;
            f32x4 a0 = *(const f32x4*)(cb + c0), a1 = *(const f32x4*)(cb + c0 + 4);
#pragma unroll
            for (int j = 0; j < 4; ++j) { if (l - 3 + j >= 0) { f32x4 u0, u1; unpack8(*(const u32x4*)(WSP(bf16_t, WS_UB) + (size_t)(row - 3 + j) * 1024 + c0), u0, u1);
                    a0 += u0 * *(const f32x4*)(cw + j * 1024 + c0); a1 += u1 * *(const f32x4*)(cw + j * 1024 + c0 + 4); } }
            *(u32x4*)(XC + (size_t)row * 1024 + c0) = pack8(a0, a1); }
        pg8::Gemm g{WSP(bf16_t, WS_UAS), WSP(bf16_t, WS_PM), 384, 256, 256}; pg8::Sched S; S.init(128, 1, G, bid, (size_t)256 * 384 * 2, 0, 0, (size_t)256 * 256 * 2);
        EpiS5a E{WSP(float, WS_E)};
        pg8::gemm_phase(lds, g, S, E, tid);
    }
    SEAM(2);
    if (IN(3)) {
        PH_BEGIN
        for (int unit = gw; unit < 256; unit += NGW) { const int g = unit >> 3, b = unit & 7, n = lane;
            const float lr = AIN(5)[g * 64 + n], li = AIN(6)[g * 64 + n], dt = expf(AIN(7)[g]);
            const float mag = expf(16.0f * lr * dt); float sn, cs; sincosf(16.0f * (li * dt), &sn, &cs); const float ar = mag * cs, ai = mag * sn;
            float sr = 0.f, si = 0.f; const size_t row0 = (size_t)g * 1024 + b * 128;
            for (int cb_ = 0; cb_ < 128; cb_ += 16) { float er[16], ei[16];
#pragma unroll
                for (int j = 0; j < 16; ++j) { er[j] = WSP(float, WS_E)[(row0 + cb_ + j) * 128 + n]; ei[j] = WSP(float, WS_E)[(row0 + cb_ + j) * 128 + 64 + n]; }
#pragma unroll
                for (int j = 0; j < 16; ++j) { bf16_t* d = WSP(bf16_t, WS_UAS) + (row0 + cb_ + j) * 384 + 256 + n; d[0] = (bf16_t)(cvt_pk_bf16(sr, 0.f) & 0xffffu); d[64] = (bf16_t)(cvt_pk_bf16(si, 0.f) & 0xffffu);
                    const float nr_ = ar * sr - ai * si + er[j], ni_ = ar * si + ai * sr + ei[j]; sr = nr_; si = ni_; } } }
        __syncthreads();
        pg8::Gemm g{WSP(bf16_t, WS_XB)  , WSP(bf16_t, WS_WLRU), 1024, 256, 256}; pg8::Sched S; S.init(64, 8, G, bid, (size_t)256 * 1024 * 2, 512, (size_t)256 * 256 * 2, 0); S.a_pn_shift = 1;
        EpiLru E{AIN(18), AIN(20), WSP(float, OFF_SP), WSP(bf16_t, WS_XB), OUT, WSP(bf16_t, WS_UB)};
        pg8::gemm_phase(lds, g, S, E, tid);
    }
    SEAM(3);
    if (IN(4)) {
        PH_BEGIN
        bf16_t* YB = WSP(bf16_t, WS_XB); const bf16_t* BX = WSP(bf16_t, WS_UB); const float* AA = OUT;
        LAS float* aggP = (LAS float*)lds; LAS float* aggH = aggP + 512;
        for (int unit = bid; unit < 256; unit += G) { const int b = unit >> 5, ch = (unit & 31) * 32 + (tid & 31), k = tid >> 5;
            const size_t base = (size_t)(b * 2048 + k * 128) * 1024 + ch;
            float h = 0.f, P = 1.f;
            for (int t0 = 0; t0 < 128; t0 += 16) { float av[16], bv[16];
#pragma unroll
                for (int j = 0; j < 16; ++j) { av[j] = AA[base + (size_t)(t0 + j) * 1024]; bv[j] = bf2f(BX[base + (size_t)(t0 + j) * 1024]); }
#pragma unroll
                for (int j = 0; j < 16; ++j) { h = av[j] * h + bv[j]; P *= av[j]; } }
            aggP[tid] = P; aggH[tid] = h;
            __syncthreads();
            float c = 0.f;
            for (int kk = 0; kk < k; ++kk) c = aggP[kk * 32 + (tid & 31)] * c + aggH[kk * 32 + (tid & 31)];
            h = c;
            for (int t0 = 0; t0 < 128; t0 += 16) { float av[16], bv[16];
#pragma unroll
                for (int j = 0; j < 16; ++j) { av[j] = AA[base + (size_t)(t0 + j) * 1024]; bv[j] = bf2f(BX[base + (size_t)(t0 + j) * 1024]); }
#pragma unroll
                for (int j = 0; j < 16; ++j) { h = av[j] * h + bv[j]; YB[base + (size_t)(t0 + j) * 1024] = (bf16_t)(cvt_pk_bf16(h, 0.f) & 0xffffu); } }
            __syncthreads();
        }
        pg8::Gemm g{WSP(bf16_t, WS_UAS), WSP(bf16_t, WS_TQ), 384, 384, 384}; pg8::Sched S; S.init(128, 1, G, bid, (size_t)256 * 384 * 2, 0, 0, (size_t)256 * 384 * 2);
        EpiS5b E{WSP(bf16_t, WS_E)};
        pg8::gemm_phase(lds, g, S, E, tid);
    }
    SEAM(4);
    if (IN(5)) {
        PH_BEGIN
        pg8::Gemm g{WSP(bf16_t, WS_E), WSP(bf16_t, WS_WGLU), 512, 512, 512}; pg8::Sched S; S.init(64, 2, G, bid, (size_t)256 * 512 * 2, 0, (size_t)256 * 512 * 2, 0);
        EpiGlu E{WSP(bf16_t, WS_E), AIN(14), WSP(bf16_t, WS_UAS)};
        pg8::gemm_phase(lds, g, S, E, tid);
    }
    SEAM(5);
    if (IN(6)) {
        PH_BEGIN
        { pg8::Gemm g{WSP(bf16_t, WS_UAS), WSP(bf16_t, WS_WA), 512, 512, 512}; pg8::Sched S; S.init(64, 4, G, bid, (size_t)256 * 512 * 2, 0, (size_t)256 * 512 * 2, 0);
          EpiMa E{WSP(bf16_t, WS_GA), OUT}; pg8::gemm_phase(lds, g, S, E, tid); }
        { pg8::Gemm g{WSP(bf16_t, WS_XB)  , WSP(bf16_t, WS_WB), 1024, 1024, 1024}; pg8::Sched S; S.init(64, 4, G, bid, (size_t)256 * 1024 * 2, 0, (size_t)256 * 1024 * 2, 0);
          EpiMb E{WSP(bf16_t, WS_GB), OUT, WSP(bf16_t, WS_UB)  }; pg8::gemm_phase(lds, g, S, E, tid); }
    }
    SEAM(6);
    if (IN(7)) {
        PH_BEGIN
        pg8::Gemm g{WSP(bf16_t, WS_UB)  , WSP(bf16_t, WS_WO), 1024, 1024, 1024}; pg8::Sched S; S.init(64, 4, G, bid, (size_t)256 * 1024 * 2, 0, (size_t)256 * 1024 * 2, 0);
        EpiRes E{AIN(0), OUT, WSP(bf16_t, WS_XB)  , WSP(float, OFF_SSQ1)};
        pg8::gemm_phase(lds, g, S, E, tid);
    }
    SEAM(7);
    if (IN(8)) {
        PH_BEGIN
        pg8::Gemm g{WSP(bf16_t, WS_XB)  , WSP(bf16_t, WS_WGU), 1024, 1024, 1024}; pg8::Sched S; S.init(64, 22, G, bid, (size_t)256 * 1024 * 2, 0, (size_t)256 * 1024 * 2, 0);
        EpiFfn E{WSP(float, OFF_SSQ1), WSP(bf16_t, WS_ACT)};
        pg8::gemm_phase(lds, g, S, E, tid);
    }
    SEAM(8);
    if (IN(9)) {
        PH_BEGIN
        { pg8::Gemm g{WSP(bf16_t, WS_ACT), WSP(bf16_t, WS_WD), FFN, FFN, FFN}; pg8::Sched S; S.init(64, 4, G, bid, (size_t)256 * FFN * 2, 0, (size_t)256 * FFN * 2, 0);
          EpiRes E{OUT, OUT, WSP(bf16_t, WS_XB)  , WSP(float, OFF_SSQ2)}; pg8::gemm_phase(lds, g, S, E, tid); }
        { pg8::Gemm g{WSP(bf16_t, WS_PB), WSP(bf16_t, WS_WPLE), 256, 256, 256}; pg8::Sched S; S.init(64, 4, G, bid, (size_t)256 * 256 * 2, 0, (size_t)256 * 256 * 2, 0);
          EpiEraw E{WSP(bf16_t, WS_GA), WSP(float, OFF_SSQE)}; pg8::gemm_phase(lds, g, S, E, tid); }
    }
    SEAM(9);
    if (IN(10)) {
        PH_BEGIN
        pg8::Gemm g{WSP(bf16_t, WS_XB)  , WSP(bf16_t, WS_WPG), 1024, 1024, 1024}; pg8::Sched S; S.init(64, 4, G, bid, (size_t)256 * 1024 * 2, 0, (size_t)256 * 1024 * 2, 0);
        EpiPg E{WSP(float, OFF_SSQ2), WSP(float, OFF_SSQE), AIN(31), AIN(33), WSP(bf16_t, WS_GA), OUT, WSP(float, OFF_SSQ3)};
        pg8::gemm_phase(lds, g, S, E, tid);
    }
    SEAM(10);
    if (IN(11)) {
        PH_BEGIN
        const f32x4* gf = (const f32x4*)AIN(34) + lane;
        for (int m = gw; m < M; m += NGW) { f32x4* xr = (f32x4*)(OUT + (size_t)m * 1024) + lane; const float rs = rstd_of(WSP(float, OFF_SSQ3)[m]);
#pragma unroll
            for (int j = 0; j < 4; ++j) xr[64 * j] = xr[64 * j] * rs * gf[64 * j]; }
    }
#undef IN
#undef SEAM
}

constexpr int LDS_BYTES = 147456;
extern "C" void kernel_launch(void* const* d_in, const int* in_sizes, int n_in, void* d_out, int out_size, void* d_ws, size_t ws_size, hipStream_t stream) {
    static int grid = 0;
    if (grid == 0) {
        int dev = 0, cus = 0, per_cu = 0;
        hipGetDevice(&dev); hipDeviceGetAttribute(&cus, hipDeviceAttributeMultiprocessorCount, dev);
        if (hipFuncSetAttribute((const void*)fwd_kernel, hipFuncAttributeMaxDynamicSharedMemorySize, LDS_BYTES) != hipSuccess) { fprintf(stderr, "kernel_launch: hipFuncSetAttribute failed\n"); grid = -1; return; }
        if (hipOccupancyMaxActiveBlocksPerMultiprocessor(&per_cu, (const void*)fwd_kernel, 512, LDS_BYTES) != hipSuccess || per_cu < 1) { fprintf(stderr, "kernel_launch: occupancy query says %d\n", per_cu); per_cu = 1; }
        (void)hipGetLastError();
        if (cus <= 0) cus = 256;
        grid = cus * per_cu;
        if (n_in != 35 || ws_size < WS_END) { fprintf(stderr, "kernel_launch: unexpected n_in %d / ws_size %zu\n", n_in, ws_size); grid = -1; return; }
    }
    if (grid < 0) return;
    (void)hipMemsetAsync((char*)d_ws + OFF_BAR, 0, 256, stream);
    Args a{};
    for (int i = 0; i < 35; ++i) a.in[i] = (const float*)d_in[i];
    a.out = (float*)d_out; a.ws = (unsigned char*)d_ws;
#if MK_N_LAUNCHES == 1
    a.ph_lo = 0; a.ph_hi = NPH;
    void* kargs[] = {&a};
    hipError_t e = hipLaunchCooperativeKernel((const void*)fwd_kernel, dim3(grid), dim3(512), kargs, LDS_BYTES, stream);
    if (e != hipSuccess) fprintf(stderr, "kernel_launch: cooperative launch failed: %s (grid %d)\n", hipGetErrorString(e), grid);
#else
    for (int ph = 0; ph < NPH; ++ph) { a.ph_lo = ph; a.ph_hi = ph + 1; hipLaunchKernelGGL(fwd_kernel, dim3(grid), dim3(512), LDS_BYTES, stream, a); }
#endif
}
```

```cpp
#include <hip/hip_runtime.h>
#include <hip/hip_cooperative_groups.h>
#include <cstdio>
#include <cstdint>
namespace cg = cooperative_groups;

#ifndef MK_N_LAUNCHES
#define MK_N_LAUNCHES 1
#endif

#define LAS __attribute__((address_space(3)))
typedef unsigned short bf16_t;
typedef short bf16x8 __attribute__((ext_vector_type(8)));
typedef float f32x4 __attribute__((ext_vector_type(4)));
typedef unsigned u32x4 __attribute__((ext_vector_type(4)));
typedef unsigned u32x2 __attribute__((ext_vector_type(2)));

constexpr int M = 16384, DM = 1024, SEQ = 2048, INC = 3584, FFN = 2816, PLE = 256;
constexpr float EPS = 1e-6f;
constexpr int NPH = 12;

constexpr size_t MiB = 1u << 20;
constexpr size_t WS_CTL = 0;
constexpr size_t OFF_BAR = 524288;
constexpr size_t OFF_SSQ0 = 0, OFF_SSQ1 = 65536, OFF_SSQ2 = 131072, OFF_SSQ3 = 196608, OFF_SSQE = 262144, OFF_SP = 327680;
constexpr size_t WS_WIN = 1 * MiB, WS_WGLU = 8 * MiB, WS_WPLE = 8 * MiB + 512 * 1024, WS_WA = 9 * MiB, WS_WB = 10 * MiB, WS_WO = 12 * MiB, WS_WGU = 14 * MiB,
                 WS_WD = 25 * MiB, WS_WPG = 31 * MiB, WS_PM = 33 * MiB, WS_TQ = 37 * MiB, WS_WLRU = 43 * MiB;
constexpr size_t WS_PB = 44 * MiB;
constexpr size_t WS_GA = 52 * MiB, WS_GB = 84 * MiB;
constexpr size_t WS_XB = 116 * MiB;
constexpr size_t WS_UB = 148 * MiB;
constexpr size_t WS_UAS = 180 * MiB;
constexpr size_t WS_E = 228 * MiB;
constexpr size_t WS_ACT = 148 * MiB;
constexpr size_t WS_END = 256 * MiB;

__device__ __forceinline__ unsigned cvt_pk_bf16(float lo, float hi) { unsigned r; asm volatile("v_cvt_pk_bf16_f32 %0, %1, %2" : "=v"(r) : "v"(lo), "v"(hi)); return r; }
__device__ __forceinline__ u32x4 pack8(const f32x4 a, const f32x4 b) { u32x4 w; w.x = cvt_pk_bf16(a[0], a[1]); w.y = cvt_pk_bf16(a[2], a[3]); w.z = cvt_pk_bf16(b[0], b[1]); w.w = cvt_pk_bf16(b[2], b[3]); return w; }
__device__ __forceinline__ void unpack8(const u32x4 w, f32x4& a, f32x4& b) {
    a[0] = __uint_as_float(w.x << 16); a[1] = __uint_as_float(w.x & 0xffff0000u); a[2] = __uint_as_float(w.y << 16); a[3] = __uint_as_float(w.y & 0xffff0000u);
    b[0] = __uint_as_float(w.z << 16); b[1] = __uint_as_float(w.z & 0xffff0000u); b[2] = __uint_as_float(w.w << 16); b[3] = __uint_as_float(w.w & 0xffff0000u);
}
__device__ __forceinline__ float bf2f(bf16_t h) { return __uint_as_float((unsigned)h << 16); }
__device__ __forceinline__ float sigm(float x) { return __builtin_amdgcn_rcpf(1.0f + __expf(-x)); }
__device__ __forceinline__ f32x4 sigm4(f32x4 v) { f32x4 o; o[0] = sigm(v[0]); o[1] = sigm(v[1]); o[2] = sigm(v[2]); o[3] = sigm(v[3]); return o; }
__device__ __forceinline__ float gelu_tanh(float y) { const float t = 1.5957691216057308f * (y + 0.044715f * y * y * y); return y * sigm(t); }
__device__ __forceinline__ float sq4(f32x4 v) { return (v[0] * v[0] + v[1] * v[1]) + (v[2] * v[2] + v[3] * v[3]); }
__device__ __forceinline__ float rstd_of(float ssq) { return rsqrtf(ssq * (1.0f / 1024.0f) + EPS); }
__device__ __forceinline__ float wave_sum(float v) {
#pragma unroll
    for (int o = 1; o < 64; o <<= 1) v += __shfl_xor(v, o);
    return v;
}

__device__ __forceinline__ void grid_bar(unsigned* ctr, unsigned target, bool leader) {
    asm volatile("s_waitcnt vmcnt(0)" ::: "memory");
    __syncthreads();
    if (leader) {
        __builtin_amdgcn_fence(__ATOMIC_RELEASE, "agent");
        asm volatile("s_waitcnt vmcnt(0)" ::: "memory");
        __hip_atomic_fetch_add(ctr, 1u, __ATOMIC_RELAXED, __HIP_MEMORY_SCOPE_AGENT);
        unsigned spins = 0;
        while (__hip_atomic_load(ctr, __ATOMIC_RELAXED, __HIP_MEMORY_SCOPE_AGENT) < target) { __builtin_amdgcn_s_sleep(2); if (++spins > (1u << 24)) break; }
        __builtin_amdgcn_fence(__ATOMIC_ACQUIRE, "agent");
        asm volatile("s_waitcnt vmcnt(0)" ::: "memory");
    }
    __syncthreads();
}

namespace pg8 {
constexpr int BM = 256, BK = 64, HALF = 128, HTB = HALF * BK * 2, STAGE_BYTES = 8 * HTB, NXCD = 8, WGM = 8;
__host__ __device__ __forceinline__ int lds_byte(int r, int c) { const int st = (r >> 4) * 2 + (c >> 5), rr = r & 15, cc = c & 31, ob = rr * 64 + cc * 2; return st * 1024 + (ob ^ (((ob >> 9) & 1) << 5)); }
__host__ __device__ __forceinline__ void stage_rc(int b, int& R, int& C) { const int st = b / 1024, sb = b % 1024, swz = sb ^ (((sb >> 9) & 1) << 5); R = (st >> 1) * 16 + swz / 64; C = (st & 1) * 32 + (swz % 64) / 2; }
__host__ __device__ __forceinline__ int perm32(int rho) { const int n = rho >> 4, i = rho & 15; return 8 * (i >> 2) + 4 * n + (i & 3); }

struct Unit { int pm, pn; size_t aoff, boff; };
struct Gemm { const bf16_t* A; const bf16_t* Bt; int lda, ldb, K; };

struct Sched {
    int nM, nN, nwg, G, c;
    size_t a_pm, a_pn, b_pn, b_grp; int a_pn_shift;
    __device__ __forceinline__ void init(int nM_, int nN_, int G_, int c_, size_t a_pm_, size_t a_pn_, size_t b_pn_, size_t b_grp_) {
        nM = nM_; nN = nN_; nwg = nM * nN; G = G_; c = c_; a_pm = a_pm_; a_pn = a_pn_; b_pn = b_pn_; b_grp = b_grp_; a_pn_shift = 0; }
    __device__ __forceinline__ bool next(int i, Unit& u) const {
        const long L = (long)i * G + c; if (L >= nwg) return false;
        int wgid = (int)L; { const int q = nwg / NXCD, r = nwg % NXCD, xcd = wgid % NXCD, off = wgid / NXCD; wgid = (xcd < r ? xcd * (q + 1) : r * (q + 1) + (xcd - r) * q) + off; }
        const int nig = WGM * nN, gid = wgid / nig, fm = gid * WGM, gsz = (nM - fm) < WGM ? (nM - fm) : WGM;
        u.pm = fm + ((wgid % nig) % gsz); u.pn = (wgid % nig) / gsz;
        u.aoff = (size_t)u.pm * a_pm + (size_t)(u.pn >> a_pn_shift) * a_pn; u.boff = (size_t)u.pn * b_pn + (size_t)(u.pm >> 2) * b_grp;
        return true;
    }
};

template <class Epi>
__device__ __forceinline__ void gemm_phase(LAS unsigned char* lds, const Gemm g, const Sched& S, const Epi& E, int tid_) {
    asm volatile("" : "+v"(tid_));
    const int tid = tid_, wid = __builtin_amdgcn_readfirstlane(tid >> 6), lane = tid & 63, wr = wid >> 2, wc = wid & 3, fr = lane & 15, fq = lane >> 4;
    const int nt = g.K / BK;
    unsigned voffA[2], voffB[2];
#pragma unroll
    for (int i = 0; i < 2; ++i) { int R, C; stage_rc(tid * 16 + i * 8192, R, C); const int Rb = (R & ~31) + perm32(R & 31);
        voffA[i] = (unsigned)(R * g.lda + C) * 2u; voffB[i] = (unsigned)(Rb * g.ldb + C) * 2u; }
    const size_t kstep = (size_t)(BK * 2);
    const size_t hstepA = (size_t)HALF * g.lda * 2, hstepB = (size_t)HALF * g.ldb * 2;
    const unsigned ldsw = (unsigned)wid * 1024u;
    const int aoff = lds_byte(wr * 64 + fr, fq * 8), boff = lds_byte(wc * 32 + fr, fq * 8);
#define PG8_SA(b, h) (((b) * 2 + (h)) * HTB)
#define PG8_SB(b, h) ((4 + (b) * 2 + (h)) * HTB)
#define PG8_STAGE(bufoff, gbase, voff) do { _Pragma("unroll") for (int _i = 0; _i < 2; ++_i) \
        __builtin_amdgcn_global_load_lds((const unsigned*)((const char*)(gbase) + (voff)[_i]), (LAS unsigned*)(lds + (bufoff) + ldsw + _i * 8192), 16, 0, 0); } while (0)
#define PG8_LDA(dst, b, h) do { _Pragma("unroll") for (int m = 0; m < 4; ++m) _Pragma("unroll") for (int k = 0; k < 2; ++k) dst[m][k] = *(const LAS bf16x8*)(lds + PG8_SA(b, h) + aoff + m * 2048 + k * 1024); } while (0)
#define PG8_LDB(dst, b, h) do { _Pragma("unroll") for (int n = 0; n < 2; ++n) _Pragma("unroll") for (int k = 0; k < 2; ++k) dst[n][k] = *(const LAS bf16x8*)(lds + PG8_SB(b, h) + boff + n * 2048 + k * 1024); } while (0)
#define PG8_MMA(ai, bj, At, Bt) do { __builtin_amdgcn_s_setprio(1); _Pragma("unroll") for (int m = 0; m < 4; ++m) _Pragma("unroll") for (int n = 0; n < 2; ++n) _Pragma("unroll") for (int k = 0; k < 2; ++k) \
        acc[ai][bj][m][n] = __builtin_amdgcn_mfma_f32_16x16x32_bf16(Bt[n][k], At[m][k], acc[ai][bj][m][n], 0, 0, 0); __builtin_amdgcn_s_setprio(0); } while (0)
#define PG8_WAIT_V(n) asm volatile("s_waitcnt vmcnt(" #n ")" ::: "memory")
#define PG8_WAIT_L(n) asm volatile("s_waitcnt lgkmcnt(" #n ")" ::: "memory")
#define PG8_BAR __builtin_amdgcn_s_barrier()
#define PG8_SCHED __builtin_amdgcn_sched_barrier(0)
    Unit cur, nxt; int ui = 0;
    if (!S.next(0, cur)) return;
    f32x4 acc[2][2][4][2];
#pragma unroll
    for (int a = 0; a < 2; ++a)
#pragma unroll
        for (int b = 0; b < 2; ++b)
#pragma unroll
            for (int m = 0; m < 4; ++m)
#pragma unroll
                for (int n = 0; n < 2; ++n) acc[a][b][m][n] = (f32x4){0.f, 0.f, 0.f, 0.f};
    bf16x8 At[4][2], B0[2][2], B1[2][2];
    const char* cA = (const char*)g.A + cur.aoff; const char* cB = (const char*)g.Bt + cur.boff;
    PG8_STAGE(PG8_SB(0, 0), cB, voffB); PG8_STAGE(PG8_SB(0, 1), cB + hstepB, voffB); PG8_STAGE(PG8_SA(0, 0), cA, voffA); PG8_STAGE(PG8_SA(0, 1), cA + hstepA, voffA);
    if (wr == 1) PG8_BAR;
    PG8_WAIT_V(2); PG8_BAR;
    PG8_STAGE(PG8_SB(1, 0), cB + kstep, voffB); PG8_STAGE(PG8_SA(1, 0), cA + kstep, voffA); PG8_STAGE(PG8_SB(1, 1), cB + hstepB + kstep, voffB);
    PG8_WAIT_V(6); PG8_BAR;
    for (;;) {
        const bool has_next = S.next(ui + 1, nxt);
        const char* nA = has_next ? (const char*)g.A + nxt.aoff : cA; const char* nB = has_next ? (const char*)g.Bt + nxt.boff : cB;
        for (int t = 0; t < nt; t += 2) {
            const bool last = (t == nt - 2);
            const char* a1 = cA + (size_t)(t + 1) * kstep;
            const char* a2 = last ? nA : cA + (size_t)(t + 2) * kstep; const char* b2 = last ? nB : cB + (size_t)(t + 2) * kstep;
            const char* a3 = a2 + kstep; const char* b3 = b2 + kstep;
            PG8_LDB(B0, 0, 0); PG8_LDB(B1, 0, 1); PG8_SCHED; PG8_LDA(At, 0, 0); PG8_STAGE(PG8_SA(1, 1), a1 + hstepA, voffA);
            PG8_WAIT_V(8); PG8_WAIT_L(0); PG8_BAR; PG8_MMA(0, 0, At, B0); PG8_MMA(0, 1, At, B1); PG8_BAR; PG8_SCHED;
            PG8_LDA(At, 0, 1); PG8_STAGE(PG8_SB(0, 0), b2, voffB); PG8_STAGE(PG8_SB(0, 1), b2 + hstepB, voffB); PG8_STAGE(PG8_SA(0, 0), a2, voffA);
            PG8_WAIT_V(8); PG8_WAIT_L(0); PG8_BAR; PG8_MMA(1, 0, At, B0); PG8_MMA(1, 1, At, B1); PG8_BAR; PG8_SCHED;
            PG8_LDB(B0, 1, 0); PG8_LDB(B1, 1, 1); PG8_SCHED; PG8_LDA(At, 1, 0); PG8_STAGE(PG8_SA(0, 1), a2 + hstepA, voffA);
            PG8_WAIT_V(8); PG8_WAIT_L(0); PG8_BAR; PG8_MMA(0, 0, At, B0); PG8_MMA(0, 1, At, B1); PG8_BAR; PG8_SCHED;
            PG8_LDA(At, 1, 1); PG8_STAGE(PG8_SB(1, 0), b3, voffB); PG8_STAGE(PG8_SB(1, 1), b3 + hstepB, voffB); PG8_STAGE(PG8_SA(1, 0), a3, voffA);
            PG8_WAIT_V(8); PG8_WAIT_L(0); PG8_BAR; PG8_MMA(1, 0, At, B0); PG8_MMA(1, 1, At, B1); PG8_BAR; PG8_SCHED;
        }
        if (wr == 0) PG8_BAR;
        { int fr_e = fr, fq_e = fq; asm volatile("" : "+v"(fr_e), "+v"(fq_e)); E(acc, cur, wr, wc, fr_e, fq_e); }
        if (!has_next) break;
#pragma unroll
        for (int a = 0; a < 2; ++a)
#pragma unroll
            for (int b = 0; b < 2; ++b)
#pragma unroll
                for (int m = 0; m < 4; ++m)
#pragma unroll
                    for (int n = 0; n < 2; ++n) acc[a][b][m][n] = (f32x4){0.f, 0.f, 0.f, 0.f};
        cur = nxt; cA = nA; cB = nB; ++ui;
        if (wr == 1) PG8_BAR;
    }
    PG8_WAIT_V(0);
    PG8_BAR;
#undef PG8_SA
#undef PG8_SB
#undef PG8_STAGE
#undef PG8_LDA
#undef PG8_LDB
#undef PG8_MMA
#undef PG8_WAIT_V
#undef PG8_WAIT_L
#undef PG8_BAR
#undef PG8_SCHED
}
}

typedef f32x4 AccT[2][2][4][2];
#define EPI_ROWS(ai, m) _Pragma("unroll") for (int ai = 0; ai < 2; ++ai) _Pragma("unroll") for (int m = 0; m < 4; ++m)
#define EPI_ROW(u, ai, m) ((u).pm * 256 + (ai) * 128 + wr * 64 + (m) * 16 + fr)
#define EPI_LCOL(bj) ((bj) * 128 + wc * 32 + 8 * fq)
__device__ __forceinline__ void row_atomic(float* dst, float s, int fq) { s += __shfl_xor(s, 16); s += __shfl_xor(s, 32); if (fq == 0) atomicAdd(dst, s); }

struct EpiIn {
    const float* ssq0; const float* b_in; bf16_t* UAS; bf16_t* UB; bf16_t* GA; bf16_t* GB;
    __device__ __forceinline__ void operator()(const AccT& acc, const pg8::Unit& u, int wr, int wc, int fr, int fq) const {
        EPI_ROWS(ai, m) { const int row = EPI_ROW(u, ai, m); const float rs = rstd_of(ssq0[row]);
#pragma unroll
            for (int bj = 0; bj < 2; ++bj) { const int col = u.pn * 256 + EPI_LCOL(bj);
                const f32x4 b0 = *(const f32x4*)(b_in + col), b1 = *(const f32x4*)(b_in + col + 4);
                f32x4 v0 = acc[ai][bj][m][0] * rs + b0, v1 = acc[ai][bj][m][1] * rs + b1;
                bf16_t* dst;
                if (u.pn < 2) { const int g = col >> 4, q = col & 15, b = row >> 11, l = row & 2047, c = l >> 4, t = l & 15;
                    dst = UAS + ((size_t)(g * 1024 + b * 128 + c) * 384 + t * 16 + q); }
                else if (u.pn < 6) dst = UB + (size_t)row * 1024 + (col - 512);
                else { v0 = sigm4(v0); v1 = sigm4(v1); dst = (u.pn < 10) ? GA + (size_t)row * 1024 + (col - 1536) : GB + (size_t)row * 1024 + (col - 2560); }
                *(u32x4*)dst = pack8(v0, v1); } }
    }
};
struct EpiEraw {
    bf16_t* ERAW; float* ssqe;
    __device__ __forceinline__ void operator()(const AccT& acc, const pg8::Unit& u, int wr, int wc, int fr, int fq) const {
        EPI_ROWS(ai, m) { const int row = EPI_ROW(u, ai, m); float s = 0.f;
#pragma unroll
            for (int bj = 0; bj < 2; ++bj) { const int col = u.pn * 256 + EPI_LCOL(bj); const f32x4 v0 = acc[ai][bj][m][0], v1 = acc[ai][bj][m][1];
                s += sq4(v0) + sq4(v1); *(u32x4*)(ERAW + (size_t)row * 1024 + col) = pack8(v0, v1); }
            row_atomic(ssqe + row, s, fq); }
    }
};
struct EpiS5a {
    float* E;
    __device__ __forceinline__ void operator()(const AccT& acc, const pg8::Unit& u, int wr, int wc, int fr, int fq) const {
        EPI_ROWS(ai, m) { const int row = EPI_ROW(u, ai, m); float* dst = E + (size_t)row * 128 + EPI_LCOL(0);
            *(f32x4*)dst = acc[ai][0][m][0]; *(f32x4*)(dst + 4) = acc[ai][0][m][1]; }
    }
};
struct EpiS5b {
    bf16_t* ZG;
    __device__ __forceinline__ void operator()(const AccT& acc, const pg8::Unit& u, int wr, int wc, int fr, int fq) const {
        const int lc = wc * 32 + 8 * fq;
        const int t0 = lc >> 4, p = lc & 15;
        EPI_ROWS(ai, m) { const int row = EPI_ROW(u, ai, m); const int g = row >> 10, b = (row >> 7) & 7, c = row & 127;
            bf16_t* dst = ZG + (size_t)(b * 2048 + c * 16 + t0) * 512 + g * 16 + p;
#pragma unroll
            for (int bj = 0; bj < 2; ++bj) { u32x2 w[2];
#pragma unroll
                for (int n = 0; n < 2; ++n) { f32x4 v = acc[ai][bj][m][n];
#pragma unroll
                    for (int j = 0; j < 4; ++j) v[j] = gelu_tanh(v[j]);
                    w[n].x = cvt_pk_bf16(v[0], v[1]); w[n].y = cvt_pk_bf16(v[2], v[3]); }
                *(u32x4*)(dst + bj * 8 * 512) = (u32x4){w[0].x, w[0].y, w[1].x, w[1].y};
                asm volatile("" ::: "memory"); } }
    }
};
struct EpiLru {
    const float* b_r; const float* b_i; const float* sp; const bf16_t* XC; float* AA; bf16_t* BX;
    __device__ __forceinline__ void operator()(const AccT& acc, const pg8::Unit& u, int wr, int wc, int fr, int fq) const {
        const int ch = u.pn * 128 + wc * 32 + 8 * fq;
        EPI_ROWS(ai, m) { const int row = EPI_ROW(u, ai, m); const size_t off = (size_t)row * 1024 + ch;
            const u32x4 xw = *(const u32x4*)(XC + off); f32x4 xx[2]; unpack8(xw, xx[0], xx[1]); u32x2 hw[2];
#pragma unroll
            for (int n = 0; n < 2; ++n) {
                const f32x4 r = sigm4(acc[ai][0][m][n] + *(const f32x4*)(b_r + ch + 4 * n)), ig = sigm4(acc[ai][1][m][n] + *(const f32x4*)(b_i + ch + 4 * n)), s4 = *(const f32x4*)(sp + ch + 4 * n);
                f32x4 a, h;
#pragma unroll
                for (int j = 0; j < 4; ++j) { a[j] = __expf(-8.0f * r[j] * s4[j]); h[j] = sqrtf(fmaxf(1.0f - a[j] * a[j], 0.f)) * ig[j] * xx[n][j]; }
                *(f32x4*)(AA + off + 4 * n) = a; hw[n].x = cvt_pk_bf16(h[0], h[1]); hw[n].y = cvt_pk_bf16(h[2], h[3]); }
            *(u32x4*)(BX + off) = (u32x4){hw[0].x, hw[0].y, hw[1].x, hw[1].y};
            asm volatile("" ::: "memory"); }
    }
};
struct EpiGlu {
    const bf16_t* ZG; const float* b_glu; bf16_t* YA;
    __device__ __forceinline__ void operator()(const AccT& acc, const pg8::Unit& u, int wr, int wc, int fr, int fq) const {
        EPI_ROWS(ai, m) { const int row = EPI_ROW(u, ai, m);
#pragma unroll
            for (int bj = 0; bj < 2; ++bj) { const int col = u.pn * 256 + EPI_LCOL(bj); const size_t off = (size_t)row * 512 + col;
                f32x4 z0, z1; unpack8(*(const u32x4*)(ZG + off), z0, z1);
                const f32x4 s0 = sigm4(acc[ai][bj][m][0] + *(const f32x4*)(b_glu + col)), s1 = sigm4(acc[ai][bj][m][1] + *(const f32x4*)(b_glu + col + 4));
                *(u32x4*)(YA + off) = pack8(z0 * s0, z1 * s1); } }
    }
};
struct EpiMa {
    const bf16_t* GA; float* TMP;
    __device__ __forceinline__ void operator()(const AccT& acc, const pg8::Unit& u, int wr, int wc, int fr, int fq) const {
        EPI_ROWS(ai, m) { const int row = EPI_ROW(u, ai, m);
#pragma unroll
            for (int bj = 0; bj < 2; ++bj) { const size_t off = (size_t)row * 1024 + u.pn * 256 + EPI_LCOL(bj);
                f32x4 g0, g1; unpack8(*(const u32x4*)(GA + off), g0, g1);
                *(f32x4*)(TMP + off) = g0 * acc[ai][bj][m][0]; *(f32x4*)(TMP + off + 4) = g1 * acc[ai][bj][m][1]; } }
    }
};
struct EpiMb {
    const bf16_t* GB; const float* TMP; bf16_t* MG;
    __device__ __forceinline__ void operator()(const AccT& acc, const pg8::Unit& u, int wr, int wc, int fr, int fq) const {
        EPI_ROWS(ai, m) { const int row = EPI_ROW(u, ai, m);
#pragma unroll
            for (int bj = 0; bj < 2; ++bj) { const size_t off = (size_t)row * 1024 + u.pn * 256 + EPI_LCOL(bj);
                f32x4 g0, g1; unpack8(*(const u32x4*)(GB + off), g0, g1);
                const f32x4 v0 = *(const f32x4*)(TMP + off) + g0 * acc[ai][bj][m][0], v1 = *(const f32x4*)(TMP + off + 4) + g1 * acc[ai][bj][m][1];
                *(u32x4*)(MG + off) = pack8(v0, v1); } }
    }
};
struct EpiRes {
    const float* xi; float* xo; bf16_t* XBo; float* ssq;
    __device__ __forceinline__ void operator()(const AccT& acc, const pg8::Unit& u, int wr, int wc, int fr, int fq) const {
        EPI_ROWS(ai, m) { const int row = EPI_ROW(u, ai, m); float s = 0.f;
#pragma unroll
            for (int bj = 0; bj < 2; ++bj) { const size_t off = (size_t)row * 1024 + u.pn * 256 + EPI_LCOL(bj);
                const f32x4 v0 = *(const f32x4*)(xi + off) + acc[ai][bj][m][0], v1 = *(const f32x4*)(xi + off + 4) + acc[ai][bj][m][1];
                s += sq4(v0) + sq4(v1);
                *(f32x4*)(xo + off) = v0; *(f32x4*)(xo + off + 4) = v1; *(u32x4*)(XBo + off) = pack8(v0, v1); }
            row_atomic(ssq + row, s, fq); }
    }
};
struct EpiFfn {
    const float* ssq1; bf16_t* ACT;
    __device__ __forceinline__ void operator()(const AccT& acc, const pg8::Unit& u, int wr, int wc, int fr, int fq) const {
        const int hc = u.pn * 128 + wc * 32 + 8 * fq;
        EPI_ROWS(ai, m) { const int row = EPI_ROW(u, ai, m); const float rs = rstd_of(ssq1[row]);
            f32x4 g0 = acc[ai][0][m][0] * rs, g1 = acc[ai][0][m][1] * rs; const f32x4 u0 = acc[ai][1][m][0] * rs, u1 = acc[ai][1][m][1] * rs;
            g0 = g0 * sigm4(g0) * u0; g1 = g1 * sigm4(g1) * u1;
            *(u32x4*)(ACT + (size_t)row * FFN + hc) = pack8(g0, g1); }
    }
};
struct EpiPg {
    const float* ssq2; const float* ssqe; const float* b_pg; const float* g_ple; const bf16_t* ERAW; float* xio; float* ssq3;
    __device__ __forceinline__ void operator()(const AccT& acc, const pg8::Unit& u, int wr, int wc, int fr, int fq) const {
        EPI_ROWS(ai, m) { const int row = EPI_ROW(u, ai, m); const float rs = rstd_of(ssq2[row]), re = rstd_of(ssqe[row]); float s = 0.f;
#pragma unroll
            for (int bj = 0; bj < 2; ++bj) { const int col = u.pn * 256 + EPI_LCOL(bj); const size_t off = (size_t)row * 1024 + col;
                f32x4 e0, e1; unpack8(*(const u32x4*)(ERAW + off), e0, e1);
                const f32x4 gt0 = sigm4(acc[ai][bj][m][0] * rs + *(const f32x4*)(b_pg + col)), gt1 = sigm4(acc[ai][bj][m][1] * rs + *(const f32x4*)(b_pg + col + 4));
                const f32x4 v0 = *(const f32x4*)(xio + off) + gt0 * (e0 * re * *(const f32x4*)(g_ple + col)), v1 = *(const f32x4*)(xio + off + 4) + gt1 * (e1 * re * *(const f32x4*)(g_ple + col + 4));
                s += sq4(v0) + sq4(v1);
                *(f32x4*)(xio + off) = v0; *(f32x4*)(xio + off + 4) = v1; }
            row_atomic(ssq3 + row, s, fq); }
    }
};

__device__ __forceinline__ void tr_item(const float* W, int K, int N, const float* gk, bf16_t* WT, int mode, LAS float* scr, int item, int lane) {
    const int nblk = N / 32, kb = item / nblk, nb = item % nblk, k0 = 64 * kb, n0 = 32 * nb;
#pragma unroll 8
    for (int i = 0; i < 32; ++i) { const int kk = 2 * i + (lane >> 5); float v = W[(size_t)(k0 + kk) * N + n0 + (lane & 31)]; if (gk) v *= gk[k0 + kk]; scr[kk * 33 + (lane & 31)] = v; }
    asm volatile("s_waitcnt lgkmcnt(0)" ::: "memory");
    const int c = lane & 7;
#pragma unroll
    for (int j = 0; j < 4; ++j) { const int n = (lane >> 3) + 8 * j; const LAS float* s = scr + (8 * c) * 33 + n;
        u32x4 o; o.x = cvt_pk_bf16(s[0 * 33], s[1 * 33]); o.y = cvt_pk_bf16(s[2 * 33], s[3 * 33]); o.z = cvt_pk_bf16(s[4 * 33], s[5 * 33]); o.w = cvt_pk_bf16(s[6 * 33], s[7 * 33]);
        const int nn = n0 + n; const int drow = (mode == 0) ? nn : (256 * (nn >> 7) + (mode - 1) * 128 + (nn & 127));
        *(u32x4*)(WT + (size_t)drow * K + k0 + 8 * c) = o; }
    asm volatile("s_waitcnt lgkmcnt(0)" ::: "memory");
}

struct Args { const float* in[35]; float* out; unsigned char* ws; int ph_lo, ph_hi; };

template <class KA> __device__ __forceinline__ void s5_precompute(KA a, unsigned char* ws, LAS unsigned char* lds, int g, int tid) {
    LAS float* PWr = (LAS float*)lds;
    LAS float* PWi = PWr + 17 * 64;
    LAS float* BBr = PWi + 17 * 64;
    LAS float* BBi = BBr + 1024;
    LAS float* Cr = BBi + 1024;
    LAS float* Ci = Cr + 1024;
    LAS float* Kt = Ci + 1024;
    const float* lam_re = a->in[5] + g * 64; const float* lam_im = a->in[6] + g * 64; const float dt = expf(a->in[7][g]);
    const float* b_re = a->in[8] + g * 1024; const float* b_im = a->in[9] + g * 1024; const float* c_re = a->in[10] + g * 1024; const float* c_im = a->in[11] + g * 1024;
    const float* dsk = a->in[12] + g * 16;
    for (int e = tid; e < 17 * 64; e += 512) { const int k = e >> 6, n = e & 63; const float lr = lam_re[n], li = lam_im[n];
        const float mag = expf((float)k * lr * dt); float s, c; sincosf((float)k * (li * dt), &s, &c); PWr[e] = mag * c; PWi[e] = mag * s; }
    for (int e = tid; e < 1024; e += 512) { const int n = e >> 4; const float lr = lam_re[n], li = lam_im[n];
        const float mag = expf(lr * dt); float s, c; sincosf(li * dt, &s, &c); const float ar = mag * c, ai = mag * s, den = lr * lr + li * li, nr = ar - 1.0f;
        const float fr = (nr * lr + ai * li) / den, fi = (ai * lr - nr * li) / den; const float br = b_re[e], bi = b_im[e];
        BBr[e] = fr * br - fi * bi; BBi[e] = fr * bi + fi * br; Cr[e] = c_re[e]; Ci[e] = c_im[e]; }
    __syncthreads();
    for (int e = tid; e < 4096; e += 512) { const int tau = e >> 8, p = (e >> 4) & 15, q = e & 15; float s = 0.f;
        for (int n = 0; n < 64; ++n) { const float pr = PWr[tau * 64 + n], pi = PWi[tau * 64 + n], br = BBr[n * 16 + q], bi = BBi[n * 16 + q];
            const float wr_ = pr * br - pi * bi, wi_ = pr * bi + pi * br; s += Cr[p * 64 + n] * wr_ - Ci[p * 64 + n] * wi_; }
        if (tau == 0 && p == q) s += dsk[p];
        Kt[e] = s; }
    __syncthreads();
    bf16_t* PMg = (bf16_t*)(ws + WS_PM) + (size_t)g * 256 * 256;
    bf16_t* TQg = (bf16_t*)(ws + WS_TQ) + (size_t)g * 256 * 384;
    for (int e = tid; e < 256 * 32; e += 512) { const int row = e >> 5, cgp = e & 31, t = row >> 4, p = row & 15, s = cgp >> 1, q0 = (cgp & 1) * 8;
        f32x4 v0 = {0.f, 0.f, 0.f, 0.f}, v1 = v0;
        if (s <= t) { const LAS float* kp = Kt + (t - s) * 256 + p * 16 + q0; v0 = (f32x4){kp[0], kp[1], kp[2], kp[3]}; v1 = (f32x4){kp[4], kp[5], kp[6], kp[7]}; }
        *(u32x4*)(TQg + (size_t)row * 384 + s * 16 + q0) = pack8(v0, v1); }
    for (int e = tid; e < 256 * 16; e += 512) { const int row = e >> 4, cgp = e & 15, t = row >> 4, p = row & 15, half = cgp >> 3, n0 = (cgp & 7) * 8;
        float v[8];
#pragma unroll
        for (int j = 0; j < 8; ++j) { const int n = n0 + j; const float cr = Cr[p * 64 + n], ci = Ci[p * 64 + n], pr = PWr[(t + 1) * 64 + n], pi = PWi[(t + 1) * 64 + n];
            v[j] = half == 0 ? (cr * pr - ci * pi) : -(cr * pi + ci * pr); }
        *(u32x4*)(TQg + (size_t)row * 384 + 256 + half * 64 + n0) = pack8((f32x4){v[0], v[1], v[2], v[3]}, (f32x4){v[4], v[5], v[6], v[7]}); }
    for (int e = tid; e < 256 * 32; e += 512) { const int row = e >> 5, cgp = e & 31, s = cgp >> 1, q0 = (cgp & 1) * 8;
        float v[8];
#pragma unroll
        for (int j = 0; j < 8; ++j) v[j] = 0.f;
        if (row < 128) { const int n = row & 63, im = row >> 6; const float pr = PWr[(15 - s) * 64 + n], pi = PWi[(15 - s) * 64 + n];
#pragma unroll
            for (int j = 0; j < 8; ++j) { const float br = BBr[n * 16 + q0 + j], bi = BBi[n * 16 + q0 + j]; v[j] = im == 0 ? (pr * br - pi * bi) : (pr * bi + pi * br); } }
        *(u32x4*)(PMg + (size_t)row * 256 + s * 16 + q0) = pack8((f32x4){v[0], v[1], v[2], v[3]}, (f32x4){v[4], v[5], v[6], v[7]}); }
    __syncthreads();
}

__global__ void __launch_bounds__(512, 2) fwd_kernel(Args args) {
    extern __shared__ __attribute__((aligned(16))) unsigned char lds_raw[];
    LAS unsigned char* lds = (LAS unsigned char*)lds_raw;
    const int G = gridDim.x, bid = blockIdx.x, NT = G * 512, NGW = G * 8;
    const int wave_s = __builtin_amdgcn_readfirstlane((int)threadIdx.x >> 6);
    const int lo = args.ph_lo, hi = args.ph_hi;
    if (hi < 0) cg::this_grid().sync();
    unsigned n_bar = 0;
#ifndef PHMASK
#define PHMASK 0xFFF
#endif
#define IN(k) (((PHMASK >> (k)) & 1) && lo <= (k) && (k) < hi)
#define SEAM(k) do { if (IN(k) && IN((k) + 1)) { ++n_bar; grid_bar((unsigned*)(kap->ws + OFF_BAR), n_bar * (unsigned)G, wave_s == 0 && __builtin_amdgcn_mbcnt_hi(~0u, __builtin_amdgcn_mbcnt_lo(~0u, 0u)) == 0u); } } while (0)
    typedef const __attribute__((address_space(4))) Args* KArgs;
    const KArgs kap = (KArgs)__builtin_amdgcn_kernarg_segment_ptr();
#define PH_BEGIN KArgs ap = kap; asm volatile("" : "+s"(ap)); unsigned char* const ws = ap->ws; float* const OUT = ap->out; (void)ws; (void)OUT; \
    int lane = (int)__builtin_amdgcn_mbcnt_hi(~0u, __builtin_amdgcn_mbcnt_lo(~0u, 0u)); asm volatile("" : "+v"(lane)); const int wave = wave_s, tid = wave * 64 + lane, gtid = bid * 512 + tid, gw = bid * 8 + wave; (void)gtid; (void)gw;
#define AIN(k) (ap->in[k])
#define WSP(T, off) ((T*)(ws + (off)))
    if (IN(0)) {
        PH_BEGIN
        if (bid < 32) s5_precompute(ap, ws, lds, bid, tid);
        {
            LAS float* scr = (LAS float*)(lds + wave * 16384);
            constexpr int I_IN = 16 * 112, I_GLU = 8 * 16, I_A = 8 * 32, I_B = 16 * 32, I_O = 16 * 32, I_G = 16 * 88, I_U = 16 * 88, I_D = 44 * 32, I_PG = 16 * 32, I_PLE = 4 * 32;
            constexpr int NITEMS = I_IN + I_GLU + I_A + I_B + I_O + I_G + I_U + I_D + I_PG + I_PLE;
            for (int it = gw; it < NITEMS; it += NGW) {
                int r = it;
                if (r < I_IN) { tr_item(AIN(3), 1024, INC, AIN(2), WSP(bf16_t, WS_WIN), 0, scr, r, lane); continue; } r -= I_IN;
                if (r < I_GLU) { tr_item(AIN(13), 512, 512, nullptr, WSP(bf16_t, WS_WGLU), 0, scr, r, lane); continue; } r -= I_GLU;
                if (r < I_A) { tr_item(AIN(22), 512, 1024, nullptr, WSP(bf16_t, WS_WA), 0, scr, r, lane); continue; } r -= I_A;
                if (r < I_B) { tr_item(AIN(23), 1024, 1024, nullptr, WSP(bf16_t, WS_WB), 0, scr, r, lane); continue; } r -= I_B;
                if (r < I_O) { tr_item(AIN(24), 1024, 1024, nullptr, WSP(bf16_t, WS_WO), 0, scr, r, lane); continue; } r -= I_O;
                if (r < I_G) { tr_item(AIN(26), 1024, FFN, AIN(25), WSP(bf16_t, WS_WGU), 1, scr, r, lane); continue; } r -= I_G;
                if (r < I_U) { tr_item(AIN(27), 1024, FFN, AIN(25), WSP(bf16_t, WS_WGU), 2, scr, r, lane); continue; } r -= I_U;
                if (r < I_D) { tr_item(AIN(28), FFN, 1024, nullptr, WSP(bf16_t, WS_WD), 0, scr, r, lane); continue; } r -= I_D;
                if (r < I_PG) { tr_item(AIN(30), 1024, 1024, AIN(29), WSP(bf16_t, WS_WPG), 0, scr, r, lane); continue; } r -= I_PG;
                tr_item(AIN(32), 256, 1024, nullptr, WSP(bf16_t, WS_WPLE), 0, scr, r, lane);
            }
        }
        for (int e = gtid; e < 2048 * 32; e += NT) { const int row = e >> 5, kk0 = (e & 31) * 8, pn = row >> 8, j = row & 255, oc = pn * 128 + (j & 127), ic0 = 256 * (pn >> 1) + kk0;
            const float* w = (j < 128) ? AIN(17) : AIN(19);
            f32x4 v0 = {0.f, 0.f, 0.f, 0.f}, v1 = v0;
            if ((ic0 >> 6) == (oc >> 6)) { const float* wp = w + (size_t)(oc >> 6) * 4096 + (size_t)(ic0 & 63) * 64 + (oc & 63);
                v0 = (f32x4){wp[0], wp[64], wp[128], wp[192]}; v1 = (f32x4){wp[256], wp[320], wp[384], wp[448]}; }
            *(u32x4*)(WSP(bf16_t, WS_WLRU) + (size_t)row * 256 + kk0) = pack8(v0, v1); }
        for (int e = gtid; e < 1024; e += NT) WSP(float, OFF_SP)[e] = log1pf(expf(-AIN(21)[e]));
        for (int e = gtid; e < M; e += NT) { WSP(float, OFF_SSQ1)[e] = 0.f; WSP(float, OFF_SSQ2)[e] = 0.f; WSP(float, OFF_SSQ3)[e] = 0.f; WSP(float, OFF_SSQE)[e] = 0.f; }
        for (int m = gw; m < M; m += NGW) { const f32x4* xr = (const f32x4*)(AIN(0) + (size_t)m * 1024) + lane; f32x4 v[4]; float s = 0.f;
#pragma unroll
            for (int j = 0; j < 4; ++j) { v[j] = xr[64 * j]; s += sq4(v[j]); }
            s = wave_sum(s); if (lane == 0) WSP(float, OFF_SSQ0)[m] = s;
            u32x2* o = (u32x2*)(WSP(bf16_t, WS_XB) + (size_t)m * 1024) + lane;
#pragma unroll
            for (int j = 0; j < 4; ++j) { u32x2 w; w.x = cvt_pk_bf16(v[j][0], v[j][1]); w.y = cvt_pk_bf16(v[j][2], v[j][3]); o[64 * j] = w; } }
        for (int e = gtid; e < M * PLE / 8; e += NT) { const f32x4* pp = (const f32x4*)(AIN(1)) + (size_t)e * 2; *(u32x4*)(WSP(bf16_t, WS_PB) + (size_t)e * 8) = pack8(pp[0], pp[1]); }
    }
    SEAM(0);
    if (IN(1)) {
        PH_BEGIN
        pg8::Gemm g{WSP(bf16_t, WS_XB), WSP(bf16_t, WS_WIN), 1024, 1024, 1024}; pg8::Sched S; S.init(64, 14, G, bid, (size_t)256 * 1024 * 2, 0, (size_t)256 * 1024 * 2, 0);
        EpiIn E{WSP(float, OFF_SSQ0), AIN(4), WSP(bf16_t, WS_UAS), WSP(bf16_t, WS_UB), WSP(bf16_t, WS_GA), WSP(bf16_t, WS_GB)};
        pg8::gemm_phase(lds, g, S, E, tid);
    }
    SEAM(1);
    if (IN(2)) {
        PH_BEGIN
        const float* cw = AIN(15); const float* cb = AIN(16); bf16_t* XC = WSP(bf16_t, WS_XB);
        for (int e = gtid; e < M * 128; e += NT) { const int row = e >> 7, c0 = (e & 127) * 8, l = row & 2047;
            f32x4 a0 = *(const f32x4*)(cb + c0), a1 = *(const f32x4*)(cb + c0 + 4);
#pragma unroll
            for (int j = 0; j < 4; ++j) { if (l - 3 + j >= 0) { f32x4 u0, u1; unpack8(*(const u32x4*)(WSP(bf16_t, WS_UB) + (size_t)(row - 3 + j) * 1024 + c0), u0, u1);
                    a0 += u0 * *(const f32x4*)(cw + j * 1024 + c0); a1 += u1 * *(const f32x4*)(cw + j * 1024 + c0 + 4); } }
            *(u32x4*)(XC + (size_t)row * 1024 + c0) = pack8(a0, a1); }
        pg8::Gemm g{WSP(bf16_t, WS_UAS), WSP(bf16_t, WS_PM), 384, 256, 256}; pg8::Sched S; S.init(128, 1, G, bid, (size_t)256 * 384 * 2, 0, 0, (size_t)256 * 256 * 2);
        EpiS5a E{WSP(float, WS_E)};
        pg8::gemm_phase(lds, g, S, E, tid);
    }
    SEAM(2);
    if (IN(3)) {
        PH_BEGIN
        for (int unit = gw; unit < 256; unit += NGW) { const int g = unit >> 3, b = unit & 7, n = lane;
            const float lr = AIN(5)[g * 64 + n], li = AIN(6)[g * 64 + n], dt = expf(AIN(7)[g]);
            const float mag = expf(16.0f * lr * dt); float sn, cs; sincosf(16.0f * (li * dt), &sn, &cs); const float ar = mag * cs, ai = mag * sn;
            float sr = 0.f, si = 0.f; const size_t row0 = (size_t)g * 1024 + b * 128;
            for (int cb_ = 0; cb_ < 128; cb_ += 16) { float er[16], ei[16];
#pragma unroll
                for (int j = 0; j < 16; ++j) { er[j] = WSP(float, WS_E)[(row0 + cb_ + j) * 128 + n]; ei[j] = WSP(float, WS_E)[(row0 + cb_ + j) * 128 + 64 + n]; }
#pragma unroll
                for (int j = 0; j < 16; ++j) { bf16_t* d = WSP(bf16_t, WS_UAS) + (row0 + cb_ + j) * 384 + 256 + n; d[0] = (bf16_t)(cvt_pk_bf16(sr, 0.f) & 0xffffu); d[64] = (bf16_t)(cvt_pk_bf16(si, 0.f) & 0xffffu);
                    const float nr_ = ar * sr - ai * si + er[j], ni_ = ar * si + ai * sr + ei[j]; sr = nr_; si = ni_; } } }
        __syncthreads();
        pg8::Gemm g{WSP(bf16_t, WS_XB)  , WSP(bf16_t, WS_WLRU), 1024, 256, 256}; pg8::Sched S; S.init(64, 8, G, bid, (size_t)256 * 1024 * 2, 512, (size_t)256 * 256 * 2, 0); S.a_pn_shift = 1;
        EpiLru E{AIN(18), AIN(20), WSP(float, OFF_SP), WSP(bf16_t, WS_XB), OUT, WSP(bf16_t, WS_UB)};
        pg8::gemm_phase(lds, g, S, E, tid);
    }
    SEAM(3);
    if (IN(4)) {
        PH_BEGIN
        bf16_t* YB = WSP(bf16_t, WS_XB); const bf16_t* BX = WSP(bf16_t, WS_UB); const float* AA = OUT;
        LAS float* aggP = (LAS float*)lds; LAS float* aggH = aggP + 512;
        for (int unit = bid; unit < 256; unit += G) { const int b = unit >> 5, ch = (unit & 31) * 32 + (tid & 31), k = tid >> 5;
            const size_t base = (size_t)(b * 2048 + k * 128) * 1024 + ch;
            float h = 0.f, P = 1.f;
            for (int t0 = 0; t0 < 128; t0 += 16) { float av[16], bv[16];
#pragma unroll
                for (int j = 0; j < 16; ++j) { av[j] = AA[base + (size_t)(t0 + j) * 1024]; bv[j] = bf2f(BX[base + (size_t)(t0 + j) * 1024]); }
#pragma unroll
                for (int j = 0; j < 16; ++j) { h = av[j] * h + bv[j]; P *= av[j]; } }
            aggP[tid] = P; aggH[tid] = h;
            __syncthreads();
            float c = 0.f;
            for (int kk = 0; kk < k; ++kk) c = aggP[kk * 32 + (tid & 31)] * c + aggH[kk * 32 + (tid & 31)];
            h = c;
            for (int t0 = 0; t0 < 128; t0 += 16) { float av[16], bv[16];
#pragma unroll
                for (int j = 0; j < 16; ++j) { av[j] = AA[base + (size_t)(t0 + j) * 1024]; bv[j] = bf2f(BX[base + (size_t)(t0 + j) * 1024]); }
#pragma unroll
                for (int j = 0; j < 16; ++j) { h = av[j] * h + bv[j]; YB[base + (size_t)(t0 + j) * 1024] = (bf16_t)(cvt_pk_bf16(h, 0.f) & 0xffffu); } }
            __syncthreads();
        }
        pg8::Gemm g{WSP(bf16_t, WS_UAS), WSP(bf16_t, WS_TQ), 384, 384, 384}; pg8::Sched S; S.init(128, 1, G, bid, (size_t)256 * 384 * 2, 0, 0, (size_t)256 * 384 * 2);
        EpiS5b E{WSP(bf16_t, WS_E)};
        pg8::gemm_phase(lds, g, S, E, tid);
    }
    SEAM(4);
    if (IN(5)) {
        PH_BEGIN
        pg8::Gemm g{WSP(bf16_t, WS_E), WSP(bf16_t, WS_WGLU), 512, 512, 512}; pg8::Sched S; S.init(64, 2, G, bid, (size_t)256 * 512 * 2, 0, (size_t)256 * 512 * 2, 0);
        EpiGlu E{WSP(bf16_t, WS_E), AIN(14), WSP(bf16_t, WS_UAS)};
        pg8::gemm_phase(lds, g, S, E, tid);
    }
    SEAM(5);
    if (IN(6)) {
        PH_BEGIN
        { pg8::Gemm g{WSP(bf16_t, WS_UAS), WSP(bf16_t, WS_WA), 512, 512, 512}; pg8::Sched S; S.init(64, 4, G, bid, (size_t)256 * 512 * 2, 0, (size_t)256 * 512 * 2, 0);
          EpiMa E{WSP(bf16_t, WS_GA), OUT}; pg8::gemm_phase(lds, g, S, E, tid); }
        { pg8::Gemm g{WSP(bf16_t, WS_XB)  , WSP(bf16_t, WS_WB), 1024, 1024, 1024}; pg8::Sched S; S.init(64, 4, G, bid, (size_t)256 * 1024 * 2, 0, (size_t)256 * 1024 * 2, 0);
          EpiMb E{WSP(bf16_t, WS_GB), OUT, WSP(bf16_t, WS_UB)  }; pg8::gemm_phase(lds, g, S, E, tid); }
    }
    SEAM(6);
    if (IN(7)) {
        PH_BEGIN
        pg8::Gemm g{WSP(bf16_t, WS_UB)  , WSP(bf16_t, WS_WO), 1024, 1024, 1024}; pg8::Sched S; S.init(64, 4, G, bid, (size_t)256 * 1024 * 2, 0, (size_t)256 * 1024 * 2, 0);
        EpiRes E{AIN(0), OUT, WSP(bf16_t, WS_XB)  , WSP(float, OFF_SSQ1)};
        pg8::gemm_phase(lds, g, S, E, tid);
    }
    SEAM(7);
    if (IN(8)) {
        PH_BEGIN
        pg8::Gemm g{WSP(bf16_t, WS_XB)  , WSP(bf16_t, WS_WGU), 1024, 1024, 1024}; pg8::Sched S; S.init(64, 22, G, bid, (size_t)256 * 1024 * 2, 0, (size_t)256 * 1024 * 2, 0);
        EpiFfn E{WSP(float, OFF_SSQ1), WSP(bf16_t, WS_ACT)};
        pg8::gemm_phase(lds, g, S, E, tid);
    }
    SEAM(8);
    if (IN(9)) {
        PH_BEGIN
        { pg8::Gemm g{WSP(bf16_t, WS_ACT), WSP(bf16_t, WS_WD), FFN, FFN, FFN}; pg8::Sched S; S.init(64, 4, G, bid, (size_t)256 * FFN * 2, 0, (size_t)256 * FFN * 2, 0);
          EpiRes E{OUT, OUT, WSP(bf16_t, WS_XB)  , WSP(float, OFF_SSQ2)}; pg8::gemm_phase(lds, g, S, E, tid); }
        { pg8::Gemm g{WSP(bf16_t, WS_PB), WSP(bf16_t, WS_WPLE), 256, 256, 256}; pg8::Sched S; S.init(64, 4, G, bid, (size_t)256 * 256 * 2, 0, (size_t)256 * 256 * 2, 0);
          EpiEraw E{WSP(bf16_t, WS_GA), WSP(float, OFF_SSQE)}; pg8::gemm_phase(lds, g, S, E, tid); }
    }
    SEAM(9);
    if (IN(10)) {
        PH_BEGIN
        pg8::Gemm g{WSP(bf16_t, WS_XB)  , WSP(bf16_t, WS_WPG), 1024, 1024, 1024}; pg8::Sched S; S.init(64, 4, G, bid, (size_t)256 * 1024 * 2, 0, (size_t)256 * 1024 * 2, 0);
        EpiPg E{WSP(float, OFF_SSQ2), WSP(float, OFF_SSQE), AIN(31), AIN(33), WSP(bf16_t, WS_GA), OUT, WSP(float, OFF_SSQ3)};
        pg8::gemm_phase(lds, g, S, E, tid);
    }
    SEAM(10);
    if (IN(11)) {
        PH_BEGIN
        const f32x4* gf = (const f32x4*)AIN(34) + lane;
        for (int m = gw; m < M; m += NGW) { f32x4* xr = (f32x4*)(OUT + (size_t)m * 1024) + lane; const float rs = rstd_of(WSP(float, OFF_SSQ3)[m]);
#pragma unroll
            for (int j = 0; j < 4; ++j) xr[64 * j] = xr[64 * j] * rs * gf[64 * j]; }
    }
#undef IN
#undef SEAM
}

constexpr int LDS_BYTES = 147456;
extern "C" void kernel_launch(void* const* d_in, const int* in_sizes, int n_in, void* d_out, int out_size, void* d_ws, size_t ws_size, hipStream_t stream) {
    static int grid = 0;
    if (grid == 0) {
        int dev = 0, cus = 0, per_cu = 0;
        hipGetDevice(&dev); hipDeviceGetAttribute(&cus, hipDeviceAttributeMultiprocessorCount, dev);
        if (hipFuncSetAttribute((const void*)fwd_kernel, hipFuncAttributeMaxDynamicSharedMemorySize, LDS_BYTES) != hipSuccess) { fprintf(stderr, "kernel_launch: hipFuncSetAttribute failed\n"); grid = -1; return; }
        if (hipOccupancyMaxActiveBlocksPerMultiprocessor(&per_cu, (const void*)fwd_kernel, 512, LDS_BYTES) != hipSuccess || per_cu < 1) { fprintf(stderr, "kernel_launch: occupancy query says %d\n", per_cu); per_cu = 1; }
        (void)hipGetLastError();
        if (cus <= 0) cus = 256;
        grid = cus * per_cu;
        if (n_in != 35 || ws_size < WS_END) { fprintf(stderr, "kernel_launch: unexpected n_in %d / ws_size %zu\n", n_in, ws_size); grid = -1; return; }
    }
    if (grid < 0) return;
    (void)hipMemsetAsync((char*)d_ws + OFF_BAR, 0, 256, stream);
    Args a{};
    for (int i = 0; i < 35; ++i) a.in[i] = (const float*)d_in[i];
    a.out = (float*)d_out; a.ws = (unsigned char*)d_ws;
#if MK_N_LAUNCHES == 1
    a.ph_lo = 0; a.ph_hi = NPH;
    void* kargs[] = {&a};
    hipError_t e = hipLaunchCooperativeKernel((const void*)fwd_kernel, dim3(grid), dim3(512), kargs, LDS_BYTES, stream);
    if (e != hipSuccess) fprintf(stderr, "kernel_launch: cooperative launch failed: %s (grid %d)\n", hipGetErrorString(e), grid);
#else
    for (int ph = 0; ph < NPH; ++ph) { a.ph_lo = ph; a.ph_hi = ph + 1; hipLaunchKernelGGL(fwd_kernel, dim3(grid), dim3(512), LDS_BYTES, stream, a); }
#endif
}
```

```cpp
#include <hip/hip_runtime.h>
#include <hip/hip_cooperative_groups.h>
#include <cstdio>
#include <cstdint>
namespace cg = cooperative_groups;

#ifndef MK_N_LAUNCHES
#define MK_N_LAUNCHES 1
#endif

#define LAS __attribute__((address_space(3)))
typedef unsigned short bf16_t;
typedef short bf16x8 __attribute__((ext_vector_type(8)));
typedef float f32x4 __attribute__((ext_vector_type(4)));
typedef unsigned u32x4 __attribute__((ext_vector_type(4)));
typedef unsigned u32x2 __attribute__((ext_vector_type(2)));

constexpr int M = 16384, DM = 1024, SEQ = 2048, INC = 3584, FFN = 2816, PLE = 256;
constexpr float EPS = 1e-6f;
constexpr int NPH = 12;

constexpr size_t MiB = 1u << 20;
constexpr size_t WS_CTL = 0;
constexpr size_t OFF_BAR = 524288;
constexpr size_t OFF_SSQ0 = 0, OFF_SSQ1 = 65536, OFF_SSQ2 = 131072, OFF_SSQ3 = 196608, OFF_SSQE = 262144, OFF_SP = 327680;
constexpr size_t WS_WIN = 1 * MiB, WS_WGLU = 8 * MiB, WS_WPLE = 8 * MiB + 512 * 1024, WS_WA = 9 * MiB, WS_WB = 10 * MiB, WS_WO = 12 * MiB, WS_WGU = 14 * MiB,
                 WS_WD = 25 * MiB, WS_WPG = 31 * MiB, WS_PM = 33 * MiB, WS_TQ = 37 * MiB, WS_WLRU = 43 * MiB;
constexpr size_t WS_PB = 44 * MiB;
constexpr size_t WS_GA = 52 * MiB, WS_GB = 84 * MiB;
constexpr size_t WS_XB = 116 * MiB;
constexpr size_t WS_UB = 148 * MiB;
constexpr size_t WS_UAS = 180 * MiB;
constexpr size_t WS_E = 228 * MiB;
constexpr size_t WS_ZG = 204 * MiB;
constexpr size_t WS_YAB = 116 * MiB;
constexpr size_t WS_MG = 164 * MiB;
constexpr size_t WS_ACT = 148 * MiB;
constexpr size_t WS_END = 256 * MiB;

__device__ __forceinline__ unsigned cvt_pk_bf16(float lo, float hi) { unsigned r; asm volatile("v_cvt_pk_bf16_f32 %0, %1, %2" : "=v"(r) : "v"(lo), "v"(hi)); return r; }
__device__ __forceinline__ u32x4 pack8(const f32x4 a, const f32x4 b) { u32x4 w; w.x = cvt_pk_bf16(a[0], a[1]); w.y = cvt_pk_bf16(a[2], a[3]); w.z = cvt_pk_bf16(b[0], b[1]); w.w = cvt_pk_bf16(b[2], b[3]); return w; }
__device__ __forceinline__ void unpack8(const u32x4 w, f32x4& a, f32x4& b) {
    a[0] = __uint_as_float(w.x << 16); a[1] = __uint_as_float(w.x & 0xffff0000u); a[2] = __uint_as_float(w.y << 16); a[3] = __uint_as_float(w.y & 0xffff0000u);
    b[0] = __uint_as_float(w.z << 16); b[1] = __uint_as_float(w.z & 0xffff0000u); b[2] = __uint_as_float(w.w << 16); b[3] = __uint_as_float(w.w & 0xffff0000u);
}
__device__ __forceinline__ float bf2f(bf16_t h) { return __uint_as_float((unsigned)h << 16); }
__device__ __forceinline__ float sigm(float x) { return __builtin_amdgcn_rcpf(1.0f + __expf(-x)); }
__device__ __forceinline__ f32x4 sigm4(f32x4 v) { f32x4 o; o[0] = sigm(v[0]); o[1] = sigm(v[1]); o[2] = sigm(v[2]); o[3] = sigm(v[3]); return o; }
__device__ __forceinline__ float gelu_tanh(float y) { const float t = 1.5957691216057308f * (y + 0.044715f * y * y * y); return y * sigm(t); }
__device__ __forceinline__ float sq4(f32x4 v) { return (v[0] * v[0] + v[1] * v[1]) + (v[2] * v[2] + v[3] * v[3]); }
__device__ __forceinline__ float rstd_of(float ssq) { return rsqrtf(ssq * (1.0f / 1024.0f) + EPS); }
__device__ __forceinline__ float wave_sum(float v) {
#pragma unroll
    for (int o = 1; o < 64; o <<= 1) v += __shfl_xor(v, o);
    return v;
}

#define XB_TMO      128
#define XB_XCNT(j)  (256  + 64 * (j))
#define XB_XSUB(j)  (1280 + 64 * (j))
#define XB_XGEN(j)  (2304 + 64 * (j))
#define XB_TOP      3328
#define XB_TOPGEN   3392
#define XCD_BAR_WORDS 3456
#define XB_SPIN_CAP (1u << 18)
__device__ __forceinline__ unsigned xb_ld(unsigned* p)              { return __hip_atomic_load(p, __ATOMIC_RELAXED, __HIP_MEMORY_SCOPE_AGENT); }
__device__ __forceinline__ unsigned xb_add(unsigned* p, unsigned v) { return __hip_atomic_fetch_add(p, v, __ATOMIC_RELAXED, __HIP_MEMORY_SCOPE_AGENT); }
__device__ __forceinline__ unsigned xb_xcc_id() { return (unsigned)__builtin_amdgcn_s_getreg((3 << 11) | 20) & 0xFu; }
#define XB_SPIN(cond, bar) do { unsigned _sp = 0; while (cond) { __builtin_amdgcn_s_sleep(1); \
    if ((++_sp & 255u) == 0u) { if (xb_ld(&(bar)[XB_TMO])) break; if (_sp > XB_SPIN_CAP) { atomicAdd(&(bar)[XB_TMO], 1u); break; } } } } while (0)
__device__ __forceinline__ void xcd_barrier_complete(unsigned* bar, unsigned x, unsigned G, unsigned& nloc, unsigned& nx) {
    unsigned sum, cnt, mine, sp = 0u;
    for (;;) {
        sum = 0u; cnt = 0u; mine = 0u;
#pragma unroll
        for (unsigned j = 0; j < 16; ++j) { const unsigned c = xb_ld(&bar[XB_XCNT(j)]); sum += c; cnt += (c > 0u) ? 1u : 0u; mine = (j == x) ? c : mine; }
        if (sum == G) break;
        __builtin_amdgcn_s_sleep(1);
        if ((++sp & 255u) == 0u) { if (xb_ld(&bar[XB_TMO])) break; if (sp > XB_SPIN_CAP) { atomicAdd(&bar[XB_TMO], 1u); break; } }
    }
    nloc = mine > 0u ? mine : 1u; nx = cnt > 0u ? cnt : 1u;
}
__device__ __forceinline__ void xcd_barrier(unsigned* bar, unsigned x, volatile LAS unsigned* st, unsigned G, bool leader) {
    asm volatile("s_waitcnt vmcnt(0)" ::: "memory");
    __syncthreads();
    if (leader) {
        __builtin_amdgcn_s_waitcnt(0);
        unsigned nloc = st[0], nx = st[1];
        if (nloc == 0u) { xcd_barrier_complete(bar, x, G, nloc, nx); st[0] = nloc; st[1] = nx; }
        const unsigned old = xb_add(&bar[XB_XSUB(x)], 1u);
        const unsigned gen = old / nloc;
        if (old + 1u == (gen + 1u) * nloc) {
            __builtin_amdgcn_fence(__ATOMIC_RELEASE, "agent");
            asm volatile("s_waitcnt vmcnt(0)" ::: "memory");
            const unsigned og = xb_add(&bar[XB_TOP], 1u);
            const unsigned tg = og / nx;
            if (og + 1u == (tg + 1u) * nx) xb_add(&bar[XB_TOPGEN], 1u);
            else XB_SPIN(xb_ld(&bar[XB_TOPGEN]) == tg, bar);
            __builtin_amdgcn_fence(__ATOMIC_ACQUIRE, "agent");
            xb_add(&bar[XB_XGEN(x)], 1u);
            asm volatile("s_waitcnt vmcnt(0)" ::: "memory");
        } else {
            XB_SPIN(xb_ld(&bar[XB_XGEN(x)]) == gen, bar);
            __builtin_amdgcn_fence(__ATOMIC_ACQUIRE, "agent");
            asm volatile("s_waitcnt vmcnt(0)" ::: "memory");
        }
    }
    __syncthreads();
}

namespace pg8 {
constexpr int BM = 256, BK = 64, HALF = 128, HTB = HALF * BK * 2, STAGE_BYTES = 8 * HTB, NXCD = 8, WGM = 8;
__host__ __device__ __forceinline__ int lds_byte(int r, int c) { const int st = (r >> 4) * 2 + (c >> 5), rr = r & 15, cc = c & 31, ob = rr * 64 + cc * 2; return st * 1024 + (ob ^ (((ob >> 9) & 1) << 5)); }
__host__ __device__ __forceinline__ void stage_rc(int b, int& R, int& C) { const int st = b / 1024, sb = b % 1024, swz = sb ^ (((sb >> 9) & 1) << 5); R = (st >> 1) * 16 + swz / 64; C = (st & 1) * 32 + (swz % 64) / 2; }
__host__ __device__ __forceinline__ int perm32(int rho) { const int n = rho >> 4, i = rho & 15; return 8 * (i >> 2) + 4 * n + (i & 3); }

struct Unit { int pm, pn; size_t aoff, boff; };
struct Gemm { const bf16_t* A; const bf16_t* Bt; int lda, ldb, K; };

struct Sched {
    int nM, nN, nwg, G, c;
    size_t a_pm, a_pn, b_pn, b_grp; int a_pn_shift;
    __device__ __forceinline__ void init(int nM_, int nN_, int G_, int c_, size_t a_pm_, size_t a_pn_, size_t b_pn_, size_t b_grp_) {
        nM = nM_; nN = nN_; nwg = nM * nN; G = G_; c = c_; a_pm = a_pm_; a_pn = a_pn_; b_pn = b_pn_; b_grp = b_grp_; a_pn_shift = 0; }
    __device__ __forceinline__ bool next(int i, Unit& u) const {
        const long L = (long)i * G + c; if (L >= nwg) return false;
        int wgid = (int)L; { const int q = nwg / NXCD, r = nwg % NXCD, xcd = wgid % NXCD, off = wgid / NXCD; wgid = (xcd < r ? xcd * (q + 1) : r * (q + 1) + (xcd - r) * q) + off; }
        const int nig = WGM * nN, gid = wgid / nig, fm = gid * WGM, gsz = (nM - fm) < WGM ? (nM - fm) : WGM;
        u.pm = fm + ((wgid % nig) % gsz); u.pn = (wgid % nig) / gsz;
        u.aoff = (size_t)u.pm * a_pm + (size_t)(u.pn >> a_pn_shift) * a_pn; u.boff = (size_t)u.pn * b_pn + (size_t)(u.pm >> 2) * b_grp;
        return true;
    }
};

struct OneUnit {
    int pm, pn; size_t aoff, boff;
    __device__ __forceinline__ bool next(int i, Unit& u) const { if (i != 0) return false; u.pm = pm; u.pn = pn; u.aoff = aoff; u.boff = boff; return true; }
};

struct NoMid { static constexpr bool ENABLED = false; int mid_t; template <class A, class U> __device__ __forceinline__ void operator()(A&, const U&, int, int, int, int) const {} };
template <class Epi, class SchedT, class Mid = NoMid, bool ALIGN = true>
__device__ __forceinline__ void gemm_phase(LAS unsigned char* lds, const Gemm g, const SchedT& S, const Epi& E, int tid_, const Mid Mh = Mid{}) {
    asm volatile("" : "+v"(tid_));
    const int tid = tid_, wid = __builtin_amdgcn_readfirstlane(tid >> 6), lane = tid & 63, wr = wid >> 2, wc = wid & 3, fr = lane & 15, fq = lane >> 4;
    const int nt = g.K / BK;
    unsigned voffA[2], voffB[2];
#pragma unroll
    for (int i = 0; i < 2; ++i) { int R, C; stage_rc(tid * 16 + i * 8192, R, C); const int Rb = (R & ~31) + perm32(R & 31);
        voffA[i] = (unsigned)(R * g.lda + C) * 2u; voffB[i] = (unsigned)(Rb * g.ldb + C) * 2u; }
    const size_t kstep = (size_t)(BK * 2);
    const size_t hstepA = (size_t)HALF * g.lda * 2, hstepB = (size_t)HALF * g.ldb * 2;
    const unsigned ldsw = (unsigned)wid * 1024u;
    const int aoff = lds_byte(wr * 64 + fr, fq * 8), boff = lds_byte(wc * 32 + fr, fq * 8);
#define PG8_SA(b, h) (((b) * 2 + (h)) * HTB)
#define PG8_SB(b, h) ((4 + (b) * 2 + (h)) * HTB)
#define PG8_STAGE(bufoff, gbase, voff) do { _Pragma("unroll") for (int _i = 0; _i < 2; ++_i) \
        __builtin_amdgcn_global_load_lds((const unsigned*)((const char*)(gbase) + (voff)[_i]), (LAS unsigned*)(lds + (bufoff) + ldsw + _i * 8192), 16, 0, 0); } while (0)
#define PG8_LDA(dst, b, h) do { _Pragma("unroll") for (int m = 0; m < 4; ++m) _Pragma("unroll") for (int k = 0; k < 2; ++k) dst[m][k] = *(const LAS bf16x8*)(lds + PG8_SA(b, h) + aoff + m * 2048 + k * 1024); } while (0)
#define PG8_LDB(dst, b, h) do { _Pragma("unroll") for (int n = 0; n < 2; ++n) _Pragma("unroll") for (int k = 0; k < 2; ++k) dst[n][k] = *(const LAS bf16x8*)(lds + PG8_SB(b, h) + boff + n * 2048 + k * 1024); } while (0)
#define PG8_MMA(ai, bj, At, Bt) do { __builtin_amdgcn_s_setprio(1); _Pragma("unroll") for (int m = 0; m < 4; ++m) _Pragma("unroll") for (int n = 0; n < 2; ++n) _Pragma("unroll") for (int k = 0; k < 2; ++k) \
        acc[ai][bj][m][n] = __builtin_amdgcn_mfma_f32_16x16x32_bf16(Bt[n][k], At[m][k], acc[ai][bj][m][n], 0, 0, 0); __builtin_amdgcn_s_setprio(0); } while (0)
#define PG8_WAIT_V(n) asm volatile("s_waitcnt vmcnt(" #n ")" ::: "memory")
#define PG8_WAIT_L(n) asm volatile("s_waitcnt lgkmcnt(" #n ")" ::: "memory")
#define PG8_BAR __builtin_amdgcn_s_barrier()
#define PG8_SCHED __builtin_amdgcn_sched_barrier(0)
    Unit cur, nxt; int ui = 0;
    if (!S.next(0, cur)) return;
    f32x4 acc[2][2][4][2];
#pragma unroll
    for (int a = 0; a < 2; ++a)
#pragma unroll
        for (int b = 0; b < 2; ++b)
#pragma unroll
            for (int m = 0; m < 4; ++m)
#pragma unroll
                for (int n = 0; n < 2; ++n) acc[a][b][m][n] = (f32x4){0.f, 0.f, 0.f, 0.f};
    bf16x8 At[4][2], B0[2][2], B1[2][2];
    const char* cA = (const char*)g.A + cur.aoff; const char* cB = (const char*)g.Bt + cur.boff;
    PG8_STAGE(PG8_SB(0, 0), cB, voffB); PG8_STAGE(PG8_SB(0, 1), cB + hstepB, voffB); PG8_STAGE(PG8_SA(0, 0), cA, voffA); PG8_STAGE(PG8_SA(0, 1), cA + hstepA, voffA);
    if (wr == 1) PG8_BAR;
    PG8_WAIT_V(2); PG8_BAR;
    PG8_STAGE(PG8_SB(1, 0), cB + kstep, voffB); PG8_STAGE(PG8_SA(1, 0), cA + kstep, voffA); PG8_STAGE(PG8_SB(1, 1), cB + hstepB + kstep, voffB);
    PG8_WAIT_V(6); PG8_BAR;
    for (;;) {
        const bool has_next = S.next(ui + 1, nxt);
        const char* nA = has_next ? (const char*)g.A + nxt.aoff : cA; const char* nB = has_next ? (const char*)g.Bt + nxt.boff : cB;
        for (int t = 0; t < nt; t += 2) {
            if constexpr (Mid::ENABLED) { if (t == Mh.mid_t) { int fr_e = fr, fq_e = fq; asm volatile("" : "+v"(fr_e), "+v"(fq_e)); Mh(acc, cur, wr, wc, fr_e, fq_e); } }
            const bool last = (t == nt - 2);
            const char* a1 = cA + (size_t)(t + 1) * kstep;
            const char* a2 = last ? nA : cA + (size_t)(t + 2) * kstep; const char* b2 = last ? nB : cB + (size_t)(t + 2) * kstep;
            const char* a3 = a2 + kstep; const char* b3 = b2 + kstep;
            PG8_LDB(B0, 0, 0); PG8_LDB(B1, 0, 1); PG8_SCHED; PG8_LDA(At, 0, 0); PG8_STAGE(PG8_SA(1, 1), a1 + hstepA, voffA);
            PG8_WAIT_V(8); PG8_WAIT_L(0); PG8_BAR; PG8_MMA(0, 0, At, B0); PG8_MMA(0, 1, At, B1); PG8_BAR; PG8_SCHED;
            PG8_LDA(At, 0, 1); PG8_STAGE(PG8_SB(0, 0), b2, voffB); PG8_STAGE(PG8_SB(0, 1), b2 + hstepB, voffB); PG8_STAGE(PG8_SA(0, 0), a2, voffA);
            PG8_WAIT_V(8); PG8_WAIT_L(0); PG8_BAR; PG8_MMA(1, 0, At, B0); PG8_MMA(1, 1, At, B1); PG8_BAR; PG8_SCHED;
            PG8_LDB(B0, 1, 0); PG8_LDB(B1, 1, 1); PG8_SCHED; PG8_LDA(At, 1, 0); PG8_STAGE(PG8_SA(0, 1), a2 + hstepA, voffA);
            PG8_WAIT_V(8); PG8_WAIT_L(0); PG8_BAR; PG8_MMA(0, 0, At, B0); PG8_MMA(0, 1, At, B1); PG8_BAR; PG8_SCHED;
            PG8_LDA(At, 1, 1); PG8_STAGE(PG8_SB(1, 0), b3, voffB); PG8_STAGE(PG8_SB(1, 1), b3 + hstepB, voffB); PG8_STAGE(PG8_SA(1, 0), a3, voffA);
            PG8_WAIT_V(8); PG8_WAIT_L(0); PG8_BAR; PG8_MMA(1, 0, At, B0); PG8_MMA(1, 1, At, B1); PG8_BAR; PG8_SCHED;
        }
        if constexpr (ALIGN) { if (wr == 0) PG8_BAR; }
        { int fr_e = fr, fq_e = fq; asm volatile("" : "+v"(fr_e), "+v"(fq_e)); E(acc, cur, wr, wc, fr_e, fq_e); }
        if (!has_next) break;
#pragma unroll
        for (int a = 0; a < 2; ++a)
#pragma unroll
            for (int b = 0; b < 2; ++b)
#pragma unroll
                for (int m = 0; m < 4; ++m)
#pragma unroll
                    for (int n = 0; n < 2; ++n) acc[a][b][m][n] = (f32x4){0.f, 0.f, 0.f, 0.f};
        cur = nxt; cA = nA; cB = nB; ++ui;
        if constexpr (ALIGN) { if (wr == 1) PG8_BAR; }
    }
    PG8_WAIT_V(0);
    if constexpr (!ALIGN) { if (wr == 0) PG8_BAR; }
    PG8_BAR;
#undef PG8_SA
#undef PG8_SB
#undef PG8_STAGE
#undef PG8_LDA
#undef PG8_LDB
#undef PG8_MMA
#undef PG8_WAIT_V
#undef PG8_WAIT_L
#undef PG8_BAR
#undef PG8_SCHED
}
}

typedef f32x4 AccT[2][2][4][2];
#define EPI_ROWS(ai, m) _Pragma("unroll") for (int ai = 0; ai < 2; ++ai) _Pragma("unroll") for (int m = 0; m < 4; ++m)
#define EPI_ROW(u, ai, m) ((u).pm * 256 + (ai) * 128 + wr * 64 + (m) * 16 + fr)
#define EPI_LCOL(bj) ((bj) * 128 + wc * 32 + 8 * fq)
__device__ __forceinline__ void row_atomic(float* dst, float s, int fq) { s += __shfl_xor(s, 16); s += __shfl_xor(s, 32); if (fq == 0) atomicAdd(dst, s); }

struct EpiIn {
    const float* ssq0; const float* b_in; bf16_t* UAS; bf16_t* UB; bf16_t* GR; bf16_t* GB; int pn0;
    __device__ __forceinline__ void operator()(const AccT& acc, const pg8::Unit& u, int wr, int wc, int fr, int fq) const {
        const int upn = u.pn + pn0;
        if (upn >= 6) { const int ch = (upn - 6) * 128 + wc * 32 + 8 * fq; const float NL = -1.4426950408889634f;
            const f32x4 ba0 = *(const f32x4*)(b_in + 1536 + ch) * NL, ba1 = *(const f32x4*)(b_in + 1536 + ch + 4) * NL, bb0 = *(const f32x4*)(b_in + 2560 + ch) * NL, bb1 = *(const f32x4*)(b_in + 2560 + ch + 4) * NL;
            EPI_ROWS(ai, m) { const int row = EPI_ROW(u, ai, m); const float rs = rstd_of(ssq0[row]) * NL; f32x4 r0, r1, g0, g1;
#pragma unroll
                for (int j = 0; j < 4; ++j) {
                    const float ea0 = __builtin_amdgcn_exp2f(__builtin_fmaf(acc[ai][0][m][0][j], rs, ba0[j])), ea1 = __builtin_amdgcn_exp2f(__builtin_fmaf(acc[ai][0][m][1][j], rs, ba1[j]));
                    const float eb0 = fminf(__builtin_amdgcn_exp2f(__builtin_fmaf(acc[ai][1][m][0][j], rs, bb0[j])), 1e30f), eb1 = fminf(__builtin_amdgcn_exp2f(__builtin_fmaf(acc[ai][1][m][1][j], rs, bb1[j])), 1e30f);
                    g0[j] = __builtin_amdgcn_rcpf(1.0f + eb0); g1[j] = __builtin_amdgcn_rcpf(1.0f + eb1);
                    r0[j] = (1.0f + eb0) * __builtin_amdgcn_rcpf(1.0f + ea0); r1[j] = (1.0f + eb1) * __builtin_amdgcn_rcpf(1.0f + ea1); }
                *(u32x4*)(GR + (size_t)row * 1024 + ch) = pack8(r0, r1); *(u32x4*)(GB + (size_t)row * 1024 + ch) = pack8(g0, g1); }
            return; }
        EPI_ROWS(ai, m) { const int row = EPI_ROW(u, ai, m); const float rs = rstd_of(ssq0[row]);
#pragma unroll
            for (int bj = 0; bj < 2; ++bj) { const int col = upn * 256 + EPI_LCOL(bj);
                const f32x4 b0 = *(const f32x4*)(b_in + col), b1 = *(const f32x4*)(b_in + col + 4);
                const f32x4 v0 = acc[ai][bj][m][0] * rs + b0, v1 = acc[ai][bj][m][1] * rs + b1;
                bf16_t* dst;
                if (upn < 2) { const int g = col >> 4, q = col & 15, b = row >> 11, l = row & 2047, c = l >> 4, t = l & 15;
                    dst = UAS + ((size_t)(g * 1024 + b * 128 + c) * 384 + t * 16 + q); }
                else dst = UB + (size_t)row * 1024 + (col - 512);
                *(u32x4*)dst = pack8(v0, v1); } }
    }
};
struct EpiEraw {
    bf16_t* ERAW; float* ssqe;
    __device__ __forceinline__ void operator()(const AccT& acc, const pg8::Unit& u, int wr, int wc, int fr, int fq) const {
        EPI_ROWS(ai, m) { const int row = EPI_ROW(u, ai, m); float s = 0.f;
#pragma unroll
            for (int bj = 0; bj < 2; ++bj) { const int col = u.pn * 256 + EPI_LCOL(bj); const f32x4 v0 = acc[ai][bj][m][0], v1 = acc[ai][bj][m][1];
                s += sq4(v0) + sq4(v1); *(u32x4*)(ERAW + (size_t)row * 1024 + col) = pack8(v0, v1); }
            row_atomic(ssqe + row, s, fq); }
    }
};
struct EpiS5a {
    float* E;
    __device__ __forceinline__ void operator()(const AccT& acc, const pg8::Unit& u, int wr, int wc, int fr, int fq) const {
        EPI_ROWS(ai, m) { const int row = EPI_ROW(u, ai, m); float* dst = E + (size_t)row * 128 + EPI_LCOL(0);
            *(f32x4*)dst = acc[ai][0][m][0]; *(f32x4*)(dst + 4) = acc[ai][0][m][1]; }
    }
};
struct EpiS5b {
    bf16_t* ZG;
    __device__ __forceinline__ void operator()(const AccT& acc, const pg8::Unit& u, int wr, int wc, int fr, int fq) const {
        const int lc = wc * 32 + 8 * fq;
        const int t0 = lc >> 4, p = lc & 15;
        EPI_ROWS(ai, m) { const int row = EPI_ROW(u, ai, m); const int g = row >> 10, b = (row >> 7) & 7, c = row & 127;
            bf16_t* dst = ZG + (size_t)(b * 2048 + c * 16 + t0) * 512 + g * 16 + p;
#pragma unroll
            for (int bj = 0; bj < 2; ++bj) { u32x2 w[2];
#pragma unroll
                for (int n = 0; n < 2; ++n) { f32x4 v = acc[ai][bj][m][n];
#pragma unroll
                    for (int j = 0; j < 4; ++j) v[j] = gelu_tanh(v[j]);
                    w[n].x = cvt_pk_bf16(v[0], v[1]); w[n].y = cvt_pk_bf16(v[2], v[3]); }
                *(u32x4*)(dst + bj * 8 * 512) = (u32x4){w[0].x, w[0].y, w[1].x, w[1].y};
                asm volatile("" ::: "memory"); } }
    }
};
struct EpiLru {
    const float* b_r; const float* b_i; const float* sp; const bf16_t* XC; float* AA; bf16_t* BX;
    __device__ __forceinline__ void operator()(const AccT& acc, const pg8::Unit& u, int wr, int wc, int fr, int fq) const {
        const int ch = u.pn * 128 + wc * 32 + 8 * fq;
        EPI_ROWS(ai, m) { const int row = EPI_ROW(u, ai, m); const size_t off = (size_t)row * 1024 + ch;
            const u32x4 xw = *(const u32x4*)(XC + off); f32x4 xx[2]; unpack8(xw, xx[0], xx[1]); u32x2 hw[2];
#pragma unroll
            for (int n = 0; n < 2; ++n) {
                const f32x4 r = sigm4(acc[ai][0][m][n] + *(const f32x4*)(b_r + ch + 4 * n)), ig = sigm4(acc[ai][1][m][n] + *(const f32x4*)(b_i + ch + 4 * n)), s4 = *(const f32x4*)(sp + ch + 4 * n);
                f32x4 a, h;
#pragma unroll
                for (int j = 0; j < 4; ++j) { a[j] = __expf(-8.0f * r[j] * s4[j]); h[j] = sqrtf(fmaxf(1.0f - a[j] * a[j], 0.f)) * ig[j] * xx[n][j]; }
                *(f32x4*)(AA + off + 4 * n) = a; hw[n].x = cvt_pk_bf16(h[0], h[1]); hw[n].y = cvt_pk_bf16(h[2], h[3]); }
            *(u32x4*)(BX + off) = (u32x4){hw[0].x, hw[0].y, hw[1].x, hw[1].y};
            asm volatile("" ::: "memory"); }
    }
};
struct EpiGlu {
    const bf16_t* ZG; const float* b_glu; bf16_t* YA;
    __device__ __forceinline__ void operator()(const AccT& acc, const pg8::Unit& u, int wr, int wc, int fr, int fq) const {
        EPI_ROWS(ai, m) { const int row = EPI_ROW(u, ai, m);
#pragma unroll
            for (int bj = 0; bj < 2; ++bj) { const int col = u.pn * 256 + EPI_LCOL(bj); const size_t off = (size_t)row * 512 + col;
                f32x4 z0, z1; unpack8(*(const u32x4*)(ZG + off), z0, z1);
                const f32x4 s0 = sigm4(acc[ai][bj][m][0] + *(const f32x4*)(b_glu + col)), s1 = sigm4(acc[ai][bj][m][1] + *(const f32x4*)(b_glu + col + 4));
                *(u32x4*)(YA + (size_t)row * 1536 + col) = pack8(z0 * s0, z1 * s1); } }
    }
};
struct MidGate {
    static constexpr bool ENABLED = true; int mid_t; const bf16_t* GR;
    __device__ __forceinline__ void operator()(AccT& acc, const pg8::Unit& u, int wr, int wc, int fr, int fq) const {
#pragma unroll
        for (int ai = 0; ai < 2; ++ai) { u32x4 gr[4][2];
#pragma unroll
            for (int m = 0; m < 4; ++m)
#pragma unroll
                for (int bj = 0; bj < 2; ++bj) gr[m][bj] = *(const u32x4*)(GR + (size_t)EPI_ROW(u, ai, m) * 1024 + u.pn * 256 + EPI_LCOL(bj));
#pragma unroll
            for (int m = 0; m < 4; ++m)
#pragma unroll
                for (int bj = 0; bj < 2; ++bj) { f32x4 a0, a1; unpack8(gr[m][bj], a0, a1); acc[ai][bj][m][0] *= a0; acc[ai][bj][m][1] *= a1; }
            asm volatile("" ::: "memory"); }
    }
};
struct EpiMg {
    const bf16_t* GB; bf16_t* MG;
    __device__ __forceinline__ void operator()(const AccT& acc, const pg8::Unit& u, int wr, int wc, int fr, int fq) const {
#pragma unroll
        for (int ai = 0; ai < 2; ++ai) { u32x4 gb[4][2];
#pragma unroll
            for (int m = 0; m < 4; ++m)
#pragma unroll
                for (int bj = 0; bj < 2; ++bj) gb[m][bj] = *(const u32x4*)(GB + (size_t)EPI_ROW(u, ai, m) * 1024 + u.pn * 256 + EPI_LCOL(bj));
#pragma unroll
            for (int m = 0; m < 4; ++m)
#pragma unroll
                for (int bj = 0; bj < 2; ++bj) { f32x4 g0, g1; unpack8(gb[m][bj], g0, g1);
                    *(u32x4*)(MG + (size_t)EPI_ROW(u, ai, m) * 1024 + u.pn * 256 + EPI_LCOL(bj)) = pack8(g0 * acc[ai][bj][m][0], g1 * acc[ai][bj][m][1]); }
            asm volatile("" ::: "memory"); }
    }
};
struct EpiRes {
    const float* xi; const bf16_t* xib; bf16_t* XBo; float* ssq;
    __device__ __forceinline__ void operator()(const AccT& acc, const pg8::Unit& u, int wr, int wc, int fr, int fq) const {
#pragma unroll
        for (int ai = 0; ai < 2; ++ai) { u32x4 rw[4][2];
#pragma unroll
            for (int m = 0; m < 4; ++m)
#pragma unroll
                for (int bj = 0; bj < 2; ++bj) rw[m][bj] = *(const u32x4*)(xib + (size_t)EPI_ROW(u, ai, m) * 1024 + u.pn * 256 + EPI_LCOL(bj));
#pragma unroll
            for (int m = 0; m < 4; ++m) { const int row = EPI_ROW(u, ai, m); float s = 0.f;
#pragma unroll
                for (int bj = 0; bj < 2; ++bj) { const size_t off = (size_t)row * 1024 + u.pn * 256 + EPI_LCOL(bj);
                    f32x4 r0, r1; unpack8(rw[m][bj], r0, r1);
                    const f32x4 v0 = r0 + acc[ai][bj][m][0], v1 = r1 + acc[ai][bj][m][1];
                    s += sq4(v0) + sq4(v1);
                    *(u32x4*)(XBo + off) = pack8(v0, v1); }
                row_atomic(ssq + row, s, fq); }
            asm volatile("" ::: "memory"); }
    }
};
struct EpiFfn {
    const float* ssq1; bf16_t* ACT;
    __device__ __forceinline__ void operator()(const AccT& acc, const pg8::Unit& u, int wr, int wc, int fr, int fq) const {
        const int hc = u.pn * 128 + wc * 32 + 8 * fq;
        EPI_ROWS(ai, m) { const int row = EPI_ROW(u, ai, m); const float rs = rstd_of(ssq1[row]);
            f32x4 g0 = acc[ai][0][m][0] * rs, g1 = acc[ai][0][m][1] * rs; const f32x4 u0 = acc[ai][1][m][0] * rs, u1 = acc[ai][1][m][1] * rs;
            g0 = g0 * sigm4(g0) * u0; g1 = g1 * sigm4(g1) * u1;
            *(u32x4*)(ACT + (size_t)row * FFN + hc) = pack8(g0, g1); }
    }
};
struct EpiPg {
    const float* ssq2; const float* ssqe; const float* b_pg; const float* g_ple; const bf16_t* ERAW; const bf16_t* X2B; float* ssq3; unsigned* cnt; const float* g_final; float* out;
    __device__ __forceinline__ void operator()(AccT& acc, const pg8::Unit& u, int wr, int wc, int fr, int fq) const {
#pragma unroll
        for (int ai = 0; ai < 2; ++ai)
#pragma unroll
        for (int mp = 0; mp < 2; ++mp) { u32x4 ew[2][2], xw[2][2];
#pragma unroll
            for (int mm = 0; mm < 2; ++mm)
#pragma unroll
                for (int bj = 0; bj < 2; ++bj) { const size_t off = (size_t)EPI_ROW(u, ai, mp * 2 + mm) * 1024 + u.pn * 256 + EPI_LCOL(bj); ew[mm][bj] = *(const u32x4*)(ERAW + off); xw[mm][bj] = *(const u32x4*)(X2B + off); }
#pragma unroll
            for (int mm = 0; mm < 2; ++mm) { const int m = mp * 2 + mm; const int row = EPI_ROW(u, ai, m); const float rs = rstd_of(ssq2[row]), re = rstd_of(ssqe[row]); float s = 0.f;
#pragma unroll
                for (int bj = 0; bj < 2; ++bj) { const int col = u.pn * 256 + EPI_LCOL(bj);
                    f32x4 e0, e1, x0, x1; unpack8(ew[mm][bj], e0, e1); unpack8(xw[mm][bj], x0, x1);
                    const f32x4 gt0 = sigm4(acc[ai][bj][m][0] * rs + *(const f32x4*)(b_pg + col)), gt1 = sigm4(acc[ai][bj][m][1] * rs + *(const f32x4*)(b_pg + col + 4));
                    const f32x4 v0 = x0 + gt0 * (e0 * re * *(const f32x4*)(g_ple + col)), v1 = x1 + gt1 * (e1 * re * *(const f32x4*)(g_ple + col + 4));
                    s += sq4(v0) + sq4(v1);
                    acc[ai][bj][m][0] = v0; acc[ai][bj][m][1] = v1; }
                s += __shfl_xor(s, 16); s += __shfl_xor(s, 32);
                if (fq == 0) { const float old = __hip_atomic_fetch_add(ssq3 + row, s, __ATOMIC_RELAXED, __HIP_MEMORY_SCOPE_AGENT); asm volatile("" :: "v"(old)); } }
            asm volatile("" ::: "memory"); }
        asm volatile("s_waitcnt vmcnt(0)" ::: "memory");
        unsigned* c = cnt + 64 * u.pm;
        if (__builtin_amdgcn_mbcnt_hi(~0u, __builtin_amdgcn_mbcnt_lo(~0u, 0u)) == 0u) (void)__hip_atomic_fetch_add(c, 1u, __ATOMIC_RELAXED, __HIP_MEMORY_SCOPE_AGENT);
        { unsigned spins = 0; while ((unsigned)__builtin_amdgcn_readfirstlane((int)__hip_atomic_load(c, __ATOMIC_RELAXED, __HIP_MEMORY_SCOPE_AGENT)) < 32u) { __builtin_amdgcn_s_sleep(2); if (++spins > (1u << 22)) break; } }
#pragma unroll
        for (int ai = 0; ai < 2; ++ai)
#pragma unroll
            for (int m = 0; m < 4; ++m) { const int row = EPI_ROW(u, ai, m); const float rs = rstd_of(__hip_atomic_load(ssq3 + row, __ATOMIC_RELAXED, __HIP_MEMORY_SCOPE_AGENT));
#pragma unroll
                for (int bj = 0; bj < 2; ++bj) { const int col = u.pn * 256 + EPI_LCOL(bj); float* o = out + (size_t)row * 1024 + col;
                    *(f32x4*)o = acc[ai][bj][m][0] * rs * *(const f32x4*)(g_final + col); *(f32x4*)(o + 4) = acc[ai][bj][m][1] * rs * *(const f32x4*)(g_final + col + 4); } }
    }
};

__device__ __forceinline__ void tr_item(const float* W, int K, int N, const float* gk, bf16_t* WT, int mode, LAS float* scr, int item, int lane, int ldd = 0, int koff = 0) {
    if (ldd == 0) ldd = K;
    const int nblk = N / 32, kb = item / nblk, nb = item % nblk, k0 = 64 * kb, n0 = 32 * nb;
    float tv[32];
#pragma unroll
    for (int i = 0; i < 32; ++i) { const int kk = 2 * i + (lane >> 5); tv[i] = __builtin_nontemporal_load(&W[(size_t)(k0 + kk) * N + n0 + (lane & 31)]); }
#pragma unroll
    for (int i = 0; i < 32; ++i) { const int kk = 2 * i + (lane >> 5); float v = tv[i]; if (gk) v *= gk[k0 + kk]; scr[kk * 33 + (lane & 31)] = v; }
    asm volatile("s_waitcnt lgkmcnt(0)" ::: "memory");
    const int c = lane & 7;
#pragma unroll
    for (int j = 0; j < 4; ++j) { const int n = (lane >> 3) + 8 * j; const LAS float* s = scr + (8 * c) * 33 + n;
        u32x4 o; o.x = cvt_pk_bf16(s[0 * 33], s[1 * 33]); o.y = cvt_pk_bf16(s[2 * 33], s[3 * 33]); o.z = cvt_pk_bf16(s[4 * 33], s[5 * 33]); o.w = cvt_pk_bf16(s[6 * 33], s[7 * 33]);
        const int nn = n0 + n; int drow;
        if (mode == 0) drow = nn; else if (mode == 3) { if (nn < 1536) drow = nn; else { const int gbs = nn >= 2560, c_ = nn - (gbs ? 2560 : 1536); drow = 1536 + 256 * (c_ >> 7) + gbs * 128 + (c_ & 127); } }
        else drow = 256 * (nn >> 7) + (mode - 1) * 128 + (nn & 127);
        *(u32x4*)(WT + (size_t)drow * ldd + koff + k0 + 8 * c) = o; }
    asm volatile("s_waitcnt lgkmcnt(0)" ::: "memory");
}

struct Args { const float* in[35]; float* out; unsigned char* ws; int ph_lo, ph_hi; };

template <class KA> __device__ __forceinline__ void s5_precompute(KA a, unsigned char* ws, LAS unsigned char* lds, int g, int part, int nparts, int tid) {
    const int tau_lo = part * (16 / nparts), tau_hi = tau_lo + 16 / nparts, row_lo = part * (256 / nparts), row_hi = row_lo + 256 / nparts;
    LAS float* PWr = (LAS float*)lds;
    LAS float* PWi = PWr + 17 * 64;
    LAS float* BBr = PWi + 17 * 64;
    LAS float* BBi = BBr + 1024;
    LAS float* Cr = BBi + 1024;
    LAS float* Ci = Cr + 1024;
    LAS float* Kt = Ci + 1024;
    const float* lam_re = a->in[5] + g * 64; const float* lam_im = a->in[6] + g * 64; const float dt = expf(a->in[7][g]);
    const float* b_re = a->in[8] + g * 1024; const float* b_im = a->in[9] + g * 1024; const float* c_re = a->in[10] + g * 1024; const float* c_im = a->in[11] + g * 1024;
    const float* dsk = a->in[12] + g * 16;
    for (int e = tid; e < 17 * 64; e += 512) { const int k = e >> 6, n = e & 63; const float lr = lam_re[n], li = lam_im[n];
        const float mag = expf((float)k * lr * dt); float s, c; sincosf((float)k * (li * dt), &s, &c); PWr[e] = mag * c; PWi[e] = mag * s; }
    for (int e = tid; e < 1024; e += 512) { const int n = e >> 4; const float lr = lam_re[n], li = lam_im[n];
        const float mag = expf(lr * dt); float s, c; sincosf(li * dt, &s, &c); const float ar = mag * c, ai = mag * s, den = lr * lr + li * li, nr = ar - 1.0f;
        const float fr = (nr * lr + ai * li) / den, fi = (ai * lr - nr * li) / den; const float br = b_re[e], bi = b_im[e];
        BBr[e] = fr * br - fi * bi; BBi[e] = fr * bi + fi * br; Cr[e] = c_re[e]; Ci[e] = c_im[e]; }
    __syncthreads();
    for (int e = tau_lo * 256 + tid; e < tau_hi * 256; e += 512) { const int tau = e >> 8, p = (e >> 4) & 15, q = e & 15; float s = 0.f;
        for (int n = 0; n < 64; ++n) { const float pr = PWr[tau * 64 + n], pi = PWi[tau * 64 + n], br = BBr[n * 16 + q], bi = BBi[n * 16 + q];
            const float wr_ = pr * br - pi * bi, wi_ = pr * bi + pi * br; s += Cr[p * 64 + n] * wr_ - Ci[p * 64 + n] * wi_; }
        if (tau == 0 && p == q) s += dsk[p];
        Kt[e] = s; }
    __syncthreads();
    bf16_t* PMg = (bf16_t*)(ws + WS_PM) + (size_t)g * 256 * 256;
    bf16_t* TQg = (bf16_t*)(ws + WS_TQ) + (size_t)g * 256 * 384;
    for (int e = tid; e < 256 * 32; e += 512) { const int row = e >> 5, cgp = e & 31, t = row >> 4, p = row & 15, s = cgp >> 1, q0 = (cgp & 1) * 8;
        f32x4 v0 = {0.f, 0.f, 0.f, 0.f}, v1 = v0;
        if (s <= t ? (t - s < tau_lo || t - s >= tau_hi) : (part != 0)) continue;
        if (s <= t) { const LAS float* kp = Kt + (t - s) * 256 + p * 16 + q0; v0 = (f32x4){kp[0], kp[1], kp[2], kp[3]}; v1 = (f32x4){kp[4], kp[5], kp[6], kp[7]}; }
        *(u32x4*)(TQg + (size_t)row * 384 + s * 16 + q0) = pack8(v0, v1); }
    for (int e = row_lo * 16 + tid; e < row_hi * 16; e += 512) { const int row = e >> 4, cgp = e & 15, t = row >> 4, p = row & 15, half = cgp >> 3, n0 = (cgp & 7) * 8;
        float v[8];
#pragma unroll
        for (int j = 0; j < 8; ++j) { const int n = n0 + j; const float cr = Cr[p * 64 + n], ci = Ci[p * 64 + n], pr = PWr[(t + 1) * 64 + n], pi = PWi[(t + 1) * 64 + n];
            v[j] = half == 0 ? (cr * pr - ci * pi) : -(cr * pi + ci * pr); }
        *(u32x4*)(TQg + (size_t)row * 384 + 256 + half * 64 + n0) = pack8((f32x4){v[0], v[1], v[2], v[3]}, (f32x4){v[4], v[5], v[6], v[7]}); }
    for (int e = row_lo * 32 + tid; e < row_hi * 32; e += 512) { const int row = e >> 5, cgp = e & 31, s = cgp >> 1, q0 = (cgp & 1) * 8;
        float v[8];
#pragma unroll
        for (int j = 0; j < 8; ++j) v[j] = 0.f;
        if (row < 128) { const int n = row & 63, im = row >> 6; const float pr = PWr[(15 - s) * 64 + n], pi = PWi[(15 - s) * 64 + n];
#pragma unroll
            for (int j = 0; j < 8; ++j) { const float br = BBr[n * 16 + q0 + j], bi = BBi[n * 16 + q0 + j]; v[j] = im == 0 ? (pr * br - pi * bi) : (pr * bi + pi * br); } }
        *(u32x4*)(PMg + (size_t)row * 256 + s * 16 + q0) = pack8((f32x4){v[0], v[1], v[2], v[3]}, (f32x4){v[4], v[5], v[6], v[7]}); }
    __syncthreads();
}

__device__ __forceinline__ bf16x8 pack8s(const float (&t)[8]) { u32x4 w; w.x = cvt_pk_bf16(t[0], t[1]); w.y = cvt_pk_bf16(t[2], t[3]); w.z = cvt_pk_bf16(t[4], t[5]); w.w = cvt_pk_bf16(t[6], t[7]); return __builtin_bit_cast(bf16x8, w); }
__device__ __forceinline__ void wg_publish(bool leader) {
    asm volatile("s_waitcnt vmcnt(0)" ::: "memory"); __syncthreads();
    if (leader) { __builtin_amdgcn_fence(__ATOMIC_ACQUIRE, "agent"); asm volatile("s_waitcnt vmcnt(0)" ::: "memory"); }
    __syncthreads();
}

template <class KA>
__device__ __forceinline__ void lru_fused_unit(KA ap, unsigned char* ws, const bf16_t* UBg, LAS unsigned char* lds, int unit, int wave) {
    int lane = (int)__builtin_amdgcn_mbcnt_hi(~0u, __builtin_amdgcn_mbcnt_lo(~0u, 0u)); asm volatile("" : "+v"(lane));
    const int b = unit >> 4, h = unit & 15, ch0 = h * 64;
    const int r = lane & 15, q = lane >> 4;
    LAS float* xb = (LAS float*)(lds + wave * 10368);
    LAS float* aL = xb + 16 * 65;
    LAS bf16_t* hL = (LAS bf16_t*)(aL + 16 * 65);
    LAS float* agg = (LAS float*)(lds + 83968);
    LAS float* cwL = (LAS float*)(lds + 92160); LAS float* cbL = cwL + 256;
    LAS u32x4* BtL = (LAS u32x4*)(lds + 93696);
    LAS u32x4* IdL = (LAS u32x4*)(lds + 110080);
    const bf16_t* UBp = UBg + (size_t)b * 2048 * 1024 + ch0 + 8 * q;
    bf16_t* YBp = (bf16_t*)(ws + WS_YAB) + (size_t)b * 2048 * 1536 + 512 + ch0;
    u32x4 raw[2][4], rawn[2][4];
#define LRU_LOAD(dst, blk_) do { const int l0_ = (blk_) * 128 + wave * 16 + r - 3; _Pragma("unroll") for (int ks = 0; ks < 2; ++ks) _Pragma("unroll") for (int tp = 0; tp < 4; ++tp) { \
        const int l_ = l0_ + tp; dst[ks][tp] = (l_ >= 0) ? *(const u32x4*)(UBp + (size_t)(l_ < 0 ? 0 : l_) * 1024 + 32 * ks) : (u32x4){0u, 0u, 0u, 0u}; } } while (0)
    LRU_LOAD(raw, 0);
    { const int t_ = wave * 64 + lane; if (t_ < 256) cwL[t_] = ap->in[15][(t_ >> 6) * 1024 + ch0 + (t_ & 63)]; else if (t_ < 320) cbL[t_ - 256] = ap->in[16][ch0 + (t_ - 256)];
#pragma unroll
      for (int e2 = 0; e2 < 2; ++e2) { const int e = t_ + 512 * e2, c = e >> 7, ks = (e >> 6) & 1, ln = e & 63, rr = ln & 15, qq = ln >> 4;
          const float* w = ((c < 4) ? ap->in[17] : ap->in[19]) + h * 4096 + (c & 3) * 16 + rr; float t[8];
#pragma unroll
          for (int j = 0; j < 8; ++j) t[j] = w[(32 * ks + 8 * qq + j) * 64];
          BtL[e] = __builtin_bit_cast(u32x4, pack8s(t)); }
      { const int c = t_ >> 7, ks = (t_ >> 6) & 1, ln = t_ & 63, rr = ln & 15, qq = ln >> 4; float t[8];
#pragma unroll
        for (int j = 0; j < 8; ++j) t[j] = (32 * ks + 8 * qq + j == 16 * c + rr) ? 1.0f : 0.0f;
        IdL[t_] = __builtin_bit_cast(u32x4, pack8s(t)); } }
    float brc[4], bic[4], spc[4];
#pragma unroll
    for (int c = 0; c < 4; ++c) { const int ch = ch0 + c * 16 + r; const float L2E = 1.4426950408889634f; brc[c] = -L2E * ap->in[18][ch]; bic[c] = -L2E * ap->in[20][ch]; spc[c] = -8.0f * L2E * ((const float*)(ws + OFF_SP))[ch]; }
    __syncthreads();
    bf16x8 Bg[4][2];
#pragma unroll
    for (int c = 0; c < 4; ++c)
#pragma unroll
        for (int ks = 0; ks < 2; ++ks) Bg[c][ks] = __builtin_bit_cast(bf16x8, BtL[(c * 2 + ks) * 64 + lane]);
    float hprev = 0.f;
    for (int blk = 0; blk < 16; ++blk) {
        if (blk + 1 < 16) LRU_LOAD(rawn, blk + 1);
        bf16x8 Af[2];
#pragma unroll
        for (int ks = 0; ks < 2; ++ks) { const int cc = 32 * ks + 8 * q; f32x4 a0 = *(const LAS f32x4*)(cbL + cc), a1 = *(const LAS f32x4*)(cbL + cc + 4);
#pragma unroll
            for (int tp = 0; tp < 4; ++tp) { f32x4 u0, u1; unpack8(raw[ks][tp], u0, u1); a0 += u0 * *(const LAS f32x4*)(cwL + tp * 64 + cc); a1 += u1 * *(const LAS f32x4*)(cwL + tp * 64 + cc + 4); }
            Af[ks] = __builtin_bit_cast(bf16x8, pack8(a0, a1));
}
#pragma unroll
        for (int c = 0; c < 4; ++c) {
            f32x4 Dr = __builtin_amdgcn_mfma_f32_16x16x32_bf16(Af[0], Bg[c][0], (f32x4){0.f, 0.f, 0.f, 0.f}, 0, 0, 0);
            Dr = __builtin_amdgcn_mfma_f32_16x16x32_bf16(Af[1], Bg[c][1], Dr, 0, 0, 0);
            f32x4 Di = __builtin_amdgcn_mfma_f32_16x16x32_bf16(Af[0], __builtin_bit_cast(bf16x8, BtL[((c + 4) * 2 + 0) * 64 + lane]), (f32x4){0.f, 0.f, 0.f, 0.f}, 0, 0, 0);
            Di = __builtin_amdgcn_mfma_f32_16x16x32_bf16(Af[1], __builtin_bit_cast(bf16x8, BtL[((c + 4) * 2 + 1) * 64 + lane]), Di, 0, 0, 0);
            f32x4 Dx = __builtin_amdgcn_mfma_f32_16x16x32_bf16(Af[0], __builtin_bit_cast(bf16x8, IdL[(c * 2 + 0) * 64 + lane]), (f32x4){0.f, 0.f, 0.f, 0.f}, 0, 0, 0);
            Dx = __builtin_amdgcn_mfma_f32_16x16x32_bf16(Af[1], __builtin_bit_cast(bf16x8, IdL[(c * 2 + 1) * 64 + lane]), Dx, 0, 0, 0);
#pragma unroll
            for (int i = 0; i < 4; ++i) { const int o = (4 * q + i) * 65 + c * 16 + r;
                const float rg = __builtin_amdgcn_rcpf(1.0f + __builtin_amdgcn_exp2f(__builtin_fmaf(Dr[i], -1.4426950408889634f, brc[c]))), ig = __builtin_amdgcn_rcpf(1.0f + __builtin_amdgcn_exp2f(__builtin_fmaf(Di[i], -1.4426950408889634f, bic[c])));
                const float a = __builtin_amdgcn_exp2f(rg * spc[c]); const float xv = Dx[i];
                aL[o] = a; xb[o] = __builtin_amdgcn_sqrtf(fmaxf(1.0f - a * a, 0.f)) * ig * xv; } }
        LAS float* ag = agg + (blk & 1) * 1024;
        float av[16], bv[16];
        {
#pragma unroll
          for (int tt = 0; tt < 16; ++tt) { av[tt] = aL[tt * 65 + lane]; bv[tt] = xb[tt * 65 + lane]; }
          float P = 1.f, H = 0.f;
#pragma unroll
          for (int tt = 0; tt < 16; ++tt) { H = av[tt] * H + bv[tt]; P *= av[tt]; }
          ag[(wave * 64 + lane) * 2] = P; ag[(wave * 64 + lane) * 2 + 1] = H; }
        __syncthreads();
        { float c = hprev, cin = 0.f;
#pragma unroll
          for (int ww = 0; ww < 8; ++ww) { if (ww == wave) cin = c; c = ag[(ww * 64 + lane) * 2] * c + ag[(ww * 64 + lane) * 2 + 1]; }
          hprev = c;
          float hh = cin;
#pragma unroll
          for (int tt = 0; tt < 16; ++tt) { hh = av[tt] * hh + bv[tt]; hL[tt * 64 + lane] = (bf16_t)(cvt_pk_bf16(hh, 0.f) & 0xffffu); } }
        { const int tt = lane >> 2, g16 = lane & 3; const LAS u32x4* hp = (const LAS u32x4*)(hL + tt * 64 + 16 * g16); const u32x4 h0 = hp[0], h1 = hp[1];
          u32x4* yo = (u32x4*)(YBp + (size_t)(blk * 128 + wave * 16 + tt) * 1536 + 16 * g16); yo[0] = h0; yo[1] = h1; }
#pragma unroll
        for (int ks = 0; ks < 2; ++ks)
#pragma unroll
            for (int tp = 0; tp < 4; ++tp) raw[ks][tp] = rawn[ks][tp];
    }
#undef LRU_LOAD
    __syncthreads();
}

__global__ void __launch_bounds__(512, 2) fwd_kernel(Args args) {
    extern __shared__ __attribute__((aligned(16))) unsigned char lds_raw[];
    LAS unsigned char* lds = (LAS unsigned char*)lds_raw;
    const int G = gridDim.x, bid = blockIdx.x, NT = G * 512, NGW = G * 8;
    const int wave_s = __builtin_amdgcn_readfirstlane((int)threadIdx.x >> 6);
    const int lo = args.ph_lo, hi = args.ph_hi;
    if (hi < 0) cg::this_grid().sync();
    unsigned n_bar = 0; (void)n_bar;
    const unsigned xcc = xb_xcc_id();
    if (hi - lo > 1) {
        if (wave_s == 0 && __builtin_amdgcn_mbcnt_hi(~0u, __builtin_amdgcn_mbcnt_lo(~0u, 0u)) == 0u) { ((volatile LAS unsigned*)(lds + 131072 + 64))[0] = 0u; ((volatile LAS unsigned*)(lds + 131072 + 64))[1] = 0u;
            (void)xb_add((unsigned*)(args.ws + OFF_BAR) + XB_XCNT(xcc), 1u); }
        __syncthreads();
    }
#ifndef PROBE_PH
#define PROBE_PH (-1)
#endif
#ifndef PROBE_MULT
#define PROBE_MULT 4
#endif
    unsigned long long pr_t0 = 0, pr_dt = 0; (void)pr_t0; (void)pr_dt;
#define PROBE_A(k) do { if (PROBE_PH == (k)) pr_t0 = __builtin_amdgcn_s_memrealtime(); } while (0)
#define PROBE_B(k) do { if (PROBE_PH == (k)) pr_dt = __builtin_amdgcn_s_memrealtime() - pr_t0; } while (0)
#ifndef PHMASK
#define PHMASK 0xFFF
#endif
#define IN(k) (((PHMASK >> (k)) & 1) && lo <= (k) && (k) < hi)
#define LEADER (wave_s == 0 && __builtin_amdgcn_mbcnt_hi(~0u, __builtin_amdgcn_mbcnt_lo(~0u, 0u)) == 0u)
#define SEAM(k) do { if (IN(k) && (IN((k) + 1) || ((k) == 2 && IN(5)))) { xcd_barrier((unsigned*)(kap->ws + OFF_BAR), xcc, (volatile LAS unsigned*)(lds + 131072 + 64), (unsigned)G, LEADER); } } while (0)
    typedef const __attribute__((address_space(4))) Args* KArgs;
    const KArgs kap = (KArgs)__builtin_amdgcn_kernarg_segment_ptr();
#define PH_BEGIN KArgs ap = kap; asm volatile("" : "+s"(ap)); unsigned char* const ws = ap->ws; float* const OUT = ap->out; (void)ws; (void)OUT; \
    int lane = (int)__builtin_amdgcn_mbcnt_hi(~0u, __builtin_amdgcn_mbcnt_lo(~0u, 0u)); asm volatile("" : "+v"(lane)); const int wave = wave_s, tid = wave * 64 + lane, gtid = bid * 512 + tid, gw = bid * 8 + wave; (void)gtid; (void)gw;
#define AIN(k) (ap->in[k])
#define WSP(T, off) ((T*)(ws + (off)))
    PROBE_A(0);
    if (IN(0)) {
        PH_BEGIN
        const bool g256 = (G == 256);
        if (g256) { if (bid < 128) s5_precompute(ap, ws, lds, bid >> 2, bid & 3, 4, tid); }
        else if (bid < 32) s5_precompute(ap, ws, lds, bid, 0, 1, tid);
        {
            const int npair = g256 ? 1024 : NGW, pr = g256 ? (gw & 1023) : gw, k_lo = g256 ? ((gw >> 10) ? 3 : 0) : 0, k_hi = g256 ? ((gw >> 10) ? 8 : 3) : (M / 2 + npair - 1) / npair;
            for (int k = k_lo; k < k_hi; ++k) { const int m = 2 * (pr + npair * k); if (m >= M) break;
                const f32x4* xr = (const f32x4*)(AIN(0) + (size_t)m * 1024) + lane; f32x4 v[8]; float s0 = 0.f, s1 = 0.f;
#pragma unroll
                for (int j = 0; j < 8; ++j) v[j] = __builtin_nontemporal_load(&xr[64 * j]);
#pragma unroll
                for (int j = 0; j < 4; ++j) { s0 += sq4(v[j]); s1 += sq4(v[4 + j]); }
                s0 = wave_sum(s0); s1 = wave_sum(s1); if (lane == 0) { WSP(float, OFF_SSQ0)[m] = s0; WSP(float, OFF_SSQ0)[m + 1] = s1; }
                u32x2* o = (u32x2*)((bf16_t*)OUT + (size_t)M * 1024   + (size_t)m * 1024) + lane;
#pragma unroll
                for (int j = 0; j < 8; ++j) { u32x2 w; w.x = cvt_pk_bf16(v[j][0], v[j][1]); w.y = cvt_pk_bf16(v[j][2], v[j][3]); o[64 * j] = w; } }
            LAS float* scr = (LAS float*)(lds + wave * 16384);
            const int wq = g256 ? gw - 1024 : gw, nW = g256 ? 1024 : NGW;
            if (wq >= 0) for (int it = wq; it < 16 * 112; it += nW) tr_item(AIN(3), 1024, INC, AIN(2), WSP(bf16_t, WS_WIN), 3, scr, it, lane);
        }
        for (int e = gtid; e < 1024; e += NT) WSP(float, OFF_SP)[e] = log1pf(expf(-AIN(21)[e]));
        for (int e = gtid; e < M; e += NT) { WSP(float, OFF_SSQ1)[e] = 0.f; WSP(float, OFF_SSQ2)[e] = 0.f; WSP(float, OFF_SSQ3)[e] = 0.f; WSP(float, OFF_SSQE)[e] = 0.f; }
    }
    SEAM(0);
    PROBE_B(0);
    PROBE_A(1);
    if (IN(1)) {
        PH_BEGIN
        pg8::Gemm g{(const bf16_t*)OUT + (size_t)M * 1024  , WSP(bf16_t, WS_WIN), 1024, 1024, 1024}; pg8::Sched S; S.init(64, 12, G, bid, (size_t)256 * 1024 * 2, 0, (size_t)256 * 1024 * 2, 0);
        EpiIn E{WSP(float, OFF_SSQ0), AIN(4), WSP(bf16_t, WS_UAS), (bf16_t*)OUT  , WSP(bf16_t, WS_GA), WSP(bf16_t, WS_GB), 0};
        pg8::gemm_phase(lds, g, S, E, tid);
    }
    SEAM(1);
    PROBE_B(1);
    PROBE_A(2);
    if (IN(2)) {
        PH_BEGIN
        if (PROBE_PH == 20) pr_t0 = __builtin_amdgcn_s_memrealtime();
        const int nL = (G >= 2) ? G / 2 : 1, nS = (G >= 2) ? G - nL : 1; const bool isL = (G < 2) || bid < nL, isS = (G < 2) || bid >= nL;
        if (isL) for (int unit = (G < 2) ? 0 : bid; unit < 128; unit += nL) lru_fused_unit(ap, ws, (const bf16_t*)OUT, lds, unit, wave);
        if (PROBE_PH == 20) pr_dt = __builtin_amdgcn_s_memrealtime() - pr_t0;
        if (PROBE_PH == 21) pr_t0 = __builtin_amdgcn_s_memrealtime();
        if (isS) for (int su = (G < 2) ? 0 : bid - nL; su < 128; su += nS) {
            const int g = su >> 2;
            int k256 = 256, k384 = 384; asm volatile("" : "+s"(k256), "+s"(k384));
            { pg8::Gemm gm{WSP(bf16_t, WS_UAS), WSP(bf16_t, WS_PM), 384, 256, k256}; pg8::OneUnit S{su, 0, (size_t)su * 256 * 384 * 2, (size_t)g * 256 * 256 * 2};
              EpiS5a E{WSP(float, WS_E)}; int lane1 = (int)__builtin_amdgcn_mbcnt_hi(~0u, __builtin_amdgcn_mbcnt_lo(~0u, 0u)); asm volatile("" : "+v"(lane1)); pg8::gemm_phase(lds, gm, S, E, wave * 64 + lane1); }
            int lane2 = (int)__builtin_amdgcn_mbcnt_hi(~0u, __builtin_amdgcn_mbcnt_lo(~0u, 0u)); asm volatile("" : "+v"(lane2));
            wg_publish(wave == 0 && lane2 == 0);
            for (int bb = 0; bb < 2; ++bb) { const int b = (su & 3) * 2 + bb, n = lane2;
                const float lr = AIN(5)[g * 64 + n], li = AIN(6)[g * 64 + n], dt = expf(AIN(7)[g]);
                const float mag = expf(16.0f * lr * dt); float sn, cs; sincosf(16.0f * (li * dt), &sn, &cs); const float ar = mag * cs, ai = mag * sn;
                const size_t row0 = (size_t)g * 1024 + b * 128 + wave * 16;
                float er[16], ei[16], lr_[16], li_[16];
#pragma unroll
                for (int j = 0; j < 16; ++j) { er[j] = WSP(float, WS_E)[(row0 + j) * 128 + n]; ei[j] = WSP(float, WS_E)[(row0 + j) * 128 + 64 + n]; }
                float sr = 0.f, si = 0.f;
#pragma unroll
                for (int j = 0; j < 16; ++j) { lr_[j] = sr; li_[j] = si; const float nr_ = ar * sr - ai * si + er[j], ni_ = ar * si + ai * sr + ei[j]; sr = nr_; si = ni_; }
                LAS float* segr = (LAS float*)lds; LAS float* segi = segr + 512;
                segr[wave * 64 + n] = sr; segi[wave * 64 + n] = si;
                float br = ar, bi = ai;
#pragma unroll
                for (int q = 0; q < 4; ++q) { const float t_ = br * br - bi * bi; bi = 2.0f * br * bi; br = t_; }
                __syncthreads();
                float cr = 0.f, ci = 0.f;
                for (int ww = 0; ww < wave; ++ww) { const float xr_ = segr[ww * 64 + n], xi_ = segi[ww * 64 + n]; const float t_ = br * cr - bi * ci + xr_; ci = br * ci + bi * cr + xi_; cr = t_; }
                float pr = 1.f, pi = 0.f;
#pragma unroll
                for (int j = 0; j < 16; ++j) { const float orr = lr_[j] + pr * cr - pi * ci, oii = li_[j] + pr * ci + pi * cr;
                    bf16_t* d = WSP(bf16_t, WS_UAS) + (row0 + j) * 384 + 256 + n; d[0] = (bf16_t)(cvt_pk_bf16(orr, 0.f) & 0xffffu); d[64] = (bf16_t)(cvt_pk_bf16(oii, 0.f) & 0xffffu);
                    const float t_ = pr * ar - pi * ai; pi = pr * ai + pi * ar; pr = t_; }
                __syncthreads();
            }
            wg_publish(wave == 0 && lane2 == 0);
            { pg8::Gemm gm{WSP(bf16_t, WS_UAS), WSP(bf16_t, WS_TQ), 384, 384, k384}; pg8::OneUnit S{su, 0, (size_t)su * 256 * 384 * 2, (size_t)g * 256 * 384 * 2};
              EpiS5b E{WSP(bf16_t, WS_ZG)}; pg8::gemm_phase(lds, gm, S, E, wave * 64 + lane2); }
        }
        if (isS) {
            int lane3 = (int)__builtin_amdgcn_mbcnt_hi(~0u, __builtin_amdgcn_mbcnt_lo(~0u, 0u)); asm volatile("" : "+v"(lane3));
            const int wq = ((G < 2) ? 0 : bid - nL) * 8 + wave, nW = nS * 8;
            LAS float* scr = (LAS float*)(lds + wave * 16384);
            constexpr int I_GLU = 8 * 16, I_A = 8 * 32, I_B = 16 * 32, I_O = 16 * 32, I_G = 16 * 88, I_U = 16 * 88, I_D = 44 * 32, I_PG = 16 * 32, I_PLE = 4 * 32;
            constexpr int NITEMS = I_GLU + I_A + I_B + I_O + I_D + I_PG + I_PLE; (void)I_G; (void)I_U;
            for (int it = wq; it < NITEMS; it += nW) {
                int r = it;
                if (r < I_GLU) { tr_item(AIN(13), 512, 512, nullptr, WSP(bf16_t, WS_WGLU), 0, scr, r, lane3); continue; } r -= I_GLU;
                if (r < I_A) { tr_item(AIN(22), 512, 1024, nullptr, WSP(bf16_t, WS_WA), 0, scr, r, lane3, 1536, 0); continue; } r -= I_A;
                if (r < I_B) { tr_item(AIN(23), 1024, 1024, nullptr, WSP(bf16_t, WS_WA), 0, scr, r, lane3, 1536, 512); continue; } r -= I_B;
                if (r < I_O) { tr_item(AIN(24), 1024, 1024, nullptr, WSP(bf16_t, WS_WO), 0, scr, r, lane3); continue; } r -= I_O;
                if (r < I_D) { tr_item(AIN(28), FFN, 1024, nullptr, WSP(bf16_t, WS_WD), 0, scr, r, lane3); continue; } r -= I_D;
                if (r < I_PG) { tr_item(AIN(30), 1024, 1024, AIN(29), WSP(bf16_t, WS_WPG), 0, scr, r, lane3); continue; } r -= I_PG;
                tr_item(AIN(32), 256, 1024, nullptr, WSP(bf16_t, WS_WPLE), 0, scr, r, lane3);
            }
            const int tq = ((G < 2) ? 0 : bid - nL) * 512 + wave * 64 + lane3, nT = nS * 512;
            for (int e = tq * 4; e < M * PLE / 8; e += nT * 4) { const f32x4* pp = (const f32x4*)(AIN(1)) + (size_t)e * 2; f32x4 v[8];
#pragma unroll
                for (int j = 0; j < 8; ++j) v[j] = __builtin_nontemporal_load(&pp[j]);
                u32x4* o = (u32x4*)(WSP(bf16_t, WS_PB) + (size_t)e * 8);
#pragma unroll
                for (int j = 0; j < 4; ++j) o[j] = pack8(v[2 * j], v[2 * j + 1]); }
        }
    }
    if (PROBE_PH == 21) pr_dt = __builtin_amdgcn_s_memrealtime() - pr_t0;
    SEAM(2);
    PROBE_B(2);
    PROBE_A(5);
    if (IN(5)) {
        PH_BEGIN
        pg8::Gemm g{WSP(bf16_t, WS_ZG), WSP(bf16_t, WS_WGLU), 512, 512, 512}; pg8::Sched S; S.init(64, 2, G, bid, (size_t)256 * 512 * 2, 0, (size_t)256 * 512 * 2, 0);
        EpiGlu E{WSP(bf16_t, WS_ZG), AIN(14), WSP(bf16_t, WS_YAB)};
        pg8::gemm_phase(lds, g, S, E, tid);
        {
            int lane5 = (int)__builtin_amdgcn_mbcnt_hi(~0u, __builtin_amdgcn_mbcnt_lo(~0u, 0u)); asm volatile("" : "+v"(lane5));
            pg8::Gemm g2{(const bf16_t*)OUT + (size_t)M * 1024  , WSP(bf16_t, WS_WIN) + (size_t)12 * 256 * 1024, 1024, 1024, 1024};
            pg8::Sched S2; S2.init(64, 2, G, (bid + G - G / 2) % G, (size_t)256 * 1024 * 2, 0, (size_t)256 * 1024 * 2, 0);
            EpiIn E2{WSP(float, OFF_SSQ0), AIN(4), WSP(bf16_t, WS_UAS), (bf16_t*)OUT, WSP(bf16_t, WS_GA), WSP(bf16_t, WS_GB), 12};
            pg8::gemm_phase(lds, g2, S2, E2, wave * 64 + lane5);
        }
        {
            const int nLo = (G >= 2) ? G / 2 : 1;
            if (bid < nLo) { int lane6 = (int)__builtin_amdgcn_mbcnt_hi(~0u, __builtin_amdgcn_mbcnt_lo(~0u, 0u)); asm volatile("" : "+v"(lane6));
                LAS float* scr = (LAS float*)(lds + wave * 16384);
                for (int it = bid * 8 + wave; it < 2 * 16 * 88; it += nLo * 8) {
                    if (it < 16 * 88) tr_item(AIN(26), 1024, FFN, AIN(25), WSP(bf16_t, WS_WGU), 1, scr, it, lane6);
                    else tr_item(AIN(27), 1024, FFN, AIN(25), WSP(bf16_t, WS_WGU), 2, scr, it - 16 * 88, lane6); } }
        }
    }
    SEAM(5);
    PROBE_B(5);
    PROBE_A(6);
    if (IN(6)) {
        PH_BEGIN
        pg8::Gemm g{WSP(bf16_t, WS_YAB), WSP(bf16_t, WS_WA), 1536, 1536, 1536}; pg8::Sched S; S.init(64, 4, G, bid, (size_t)256 * 1536 * 2, 0, (size_t)256 * 1536 * 2, 0);
        EpiMg E{WSP(bf16_t, WS_GB), WSP(bf16_t, WS_MG)}; MidGate Mh{8, WSP(bf16_t, WS_GA)  };
        pg8::gemm_phase<EpiMg, pg8::Sched, MidGate, false>(lds, g, S, E, tid, Mh);
    }
    SEAM(6);
    PROBE_B(6);
    PROBE_A(7);
    if (IN(7)) {
        PH_BEGIN
        pg8::Gemm g{WSP(bf16_t, WS_MG), WSP(bf16_t, WS_WO), 1024, 1024, 1024}; pg8::Sched S; S.init(64, 4, G, bid, (size_t)256 * 1024 * 2, 0, (size_t)256 * 1024 * 2, 0);
        EpiRes E{nullptr, (const bf16_t*)OUT + (size_t)M * 1024  , WSP(bf16_t, WS_XB)  , WSP(float, OFF_SSQ1)};
        pg8::gemm_phase<EpiRes, pg8::Sched, pg8::NoMid, false>(lds, g, S, E, tid);
    }
    SEAM(7);
    PROBE_B(7);
    PROBE_A(8);
    if (IN(8)) {
        PH_BEGIN
        pg8::Gemm g{WSP(bf16_t, WS_XB)  , WSP(bf16_t, WS_WGU), 1024, 1024, 1024}; pg8::Sched S; S.init(64, 22, G, bid, (size_t)256 * 1024 * 2, 0, (size_t)256 * 1024 * 2, 0);
        EpiFfn E{WSP(float, OFF_SSQ1), WSP(bf16_t, WS_ACT)};
        pg8::gemm_phase(lds, g, S, E, tid);
        {
            const int b0 = (G >= 2) ? G / 2 : 0, nB = G - b0;
            if (bid >= b0) { int lane4 = (int)__builtin_amdgcn_mbcnt_hi(~0u, __builtin_amdgcn_mbcnt_lo(~0u, 0u)); asm volatile("" : "+v"(lane4));
                pg8::Gemm g2{WSP(bf16_t, WS_PB), WSP(bf16_t, WS_WPLE), 256, 256, 256}; pg8::Sched S2; S2.init(64, 4, nB, bid - b0, (size_t)256 * 256 * 2, 0, (size_t)256 * 256 * 2, 0);
                EpiEraw E2{WSP(bf16_t, WS_GA), WSP(float, OFF_SSQE)}; pg8::gemm_phase(lds, g2, S2, E2, wave * 64 + lane4); }
        }
    }
    SEAM(8);
    PROBE_B(8);
    PROBE_A(9);
    if (IN(9)) {
        PH_BEGIN
        { pg8::Gemm g{WSP(bf16_t, WS_ACT), WSP(bf16_t, WS_WD), FFN, FFN, FFN}; pg8::Sched S; S.init(64, 4, G, bid, (size_t)256 * FFN * 2, 0, (size_t)256 * FFN * 2, 0);
          EpiRes E{nullptr, WSP(bf16_t, WS_XB)  , WSP(bf16_t, WS_XB)  , WSP(float, OFF_SSQ2)}; pg8::gemm_phase<EpiRes, pg8::Sched, pg8::NoMid, false>(lds, g, S, E, tid); }
    }
    SEAM(9);
    PROBE_B(9);
    PROBE_A(10);
    if (IN(10)) {
        PH_BEGIN
        int kq = 1024; asm volatile("" : "+s"(kq));
        pg8::Gemm g{WSP(bf16_t, WS_XB)  , WSP(bf16_t, WS_WPG), 1024, 1024, kq}; pg8::Sched S; S.init(64, 4, G, bid, (size_t)256 * 1024 * 2, 0, (size_t)256 * 1024 * 2, 0);
        EpiPg E{WSP(float, OFF_SSQ2), WSP(float, OFF_SSQE), AIN(31), AIN(33), WSP(bf16_t, WS_GA)  , WSP(bf16_t, WS_XB)  , WSP(float, OFF_SSQ3), (unsigned*)(ws + OFF_BAR + 16384), AIN(34), OUT};
        pg8::gemm_phase<EpiPg, pg8::Sched, pg8::NoMid, false>(lds, g, S, E, tid);
    }
    PROBE_B(10);
    if (PROBE_PH == 11) pr_dt = __builtin_amdgcn_s_memrealtime() - pr_t0;
    if (PROBE_PH == 12) { for (int i = 0; i < 16; ++i) xcd_barrier((unsigned*)(kap->ws + OFF_BAR), xcc, (volatile LAS unsigned*)(lds + 131072 + 64), (unsigned)G, LEADER); }
    if (PROBE_PH >= 0 && PROBE_PH != 12) { const unsigned long long t1 = __builtin_amdgcn_s_memrealtime(); while (__builtin_amdgcn_s_memrealtime() - t1 < (unsigned long long)PROBE_MULT * pr_dt) __builtin_amdgcn_s_sleep(8); }
#undef IN
#undef SEAM
}

constexpr int LDS_BYTES = 147456;
extern "C" void kernel_launch(void* const* d_in, const int* in_sizes, int n_in, void* d_out, int out_size, void* d_ws, size_t ws_size, hipStream_t stream) {
    static int grid = 0;
    if (grid == 0) {
        int dev = 0, cus = 0, per_cu = 0;
        hipGetDevice(&dev); hipDeviceGetAttribute(&cus, hipDeviceAttributeMultiprocessorCount, dev);
        if (hipFuncSetAttribute((const void*)fwd_kernel, hipFuncAttributeMaxDynamicSharedMemorySize, LDS_BYTES) != hipSuccess) { fprintf(stderr, "kernel_launch: hipFuncSetAttribute failed\n"); grid = -1; return; }
        if (hipOccupancyMaxActiveBlocksPerMultiprocessor(&per_cu, (const void*)fwd_kernel, 512, LDS_BYTES) != hipSuccess || per_cu < 1) { fprintf(stderr, "kernel_launch: occupancy query says %d\n", per_cu); per_cu = 1; }
        (void)hipGetLastError();
        if (cus <= 0) cus = 256;
        grid = cus * per_cu;
        if (n_in != 35 || ws_size < WS_END) { fprintf(stderr, "kernel_launch: unexpected n_in %d / ws_size %zu\n", n_in, ws_size); grid = -1; return; }
    }
    if (grid < 0) return;
    (void)hipMemsetAsync((char*)d_ws + OFF_BAR, 0, 32768, stream);
    Args a{};
    for (int i = 0; i < 35; ++i) a.in[i] = (const float*)d_in[i];
    a.out = (float*)d_out; a.ws = (unsigned char*)d_ws;
#if MK_N_LAUNCHES == 1
    a.ph_lo = 0; a.ph_hi = NPH;
    void* kargs[] = {&a};
    hipError_t e = hipLaunchCooperativeKernel((const void*)fwd_kernel, dim3(grid), dim3(512), kargs, LDS_BYTES, stream);
    if (e != hipSuccess) fprintf(stderr, "kernel_launch: cooperative launch failed: %s (grid %d)\n", hipGetErrorString(e), grid);
#else
    for (int ph = 0; ph < NPH; ++ph) { a.ph_lo = ph; a.ph_hi = ph + 1; hipLaunchKernelGGL(fwd_kernel, dim3(grid), dim3(512), LDS_BYTES, stream, a); }
#endif
}
```

```cpp
#include <hip/hip_runtime.h>
#include <hip/hip_cooperative_groups.h>
#include <cstdio>
#include <cstdint>
namespace cg = cooperative_groups;

#ifndef MK_N_LAUNCHES
#define MK_N_LAUNCHES 1
#endif

#define LAS __attribute__((address_space(3)))
typedef unsigned short bf16_t;
typedef short bf16x8 __attribute__((ext_vector_type(8)));
typedef float f32x4 __attribute__((ext_vector_type(4)));
typedef unsigned u32x4 __attribute__((ext_vector_type(4)));
typedef unsigned u32x2 __attribute__((ext_vector_type(2)));

constexpr int M = 16384, DM = 1024, SEQ = 2048, INC = 3584, FFN = 2816, PLE = 256;
constexpr float EPS = 1e-6f;
constexpr int NPH = 12;

constexpr size_t MiB = 1u << 20;
constexpr size_t WS_CTL = 0;
constexpr size_t OFF_BAR = 524288;
constexpr size_t OFF_SSQ0 = 0, OFF_SSQ1 = 65536, OFF_SSQ2 = 131072, OFF_SSQ3 = 196608, OFF_SSQE = 262144, OFF_SP = 327680;
constexpr size_t WS_WIN = 1 * MiB, WS_WGLU = 8 * MiB, WS_WPLE = 8 * MiB + 512 * 1024, WS_WA = 9 * MiB, WS_WB = 10 * MiB, WS_WO = 12 * MiB, WS_WGU = 14 * MiB,
                 WS_WD = 25 * MiB, WS_WPG = 31 * MiB, WS_PM = 33 * MiB, WS_TQ = 37 * MiB, WS_WLRU = 43 * MiB;
constexpr size_t WS_PB = 44 * MiB;
constexpr size_t WS_GA = 52 * MiB, WS_GB = 84 * MiB;
constexpr size_t WS_XB = 116 * MiB;
constexpr size_t WS_UB = 148 * MiB;
constexpr size_t WS_UAS = 180 * MiB;
constexpr size_t WS_E = 228 * MiB;
constexpr size_t WS_ZG = 204 * MiB;
constexpr size_t WS_YAB = 116 * MiB;
constexpr size_t WS_MG = 164 * MiB;
constexpr size_t WS_ACT = 148 * MiB;
constexpr size_t WS_END = 256 * MiB;

__device__ __forceinline__ unsigned cvt_pk_bf16(float lo, float hi) { unsigned r; asm volatile("v_cvt_pk_bf16_f32 %0, %1, %2" : "=v"(r) : "v"(lo), "v"(hi)); return r; }
__device__ __forceinline__ u32x4 pack8(const f32x4 a, const f32x4 b) { u32x4 w; w.x = cvt_pk_bf16(a[0], a[1]); w.y = cvt_pk_bf16(a[2], a[3]); w.z = cvt_pk_bf16(b[0], b[1]); w.w = cvt_pk_bf16(b[2], b[3]); return w; }
__device__ __forceinline__ void unpack8(const u32x4 w, f32x4& a, f32x4& b) {
    a[0] = __uint_as_float(w.x << 16); a[1] = __uint_as_float(w.x & 0xffff0000u); a[2] = __uint_as_float(w.y << 16); a[3] = __uint_as_float(w.y & 0xffff0000u);
    b[0] = __uint_as_float(w.z << 16); b[1] = __uint_as_float(w.z & 0xffff0000u); b[2] = __uint_as_float(w.w << 16); b[3] = __uint_as_float(w.w & 0xffff0000u);
}
__device__ __forceinline__ float bf2f(bf16_t h) { return __uint_as_float((unsigned)h << 16); }
__device__ __forceinline__ float sigm(float x) { return __builtin_amdgcn_rcpf(1.0f + __expf(-x)); }
__device__ __forceinline__ f32x4 sigm4(f32x4 v) { f32x4 o; o[0] = sigm(v[0]); o[1] = sigm(v[1]); o[2] = sigm(v[2]); o[3] = sigm(v[3]); return o; }
__device__ __forceinline__ float gelu_tanh(float y) { const float t = 1.5957691216057308f * (y + 0.044715f * y * y * y); return y * sigm(t); }
__device__ __forceinline__ float sq4(f32x4 v) { return (v[0] * v[0] + v[1] * v[1]) + (v[2] * v[2] + v[3] * v[3]); }
__device__ __forceinline__ float rstd_of(float ssq) { return rsqrtf(ssq * (1.0f / 1024.0f) + EPS); }
__device__ __forceinline__ float wave_sum(float v) {
#pragma unroll
    for (int o = 1; o < 64; o <<= 1) v += __shfl_xor(v, o);
    return v;
}

#define XB_TMO      128
#define XB_XCNT(j)  (256  + 64 * (j))
#define XB_XSUB(j)  (1280 + 64 * (j))
#define XB_XGEN(j)  (2304 + 64 * (j))
#define XB_TOP      3328
#define XB_TOPGEN   3392
#define XCD_BAR_WORDS 3456
#define XB_SPIN_CAP (1u << 18)
__device__ __forceinline__ unsigned xb_ld(unsigned* p)              { return __hip_atomic_load(p, __ATOMIC_RELAXED, __HIP_MEMORY_SCOPE_AGENT); }
__device__ __forceinline__ unsigned xb_add(unsigned* p, unsigned v) { return __hip_atomic_fetch_add(p, v, __ATOMIC_RELAXED, __HIP_MEMORY_SCOPE_AGENT); }
__device__ __forceinline__ unsigned xb_xcc_id() { return (unsigned)__builtin_amdgcn_s_getreg((3 << 11) | 20) & 0xFu; }
#define XB_SPIN(cond, bar) do { unsigned _sp = 0; while (cond) { __builtin_amdgcn_s_sleep(1); \
    if ((++_sp & 255u) == 0u) { if (xb_ld(&(bar)[XB_TMO])) break; if (_sp > XB_SPIN_CAP) { atomicAdd(&(bar)[XB_TMO], 1u); break; } } } } while (0)
__device__ __forceinline__ void xcd_barrier_complete(unsigned* bar, unsigned x, unsigned G, unsigned& nloc, unsigned& nx) {
    unsigned sum, cnt, mine, sp = 0u;
    for (;;) {
        sum = 0u; cnt = 0u; mine = 0u;
#pragma unroll
        for (unsigned j = 0; j < 16; ++j) { const unsigned c = xb_ld(&bar[XB_XCNT(j)]); sum += c; cnt += (c > 0u) ? 1u : 0u; mine = (j == x) ? c : mine; }
        if (sum == G) break;
        __builtin_amdgcn_s_sleep(1);
        if ((++sp & 255u) == 0u) { if (xb_ld(&bar[XB_TMO])) break; if (sp > XB_SPIN_CAP) { atomicAdd(&bar[XB_TMO], 1u); break; } }
    }
    nloc = mine > 0u ? mine : 1u; nx = cnt > 0u ? cnt : 1u;
}
__device__ __forceinline__ void xcd_barrier(unsigned* bar, unsigned x, volatile LAS unsigned* st, unsigned G, bool leader) {
    asm volatile("s_waitcnt vmcnt(0)" ::: "memory");
    __syncthreads();
    if (leader) {
        __builtin_amdgcn_s_waitcnt(0);
        unsigned nloc = st[0], nx = st[1];
        if (nloc == 0u) { xcd_barrier_complete(bar, x, G, nloc, nx); st[0] = nloc; st[1] = nx; }
        const unsigned old = xb_add(&bar[XB_XSUB(x)], 1u);
        const unsigned gen = old / nloc;
        if (old + 1u == (gen + 1u) * nloc) {
            __builtin_amdgcn_fence(__ATOMIC_RELEASE, "agent");
            asm volatile("s_waitcnt vmcnt(0)" ::: "memory");
            const unsigned og = xb_add(&bar[XB_TOP], 1u);
            const unsigned tg = og / nx;
            if (og + 1u == (tg + 1u) * nx) xb_add(&bar[XB_TOPGEN], 1u);
            else XB_SPIN(xb_ld(&bar[XB_TOPGEN]) == tg, bar);
            __builtin_amdgcn_fence(__ATOMIC_ACQUIRE, "agent");
            xb_add(&bar[XB_XGEN(x)], 1u);
            asm volatile("s_waitcnt vmcnt(0)" ::: "memory");
        } else {
            XB_SPIN(xb_ld(&bar[XB_XGEN(x)]) == gen, bar);
            __builtin_amdgcn_fence(__ATOMIC_ACQUIRE, "agent");
            asm volatile("s_waitcnt vmcnt(0)" ::: "memory");
        }
    }
    __syncthreads();
}

namespace pg8 {
constexpr int BM = 256, BK = 64, HALF = 128, HTB = HALF * BK * 2, STAGE_BYTES = 8 * HTB, NXCD = 8, WGM = 8;
__host__ __device__ __forceinline__ int lds_byte(int r, int c) { const int st = (r >> 4) * 2 + (c >> 5), rr = r & 15, cc = c & 31, ob = rr * 64 + cc * 2; return st * 1024 + (ob ^ (((ob >> 9) & 1) << 5)); }
__host__ __device__ __forceinline__ void stage_rc(int b, int& R, int& C) { const int st = b / 1024, sb = b % 1024, swz = sb ^ (((sb >> 9) & 1) << 5); R = (st >> 1) * 16 + swz / 64; C = (st & 1) * 32 + (swz % 64) / 2; }
__host__ __device__ __forceinline__ int perm32(int rho) { const int n = rho >> 4, i = rho & 15; return 8 * (i >> 2) + 4 * n + (i & 3); }

struct Unit { int pm, pn; size_t aoff, boff; };
struct Gemm { const bf16_t* A; const bf16_t* Bt; int lda, ldb, K; };

struct Sched {
    int nM, nN, nwg, G, c;
    size_t a_pm, a_pn, b_pn, b_grp; int a_pn_shift;
    __device__ __forceinline__ void init(int nM_, int nN_, int G_, int c_, size_t a_pm_, size_t a_pn_, size_t b_pn_, size_t b_grp_) {
        nM = nM_; nN = nN_; nwg = nM * nN; G = G_; c = c_; a_pm = a_pm_; a_pn = a_pn_; b_pn = b_pn_; b_grp = b_grp_; a_pn_shift = 0; }
    __device__ __forceinline__ bool next(int i, Unit& u) const {
        const long L = (long)i * G + c; if (L >= nwg) return false;
        int wgid = (int)L; { const int q = nwg / NXCD, r = nwg % NXCD, xcd = wgid % NXCD, off = wgid / NXCD; wgid = (xcd < r ? xcd * (q + 1) : r * (q + 1) + (xcd - r) * q) + off; }
        const int nig = WGM * nN, gid = wgid / nig, fm = gid * WGM, gsz = (nM - fm) < WGM ? (nM - fm) : WGM;
        u.pm = fm + ((wgid % nig) % gsz); u.pn = (wgid % nig) / gsz;
        u.aoff = (size_t)u.pm * a_pm + (size_t)(u.pn >> a_pn_shift) * a_pn; u.boff = (size_t)u.pn * b_pn + (size_t)(u.pm >> 2) * b_grp;
        return true;
    }
};

struct OneUnit {
    int pm, pn; size_t aoff, boff;
    __device__ __forceinline__ bool next(int i, Unit& u) const { if (i != 0) return false; u.pm = pm; u.pn = pn; u.aoff = aoff; u.boff = boff; return true; }
};

struct NoMid { static constexpr bool ENABLED = false; int mid_t; template <class A, class U> __device__ __forceinline__ void operator()(A&, const U&, int, int, int, int) const {} };
template <class Epi, class SchedT, class Mid = NoMid>
__device__ __forceinline__ void gemm_phase(LAS unsigned char* lds, const Gemm g, const SchedT& S, const Epi& E, int tid_, const Mid Mh = Mid{}) {
    asm volatile("" : "+v"(tid_));
    const int tid = tid_, wid = __builtin_amdgcn_readfirstlane(tid >> 6), lane = tid & 63, wr = wid >> 2, wc = wid & 3, fr = lane & 15, fq = lane >> 4;
    const int nt = g.K / BK;
    unsigned voffA[2], voffB[2];
#pragma unroll
    for (int i = 0; i < 2; ++i) { int R, C; stage_rc(tid * 16 + i * 8192, R, C); const int Rb = (R & ~31) + perm32(R & 31);
        voffA[i] = (unsigned)(R * g.lda + C) * 2u; voffB[i] = (unsigned)(Rb * g.ldb + C) * 2u; }
    const size_t kstep = (size_t)(BK * 2);
    const size_t hstepA = (size_t)HALF * g.lda * 2, hstepB = (size_t)HALF * g.ldb * 2;
    const unsigned ldsw = (unsigned)wid * 1024u;
    const int aoff = lds_byte(wr * 64 + fr, fq * 8), boff = lds_byte(wc * 32 + fr, fq * 8);
#define PG8_SA(b, h) (((b) * 2 + (h)) * HTB)
#define PG8_SB(b, h) ((4 + (b) * 2 + (h)) * HTB)
#define PG8_STAGE(bufoff, gbase, voff) do { _Pragma("unroll") for (int _i = 0; _i < 2; ++_i) \
        __builtin_amdgcn_global_load_lds((const unsigned*)((const char*)(gbase) + (voff)[_i]), (LAS unsigned*)(lds + (bufoff) + ldsw + _i * 8192), 16, 0, 0); } while (0)
#define PG8_LDA(dst, b, h) do { _Pragma("unroll") for (int m = 0; m < 4; ++m) _Pragma("unroll") for (int k = 0; k < 2; ++k) dst[m][k] = *(const LAS bf16x8*)(lds + PG8_SA(b, h) + aoff + m * 2048 + k * 1024); } while (0)
#define PG8_LDB(dst, b, h) do { _Pragma("unroll") for (int n = 0; n < 2; ++n) _Pragma("unroll") for (int k = 0; k < 2; ++k) dst[n][k] = *(const LAS bf16x8*)(lds + PG8_SB(b, h) + boff + n * 2048 + k * 1024); } while (0)
#define PG8_MMA(ai, bj, At, Bt) do { __builtin_amdgcn_s_setprio(1); _Pragma("unroll") for (int m = 0; m < 4; ++m) _Pragma("unroll") for (int n = 0; n < 2; ++n) _Pragma("unroll") for (int k = 0; k < 2; ++k) \
        acc[ai][bj][m][n] = __builtin_amdgcn_mfma_f32_16x16x32_bf16(Bt[n][k], At[m][k], acc[ai][bj][m][n], 0, 0, 0); __builtin_amdgcn_s_setprio(0); } while (0)
#define PG8_WAIT_V(n) asm volatile("s_waitcnt vmcnt(" #n ")" ::: "memory")
#define PG8_WAIT_L(n) asm volatile("s_waitcnt lgkmcnt(" #n ")" ::: "memory")
#define PG8_BAR __builtin_amdgcn_s_barrier()
#define PG8_SCHED __builtin_amdgcn_sched_barrier(0)
    Unit cur, nxt; int ui = 0;
    if (!S.next(0, cur)) return;
    f32x4 acc[2][2][4][2];
#pragma unroll
    for (int a = 0; a < 2; ++a)
#pragma unroll
        for (int b = 0; b < 2; ++b)
#pragma unroll
            for (int m = 0; m < 4; ++m)
#pragma unroll
                for (int n = 0; n < 2; ++n) acc[a][b][m][n] = (f32x4){0.f, 0.f, 0.f, 0.f};
    bf16x8 At[4][2], B0[2][2], B1[2][2];
    const char* cA = (const char*)g.A + cur.aoff; const char* cB = (const char*)g.Bt + cur.boff;
    PG8_STAGE(PG8_SB(0, 0), cB, voffB); PG8_STAGE(PG8_SB(0, 1), cB + hstepB, voffB); PG8_STAGE(PG8_SA(0, 0), cA, voffA); PG8_STAGE(PG8_SA(0, 1), cA + hstepA, voffA);
    if (wr == 1) PG8_BAR;
    PG8_WAIT_V(2); PG8_BAR;
    PG8_STAGE(PG8_SB(1, 0), cB + kstep, voffB); PG8_STAGE(PG8_SA(1, 0), cA + kstep, voffA); PG8_STAGE(PG8_SB(1, 1), cB + hstepB + kstep, voffB);
    PG8_WAIT_V(6); PG8_BAR;
    for (;;) {
        const bool has_next = S.next(ui + 1, nxt);
        const char* nA = has_next ? (const char*)g.A + nxt.aoff : cA; const char* nB = has_next ? (const char*)g.Bt + nxt.boff : cB;
        for (int t = 0; t < nt; t += 2) {
            if constexpr (Mid::ENABLED) { if (t == Mh.mid_t) { int fr_e = fr, fq_e = fq; asm volatile("" : "+v"(fr_e), "+v"(fq_e)); Mh(acc, cur, wr, wc, fr_e, fq_e); } }
            const bool last = (t == nt - 2);
            const char* a1 = cA + (size_t)(t + 1) * kstep;
            const char* a2 = last ? nA : cA + (size_t)(t + 2) * kstep; const char* b2 = last ? nB : cB + (size_t)(t + 2) * kstep;
            const char* a3 = a2 + kstep; const char* b3 = b2 + kstep;
            PG8_LDB(B0, 0, 0); PG8_LDB(B1, 0, 1); PG8_SCHED; PG8_LDA(At, 0, 0); PG8_STAGE(PG8_SA(1, 1), a1 + hstepA, voffA);
            PG8_WAIT_V(8); PG8_WAIT_L(0); PG8_BAR; PG8_MMA(0, 0, At, B0); PG8_MMA(0, 1, At, B1); PG8_BAR; PG8_SCHED;
            PG8_LDA(At, 0, 1); PG8_STAGE(PG8_SB(0, 0), b2, voffB); PG8_STAGE(PG8_SB(0, 1), b2 + hstepB, voffB); PG8_STAGE(PG8_SA(0, 0), a2, voffA);
            PG8_WAIT_V(8); PG8_WAIT_L(0); PG8_BAR; PG8_MMA(1, 0, At, B0); PG8_MMA(1, 1, At, B1); PG8_BAR; PG8_SCHED;
            PG8_LDB(B0, 1, 0); PG8_LDB(B1, 1, 1); PG8_SCHED; PG8_LDA(At, 1, 0); PG8_STAGE(PG8_SA(0, 1), a2 + hstepA, voffA);
            PG8_WAIT_V(8); PG8_WAIT_L(0); PG8_BAR; PG8_MMA(0, 0, At, B0); PG8_MMA(0, 1, At, B1); PG8_BAR; PG8_SCHED;
            PG8_LDA(At, 1, 1); PG8_STAGE(PG8_SB(1, 0), b3, voffB); PG8_STAGE(PG8_SB(1, 1), b3 + hstepB, voffB); PG8_STAGE(PG8_SA(1, 0), a3, voffA);
            PG8_WAIT_V(8); PG8_WAIT_L(0); PG8_BAR; PG8_MMA(1, 0, At, B0); PG8_MMA(1, 1, At, B1); PG8_BAR; PG8_SCHED;
        }
        if (wr == 0) PG8_BAR;
        { int fr_e = fr, fq_e = fq; asm volatile("" : "+v"(fr_e), "+v"(fq_e)); E(acc, cur, wr, wc, fr_e, fq_e); }
        if (!has_next) break;
#pragma unroll
        for (int a = 0; a < 2; ++a)
#pragma unroll
            for (int b = 0; b < 2; ++b)
#pragma unroll
                for (int m = 0; m < 4; ++m)
#pragma unroll
                    for (int n = 0; n < 2; ++n) acc[a][b][m][n] = (f32x4){0.f, 0.f, 0.f, 0.f};
        cur = nxt; cA = nA; cB = nB; ++ui;
        if (wr == 1) PG8_BAR;
    }
    PG8_WAIT_V(0);
    PG8_BAR;
#undef PG8_SA
#undef PG8_SB
#undef PG8_STAGE
#undef PG8_LDA
#undef PG8_LDB
#undef PG8_MMA
#undef PG8_WAIT_V
#undef PG8_WAIT_L
#undef PG8_BAR
#undef PG8_SCHED
}
}

typedef f32x4 AccT[2][2][4][2];
#define EPI_ROWS(ai, m) _Pragma("unroll") for (int ai = 0; ai < 2; ++ai) _Pragma("unroll") for (int m = 0; m < 4; ++m)
#define EPI_ROW(u, ai, m) ((u).pm * 256 + (ai) * 128 + wr * 64 + (m) * 16 + fr)
#define EPI_LCOL(bj) ((bj) * 128 + wc * 32 + 8 * fq)
__device__ __forceinline__ void row_atomic(float* dst, float s, int fq) { s += __shfl_xor(s, 16); s += __shfl_xor(s, 32); if (fq == 0) atomicAdd(dst, s); }

struct EpiIn {
    const float* ssq0; const float* b_in; bf16_t* UAS; bf16_t* UB; bf16_t* GR; bf16_t* GB; int pn0;
    __device__ __forceinline__ void operator()(const AccT& acc, const pg8::Unit& u, int wr, int wc, int fr, int fq) const {
        const int upn = u.pn + pn0;
        if (upn >= 6) { const int ch = (upn - 6) * 128 + wc * 32 + 8 * fq; const float NL = -1.4426950408889634f;
            const f32x4 ba0 = *(const f32x4*)(b_in + 1536 + ch) * NL, ba1 = *(const f32x4*)(b_in + 1536 + ch + 4) * NL, bb0 = *(const f32x4*)(b_in + 2560 + ch) * NL, bb1 = *(const f32x4*)(b_in + 2560 + ch + 4) * NL;
            EPI_ROWS(ai, m) { const int row = EPI_ROW(u, ai, m); const float rs = rstd_of(ssq0[row]) * NL; f32x4 r0, r1, g0, g1;
#pragma unroll
                for (int j = 0; j < 4; ++j) {
                    const float ea0 = __builtin_amdgcn_exp2f(__builtin_fmaf(acc[ai][0][m][0][j], rs, ba0[j])), ea1 = __builtin_amdgcn_exp2f(__builtin_fmaf(acc[ai][0][m][1][j], rs, ba1[j]));
                    const float eb0 = fminf(__builtin_amdgcn_exp2f(__builtin_fmaf(acc[ai][1][m][0][j], rs, bb0[j])), 1e30f), eb1 = fminf(__builtin_amdgcn_exp2f(__builtin_fmaf(acc[ai][1][m][1][j], rs, bb1[j])), 1e30f);
                    g0[j] = __builtin_amdgcn_rcpf(1.0f + eb0); g1[j] = __builtin_amdgcn_rcpf(1.0f + eb1);
                    r0[j] = (1.0f + eb0) * __builtin_amdgcn_rcpf(1.0f + ea0); r1[j] = (1.0f + eb1) * __builtin_amdgcn_rcpf(1.0f + ea1); }
                *(u32x4*)(GR + (size_t)row * 1024 + ch) = pack8(r0, r1); *(u32x4*)(GB + (size_t)row * 1024 + ch) = pack8(g0, g1); }
            return; }
        EPI_ROWS(ai, m) { const int row = EPI_ROW(u, ai, m); const float rs = rstd_of(ssq0[row]);
#pragma unroll
            for (int bj = 0; bj < 2; ++bj) { const int col = upn * 256 + EPI_LCOL(bj);
                const f32x4 b0 = *(const f32x4*)(b_in + col), b1 = *(const f32x4*)(b_in + col + 4);
                const f32x4 v0 = acc[ai][bj][m][0] * rs + b0, v1 = acc[ai][bj][m][1] * rs + b1;
                bf16_t* dst;
                if (upn < 2) { const int g = col >> 4, q = col & 15, b = row >> 11, l = row & 2047, c = l >> 4, t = l & 15;
                    dst = UAS + ((size_t)(g * 1024 + b * 128 + c) * 384 + t * 16 + q); }
                else dst = UB + (size_t)row * 1024 + (col - 512);
                *(u32x4*)dst = pack8(v0, v1); } }
    }
};
struct EpiEraw {
    bf16_t* ERAW; float* ssqe;
    __device__ __forceinline__ void operator()(const AccT& acc, const pg8::Unit& u, int wr, int wc, int fr, int fq) const {
        EPI_ROWS(ai, m) { const int row = EPI_ROW(u, ai, m); float s = 0.f;
#pragma unroll
            for (int bj = 0; bj < 2; ++bj) { const int col = u.pn * 256 + EPI_LCOL(bj); const f32x4 v0 = acc[ai][bj][m][0], v1 = acc[ai][bj][m][1];
                s += sq4(v0) + sq4(v1); *(u32x4*)(ERAW + (size_t)row * 1024 + col) = pack8(v0, v1); }
            row_atomic(ssqe + row, s, fq); }
    }
};
struct EpiS5a {
    float* E;
    __device__ __forceinline__ void operator()(const AccT& acc, const pg8::Unit& u, int wr, int wc, int fr, int fq) const {
        EPI_ROWS(ai, m) { const int row = EPI_ROW(u, ai, m); float* dst = E + (size_t)row * 128 + EPI_LCOL(0);
            *(f32x4*)dst = acc[ai][0][m][0]; *(f32x4*)(dst + 4) = acc[ai][0][m][1]; }
    }
};
struct EpiS5b {
    bf16_t* ZG;
    __device__ __forceinline__ void operator()(const AccT& acc, const pg8::Unit& u, int wr, int wc, int fr, int fq) const {
        const int lc = wc * 32 + 8 * fq;
        const int t0 = lc >> 4, p = lc & 15;
        EPI_ROWS(ai, m) { const int row = EPI_ROW(u, ai, m); const int g = row >> 10, b = (row >> 7) & 7, c = row & 127;
            bf16_t* dst = ZG + (size_t)(b * 2048 + c * 16 + t0) * 512 + g * 16 + p;
#pragma unroll
            for (int bj = 0; bj < 2; ++bj) { u32x2 w[2];
#pragma unroll
                for (int n = 0; n < 2; ++n) { f32x4 v = acc[ai][bj][m][n];
#pragma unroll
                    for (int j = 0; j < 4; ++j) v[j] = gelu_tanh(v[j]);
                    w[n].x = cvt_pk_bf16(v[0], v[1]); w[n].y = cvt_pk_bf16(v[2], v[3]); }
                *(u32x4*)(dst + bj * 8 * 512) = (u32x4){w[0].x, w[0].y, w[1].x, w[1].y};
                asm volatile("" ::: "memory"); } }
    }
};
struct EpiLru {
    const float* b_r; const float* b_i; const float* sp; const bf16_t* XC; float* AA; bf16_t* BX;
    __device__ __forceinline__ void operator()(const AccT& acc, const pg8::Unit& u, int wr, int wc, int fr, int fq) const {
        const int ch = u.pn * 128 + wc * 32 + 8 * fq;
        EPI_ROWS(ai, m) { const int row = EPI_ROW(u, ai, m); const size_t off = (size_t)row * 1024 + ch;
            const u32x4 xw = *(const u32x4*)(XC + off); f32x4 xx[2]; unpack8(xw, xx[0], xx[1]); u32x2 hw[2];
#pragma unroll
            for (int n = 0; n < 2; ++n) {
                const f32x4 r = sigm4(acc[ai][0][m][n] + *(const f32x4*)(b_r + ch + 4 * n)), ig = sigm4(acc[ai][1][m][n] + *(const f32x4*)(b_i + ch + 4 * n)), s4 = *(const f32x4*)(sp + ch + 4 * n);
                f32x4 a, h;
#pragma unroll
                for (int j = 0; j < 4; ++j) { a[j] = __expf(-8.0f * r[j] * s4[j]); h[j] = sqrtf(fmaxf(1.0f - a[j] * a[j], 0.f)) * ig[j] * xx[n][j]; }
                *(f32x4*)(AA + off + 4 * n) = a; hw[n].x = cvt_pk_bf16(h[0], h[1]); hw[n].y = cvt_pk_bf16(h[2], h[3]); }
            *(u32x4*)(BX + off) = (u32x4){hw[0].x, hw[0].y, hw[1].x, hw[1].y};
            asm volatile("" ::: "memory"); }
    }
};
struct EpiGlu {
    const bf16_t* ZG; const float* b_glu; bf16_t* YA;
    __device__ __forceinline__ void operator()(const AccT& acc, const pg8::Unit& u, int wr, int wc, int fr, int fq) const {
        EPI_ROWS(ai, m) { const int row = EPI_ROW(u, ai, m);
#pragma unroll
            for (int bj = 0; bj < 2; ++bj) { const int col = u.pn * 256 + EPI_LCOL(bj); const size_t off = (size_t)row * 512 + col;
                f32x4 z0, z1; unpack8(*(const u32x4*)(ZG + off), z0, z1);
                const f32x4 s0 = sigm4(acc[ai][bj][m][0] + *(const f32x4*)(b_glu + col)), s1 = sigm4(acc[ai][bj][m][1] + *(const f32x4*)(b_glu + col + 4));
                *(u32x4*)(YA + (size_t)row * 1536 + col) = pack8(z0 * s0, z1 * s1); } }
    }
};
struct MidGate {
    static constexpr bool ENABLED = true; int mid_t; const bf16_t* GR;
    __device__ __forceinline__ void operator()(AccT& acc, const pg8::Unit& u, int wr, int wc, int fr, int fq) const {
#pragma unroll
        for (int ai = 0; ai < 2; ++ai) { u32x4 gr[4][2];
#pragma unroll
            for (int m = 0; m < 4; ++m)
#pragma unroll
                for (int bj = 0; bj < 2; ++bj) gr[m][bj] = *(const u32x4*)(GR + (size_t)EPI_ROW(u, ai, m) * 1024 + u.pn * 256 + EPI_LCOL(bj));
#pragma unroll
            for (int m = 0; m < 4; ++m)
#pragma unroll
                for (int bj = 0; bj < 2; ++bj) { f32x4 a0, a1; unpack8(gr[m][bj], a0, a1); acc[ai][bj][m][0] *= a0; acc[ai][bj][m][1] *= a1; }
            asm volatile("" ::: "memory"); }
    }
};
struct EpiMg {
    const bf16_t* GB; bf16_t* MG;
    __device__ __forceinline__ void operator()(const AccT& acc, const pg8::Unit& u, int wr, int wc, int fr, int fq) const {
#pragma unroll
        for (int ai = 0; ai < 2; ++ai) { u32x4 gb[4][2];
#pragma unroll
            for (int m = 0; m < 4; ++m)
#pragma unroll
                for (int bj = 0; bj < 2; ++bj) gb[m][bj] = *(const u32x4*)(GB + (size_t)EPI_ROW(u, ai, m) * 1024 + u.pn * 256 + EPI_LCOL(bj));
#pragma unroll
            for (int m = 0; m < 4; ++m)
#pragma unroll
                for (int bj = 0; bj < 2; ++bj) { f32x4 g0, g1; unpack8(gb[m][bj], g0, g1);
                    *(u32x4*)(MG + (size_t)EPI_ROW(u, ai, m) * 1024 + u.pn * 256 + EPI_LCOL(bj)) = pack8(g0 * acc[ai][bj][m][0], g1 * acc[ai][bj][m][1]); }
            asm volatile("" ::: "memory"); }
    }
};
struct EpiRes {
    const float* xi; const bf16_t* xib; bf16_t* XBo; float* ssq;
    __device__ __forceinline__ void operator()(const AccT& acc, const pg8::Unit& u, int wr, int wc, int fr, int fq) const {
#pragma unroll
        for (int ai = 0; ai < 2; ++ai) { u32x4 rw[4][2];
#pragma unroll
            for (int m = 0; m < 4; ++m)
#pragma unroll
                for (int bj = 0; bj < 2; ++bj) rw[m][bj] = *(const u32x4*)(xib + (size_t)EPI_ROW(u, ai, m) * 1024 + u.pn * 256 + EPI_LCOL(bj));
#pragma unroll
            for (int m = 0; m < 4; ++m) { const int row = EPI_ROW(u, ai, m); float s = 0.f;
#pragma unroll
                for (int bj = 0; bj < 2; ++bj) { const size_t off = (size_t)row * 1024 + u.pn * 256 + EPI_LCOL(bj);
                    f32x4 r0, r1; unpack8(rw[m][bj], r0, r1);
                    const f32x4 v0 = r0 + acc[ai][bj][m][0], v1 = r1 + acc[ai][bj][m][1];
                    s += sq4(v0) + sq4(v1);
                    *(u32x4*)(XBo + off) = pack8(v0, v1); }
                row_atomic(ssq + row, s, fq); }
            asm volatile("" ::: "memory"); }
    }
};
struct EpiFfn {
    const float* ssq1; bf16_t* ACT;
    __device__ __forceinline__ void operator()(const AccT& acc, const pg8::Unit& u, int wr, int wc, int fr, int fq) const {
        const int hc = u.pn * 128 + wc * 32 + 8 * fq;
        EPI_ROWS(ai, m) { const int row = EPI_ROW(u, ai, m); const float rs = rstd_of(ssq1[row]);
            f32x4 g0 = acc[ai][0][m][0] * rs, g1 = acc[ai][0][m][1] * rs; const f32x4 u0 = acc[ai][1][m][0] * rs, u1 = acc[ai][1][m][1] * rs;
            g0 = g0 * sigm4(g0) * u0; g1 = g1 * sigm4(g1) * u1;
            *(u32x4*)(ACT + (size_t)row * FFN + hc) = pack8(g0, g1); }
    }
};
struct EpiPg {
    const float* ssq2; const float* ssqe; const float* b_pg; const float* g_ple; const bf16_t* ERAW; const bf16_t* X2B; float* ssq3; unsigned* cnt; const float* g_final; float* out;
    __device__ __forceinline__ void operator()(AccT& acc, const pg8::Unit& u, int wr, int wc, int fr, int fq) const {
#pragma unroll
        for (int ai = 0; ai < 2; ++ai)
#pragma unroll
        for (int mp = 0; mp < 2; ++mp) { u32x4 ew[2][2], xw[2][2];
#pragma unroll
            for (int mm = 0; mm < 2; ++mm)
#pragma unroll
                for (int bj = 0; bj < 2; ++bj) { const size_t off = (size_t)EPI_ROW(u, ai, mp * 2 + mm) * 1024 + u.pn * 256 + EPI_LCOL(bj); ew[mm][bj] = *(const u32x4*)(ERAW + off); xw[mm][bj] = *(const u32x4*)(X2B + off); }
#pragma unroll
            for (int mm = 0; mm < 2; ++mm) { const int m = mp * 2 + mm; const int row = EPI_ROW(u, ai, m); const float rs = rstd_of(ssq2[row]), re = rstd_of(ssqe[row]); float s = 0.f;
#pragma unroll
                for (int bj = 0; bj < 2; ++bj) { const int col = u.pn * 256 + EPI_LCOL(bj);
                    f32x4 e0, e1, x0, x1; unpack8(ew[mm][bj], e0, e1); unpack8(xw[mm][bj], x0, x1);
                    const f32x4 gt0 = sigm4(acc[ai][bj][m][0] * rs + *(const f32x4*)(b_pg + col)), gt1 = sigm4(acc[ai][bj][m][1] * rs + *(const f32x4*)(b_pg + col + 4));
                    const f32x4 v0 = x0 + gt0 * (e0 * re * *(const f32x4*)(g_ple + col)), v1 = x1 + gt1 * (e1 * re * *(const f32x4*)(g_ple + col + 4));
                    s += sq4(v0) + sq4(v1);
                    acc[ai][bj][m][0] = v0; acc[ai][bj][m][1] = v1; }
                s += __shfl_xor(s, 16); s += __shfl_xor(s, 32);
                if (fq == 0) { const float old = __hip_atomic_fetch_add(ssq3 + row, s, __ATOMIC_RELAXED, __HIP_MEMORY_SCOPE_AGENT); asm volatile("" :: "v"(old)); } }
            asm volatile("" ::: "memory"); }
        asm volatile("s_waitcnt vmcnt(0)" ::: "memory");
        unsigned* c = cnt + 64 * u.pm;
        if (__builtin_amdgcn_mbcnt_hi(~0u, __builtin_amdgcn_mbcnt_lo(~0u, 0u)) == 0u) (void)__hip_atomic_fetch_add(c, 1u, __ATOMIC_RELAXED, __HIP_MEMORY_SCOPE_AGENT);
        { unsigned spins = 0; while ((unsigned)__builtin_amdgcn_readfirstlane((int)__hip_atomic_load(c, __ATOMIC_RELAXED, __HIP_MEMORY_SCOPE_AGENT)) < 32u) { __builtin_amdgcn_s_sleep(2); if (++spins > (1u << 22)) break; } }
#pragma unroll
        for (int ai = 0; ai < 2; ++ai)
#pragma unroll
            for (int m = 0; m < 4; ++m) { const int row = EPI_ROW(u, ai, m); const float rs = rstd_of(__hip_atomic_load(ssq3 + row, __ATOMIC_RELAXED, __HIP_MEMORY_SCOPE_AGENT));
#pragma unroll
                for (int bj = 0; bj < 2; ++bj) { const int col = u.pn * 256 + EPI_LCOL(bj); float* o = out + (size_t)row * 1024 + col;
                    __builtin_nontemporal_store(acc[ai][bj][m][0] * rs * *(const f32x4*)(g_final + col), (f32x4*)o); __builtin_nontemporal_store(acc[ai][bj][m][1] * rs * *(const f32x4*)(g_final + col + 4), (f32x4*)(o + 4)); } }
    }
};

__device__ __forceinline__ void tr_item(const float* W, int K, int N, const float* gk, bf16_t* WT, int mode, LAS float* scr, int item, int lane, int ldd = 0, int koff = 0) {
    if (ldd == 0) ldd = K;
    const int nblk = N / 32, kb = item / nblk, nb = item % nblk, k0 = 64 * kb, n0 = 32 * nb;
    float tv[32];
#pragma unroll
    for (int i = 0; i < 32; ++i) { const int kk = 2 * i + (lane >> 5); tv[i] = __builtin_nontemporal_load(&W[(size_t)(k0 + kk) * N + n0 + (lane & 31)]); }
#pragma unroll
    for (int i = 0; i < 32; ++i) { const int kk = 2 * i + (lane >> 5); float v = tv[i]; if (gk) v *= gk[k0 + kk]; scr[kk * 33 + (lane & 31)] = v; }
    asm volatile("s_waitcnt lgkmcnt(0)" ::: "memory");
    const int c = lane & 7;
#pragma unroll
    for (int j = 0; j < 4; ++j) { const int n = (lane >> 3) + 8 * j; const LAS float* s = scr + (8 * c) * 33 + n;
        u32x4 o; o.x = cvt_pk_bf16(s[0 * 33], s[1 * 33]); o.y = cvt_pk_bf16(s[2 * 33], s[3 * 33]); o.z = cvt_pk_bf16(s[4 * 33], s[5 * 33]); o.w = cvt_pk_bf16(s[6 * 33], s[7 * 33]);
        const int nn = n0 + n; int drow;
        if (mode == 0) drow = nn; else if (mode == 3) { if (nn < 1536) drow = nn; else { const int gbs = nn >= 2560, c_ = nn - (gbs ? 2560 : 1536); drow = 1536 + 256 * (c_ >> 7) + gbs * 128 + (c_ & 127); } }
        else drow = 256 * (nn >> 7) + (mode - 1) * 128 + (nn & 127);
        *(u32x4*)(WT + (size_t)drow * ldd + koff + k0 + 8 * c) = o; }
    asm volatile("s_waitcnt lgkmcnt(0)" ::: "memory");
}

struct Args { const float* in[35]; float* out; unsigned char* ws; int ph_lo, ph_hi; };

template <class KA> __device__ __forceinline__ void s5_precompute(KA a, unsigned char* ws, LAS unsigned char* lds, int g, int part, int nparts, int tid) {
    const int tau_lo = part * (16 / nparts), tau_hi = tau_lo + 16 / nparts, row_lo = part * (256 / nparts), row_hi = row_lo + 256 / nparts;
    LAS float* PWr = (LAS float*)lds;
    LAS float* PWi = PWr + 17 * 64;
    LAS float* BBr = PWi + 17 * 64;
    LAS float* BBi = BBr + 1024;
    LAS float* Cr = BBi + 1024;
    LAS float* Ci = Cr + 1024;
    LAS float* Kt = Ci + 1024;
    const float* lam_re = a->in[5] + g * 64; const float* lam_im = a->in[6] + g * 64; const float dt = expf(a->in[7][g]);
    const float* b_re = a->in[8] + g * 1024; const float* b_im = a->in[9] + g * 1024; const float* c_re = a->in[10] + g * 1024; const float* c_im = a->in[11] + g * 1024;
    const float* dsk = a->in[12] + g * 16;
    for (int e = tid; e < 17 * 64; e += 512) { const int k = e >> 6, n = e & 63; const float lr = lam_re[n], li = lam_im[n];
        const float mag = expf((float)k * lr * dt); float s, c; sincosf((float)k * (li * dt), &s, &c); PWr[e] = mag * c; PWi[e] = mag * s; }
    for (int e = tid; e < 1024; e += 512) { const int n = e >> 4; const float lr = lam_re[n], li = lam_im[n];
        const float mag = expf(lr * dt); float s, c; sincosf(li * dt, &s, &c); const float ar = mag * c, ai = mag * s, den = lr * lr + li * li, nr = ar - 1.0f;
        const float fr = (nr * lr + ai * li) / den, fi = (ai * lr - nr * li) / den; const float br = b_re[e], bi = b_im[e];
        BBr[e] = fr * br - fi * bi; BBi[e] = fr * bi + fi * br; Cr[e] = c_re[e]; Ci[e] = c_im[e]; }
    __syncthreads();
    for (int e = tau_lo * 256 + tid; e < tau_hi * 256; e += 512) { const int tau = e >> 8, p = (e >> 4) & 15, q = e & 15; float s = 0.f;
        for (int n = 0; n < 64; ++n) { const float pr = PWr[tau * 64 + n], pi = PWi[tau * 64 + n], br = BBr[n * 16 + q], bi = BBi[n * 16 + q];
            const float wr_ = pr * br - pi * bi, wi_ = pr * bi + pi * br; s += Cr[p * 64 + n] * wr_ - Ci[p * 64 + n] * wi_; }
        if (tau == 0 && p == q) s += dsk[p];
        Kt[e] = s; }
    __syncthreads();
    bf16_t* PMg = (bf16_t*)(ws + WS_PM) + (size_t)g * 256 * 256;
    bf16_t* TQg = (bf16_t*)(ws + WS_TQ) + (size_t)g * 256 * 384;
    for (int e = tid; e < 256 * 32; e += 512) { const int row = e >> 5, cgp = e & 31, t = row >> 4, p = row & 15, s = cgp >> 1, q0 = (cgp & 1) * 8;
        f32x4 v0 = {0.f, 0.f, 0.f, 0.f}, v1 = v0;
        if (s <= t ? (t - s < tau_lo || t - s >= tau_hi) : (part != 0)) continue;
        if (s <= t) { const LAS float* kp = Kt + (t - s) * 256 + p * 16 + q0; v0 = (f32x4){kp[0], kp[1], kp[2], kp[3]}; v1 = (f32x4){kp[4], kp[5], kp[6], kp[7]}; }
        *(u32x4*)(TQg + (size_t)row * 384 + s * 16 + q0) = pack8(v0, v1); }
    for (int e = row_lo * 16 + tid; e < row_hi * 16; e += 512) { const int row = e >> 4, cgp = e & 15, t = row >> 4, p = row & 15, half = cgp >> 3, n0 = (cgp & 7) * 8;
        float v[8];
#pragma unroll
        for (int j = 0; j < 8; ++j) { const int n = n0 + j; const float cr = Cr[p * 64 + n], ci = Ci[p * 64 + n], pr = PWr[(t + 1) * 64 + n], pi = PWi[(t + 1) * 64 + n];
            v[j] = half == 0 ? (cr * pr - ci * pi) : -(cr * pi + ci * pr); }
        *(u32x4*)(TQg + (size_t)row * 384 + 256 + half * 64 + n0) = pack8((f32x4){v[0], v[1], v[2], v[3]}, (f32x4){v[4], v[5], v[6], v[7]}); }
    for (int e = row_lo * 32 + tid; e < row_hi * 32; e += 512) { const int row = e >> 5, cgp = e & 31, s = cgp >> 1, q0 = (cgp & 1) * 8;
        float v[8];
#pragma unroll
        for (int j = 0; j < 8; ++j) v[j] = 0.f;
        if (row < 128) { const int n = row & 63, im = row >> 6; const float pr = PWr[(15 - s) * 64 + n], pi = PWi[(15 - s) * 64 + n];
#pragma unroll
            for (int j = 0; j < 8; ++j) { const float br = BBr[n * 16 + q0 + j], bi = BBi[n * 16 + q0 + j]; v[j] = im == 0 ? (pr * br - pi * bi) : (pr * bi + pi * br); } }
        *(u32x4*)(PMg + (size_t)row * 256 + s * 16 + q0) = pack8((f32x4){v[0], v[1], v[2], v[3]}, (f32x4){v[4], v[5], v[6], v[7]}); }
    __syncthreads();
}

__device__ __forceinline__ bf16x8 pack8s(const float (&t)[8]) { u32x4 w; w.x = cvt_pk_bf16(t[0], t[1]); w.y = cvt_pk_bf16(t[2], t[3]); w.z = cvt_pk_bf16(t[4], t[5]); w.w = cvt_pk_bf16(t[6], t[7]); return __builtin_bit_cast(bf16x8, w); }
__device__ __forceinline__ void wg_publish(bool leader) {
    asm volatile("s_waitcnt vmcnt(0)" ::: "memory"); __syncthreads();
    if (leader) { __builtin_amdgcn_fence(__ATOMIC_ACQUIRE, "agent"); asm volatile("s_waitcnt vmcnt(0)" ::: "memory"); }
    __syncthreads();
}

template <class KA>
__device__ __forceinline__ void lru_fused_unit(KA ap, unsigned char* ws, const bf16_t* UBg, LAS unsigned char* lds, int unit, int wave) {
    int lane = (int)__builtin_amdgcn_mbcnt_hi(~0u, __builtin_amdgcn_mbcnt_lo(~0u, 0u)); asm volatile("" : "+v"(lane));
    const int b = unit >> 4, h = unit & 15, ch0 = h * 64;
    const int r = lane & 15, q = lane >> 4;
    LAS float* xb = (LAS float*)(lds + wave * 10368);
    LAS float* aL = xb + 16 * 65;
    LAS bf16_t* hL = (LAS bf16_t*)(aL + 16 * 65);
    LAS float* agg = (LAS float*)(lds + 83968);
    LAS float* cwL = (LAS float*)(lds + 92160); LAS float* cbL = cwL + 256;
    LAS u32x4* BtL = (LAS u32x4*)(lds + 93696);
    LAS u32x4* IdL = (LAS u32x4*)(lds + 110080);
    const bf16_t* UBp = UBg + (size_t)b * 2048 * 1024 + ch0 + 8 * q;
    bf16_t* YBp = (bf16_t*)(ws + WS_YAB) + (size_t)b * 2048 * 1536 + 512 + ch0;
    u32x4 raw[2][4], rawn[2][4];
#define LRU_LOAD(dst, blk_) do { const int l0_ = (blk_) * 128 + wave * 16 + r - 3; _Pragma("unroll") for (int ks = 0; ks < 2; ++ks) _Pragma("unroll") for (int tp = 0; tp < 4; ++tp) { \
        const int l_ = l0_ + tp; dst[ks][tp] = (l_ >= 0) ? *(const u32x4*)(UBp + (size_t)(l_ < 0 ? 0 : l_) * 1024 + 32 * ks) : (u32x4){0u, 0u, 0u, 0u}; } } while (0)
    LRU_LOAD(raw, 0);
    { const int t_ = wave * 64 + lane; if (t_ < 256) cwL[t_] = ap->in[15][(t_ >> 6) * 1024 + ch0 + (t_ & 63)]; else if (t_ < 320) cbL[t_ - 256] = ap->in[16][ch0 + (t_ - 256)];
#pragma unroll
      for (int e2 = 0; e2 < 2; ++e2) { const int e = t_ + 512 * e2, c = e >> 7, ks = (e >> 6) & 1, ln = e & 63, rr = ln & 15, qq = ln >> 4;
          const float* w = ((c < 4) ? ap->in[17] : ap->in[19]) + h * 4096 + (c & 3) * 16 + rr; float t[8];
#pragma unroll
          for (int j = 0; j < 8; ++j) t[j] = w[(32 * ks + 8 * qq + j) * 64];
          BtL[e] = __builtin_bit_cast(u32x4, pack8s(t)); }
      { const int c = t_ >> 7, ks = (t_ >> 6) & 1, ln = t_ & 63, rr = ln & 15, qq = ln >> 4; float t[8];
#pragma unroll
        for (int j = 0; j < 8; ++j) t[j] = (32 * ks + 8 * qq + j == 16 * c + rr) ? 1.0f : 0.0f;
        IdL[t_] = __builtin_bit_cast(u32x4, pack8s(t)); } }
    float brc[4], bic[4], spc[4];
#pragma unroll
    for (int c = 0; c < 4; ++c) { const int ch = ch0 + c * 16 + r; const float L2E = 1.4426950408889634f; brc[c] = -L2E * ap->in[18][ch]; bic[c] = -L2E * ap->in[20][ch]; spc[c] = -8.0f * L2E * ((const float*)(ws + OFF_SP))[ch]; }
    __syncthreads();
    bf16x8 Bg[4][2];
#pragma unroll
    for (int c = 0; c < 4; ++c)
#pragma unroll
        for (int ks = 0; ks < 2; ++ks) Bg[c][ks] = __builtin_bit_cast(bf16x8, BtL[(c * 2 + ks) * 64 + lane]);
    float hprev = 0.f;
    for (int blk = 0; blk < 16; ++blk) {
        if (blk + 1 < 16) LRU_LOAD(rawn, blk + 1);
        bf16x8 Af[2];
#pragma unroll
        for (int ks = 0; ks < 2; ++ks) { const int cc = 32 * ks + 8 * q; f32x4 a0 = *(const LAS f32x4*)(cbL + cc), a1 = *(const LAS f32x4*)(cbL + cc + 4);
#pragma unroll
            for (int tp = 0; tp < 4; ++tp) { f32x4 u0, u1; unpack8(raw[ks][tp], u0, u1); a0 += u0 * *(const LAS f32x4*)(cwL + tp * 64 + cc); a1 += u1 * *(const LAS f32x4*)(cwL + tp * 64 + cc + 4); }
            Af[ks] = __builtin_bit_cast(bf16x8, pack8(a0, a1));
}
#pragma unroll
        for (int c = 0; c < 4; ++c) {
            f32x4 Dr = __builtin_amdgcn_mfma_f32_16x16x32_bf16(Af[0], Bg[c][0], (f32x4){0.f, 0.f, 0.f, 0.f}, 0, 0, 0);
            Dr = __builtin_amdgcn_mfma_f32_16x16x32_bf16(Af[1], Bg[c][1], Dr, 0, 0, 0);
            f32x4 Di = __builtin_amdgcn_mfma_f32_16x16x32_bf16(Af[0], __builtin_bit_cast(bf16x8, BtL[((c + 4) * 2 + 0) * 64 + lane]), (f32x4){0.f, 0.f, 0.f, 0.f}, 0, 0, 0);
            Di = __builtin_amdgcn_mfma_f32_16x16x32_bf16(Af[1], __builtin_bit_cast(bf16x8, BtL[((c + 4) * 2 + 1) * 64 + lane]), Di, 0, 0, 0);
            f32x4 Dx = __builtin_amdgcn_mfma_f32_16x16x32_bf16(Af[0], __builtin_bit_cast(bf16x8, IdL[(c * 2 + 0) * 64 + lane]), (f32x4){0.f, 0.f, 0.f, 0.f}, 0, 0, 0);
            Dx = __builtin_amdgcn_mfma_f32_16x16x32_bf16(Af[1], __builtin_bit_cast(bf16x8, IdL[(c * 2 + 1) * 64 + lane]), Dx, 0, 0, 0);
#pragma unroll
            for (int i = 0; i < 4; ++i) { const int o = (4 * q + i) * 65 + c * 16 + r;
                const float rg = __builtin_amdgcn_rcpf(1.0f + __builtin_amdgcn_exp2f(__builtin_fmaf(Dr[i], -1.4426950408889634f, brc[c]))), ig = __builtin_amdgcn_rcpf(1.0f + __builtin_amdgcn_exp2f(__builtin_fmaf(Di[i], -1.4426950408889634f, bic[c])));
                const float a = __builtin_amdgcn_exp2f(rg * spc[c]); const float xv = Dx[i];
                aL[o] = a; xb[o] = __builtin_amdgcn_sqrtf(fmaxf(1.0f - a * a, 0.f)) * ig * xv; } }
        LAS float* ag = agg + (blk & 1) * 1024;
        float av[16], bv[16];
        {
#pragma unroll
          for (int tt = 0; tt < 16; ++tt) { av[tt] = aL[tt * 65 + lane]; bv[tt] = xb[tt * 65 + lane]; }
          float P = 1.f, H = 0.f;
#pragma unroll
          for (int tt = 0; tt < 16; ++tt) { H = av[tt] * H + bv[tt]; P *= av[tt]; }
          ag[(wave * 64 + lane) * 2] = P; ag[(wave * 64 + lane) * 2 + 1] = H; }
        __syncthreads();
        { float c = hprev, cin = 0.f;
#pragma unroll
          for (int ww = 0; ww < 8; ++ww) { if (ww == wave) cin = c; c = ag[(ww * 64 + lane) * 2] * c + ag[(ww * 64 + lane) * 2 + 1]; }
          hprev = c;
          float hh = cin;
#pragma unroll
          for (int tt = 0; tt < 16; ++tt) { hh = av[tt] * hh + bv[tt]; hL[tt * 64 + lane] = (bf16_t)(cvt_pk_bf16(hh, 0.f) & 0xffffu); } }
        { const int tt = lane >> 2, g16 = lane & 3; const LAS u32x4* hp = (const LAS u32x4*)(hL + tt * 64 + 16 * g16); const u32x4 h0 = hp[0], h1 = hp[1];
          u32x4* yo = (u32x4*)(YBp + (size_t)(blk * 128 + wave * 16 + tt) * 1536 + 16 * g16); yo[0] = h0; yo[1] = h1; }
#pragma unroll
        for (int ks = 0; ks < 2; ++ks)
#pragma unroll
            for (int tp = 0; tp < 4; ++tp) raw[ks][tp] = rawn[ks][tp];
    }
#undef LRU_LOAD
    __syncthreads();
}

__global__ void __launch_bounds__(512, 2) fwd_kernel(Args args) {
    extern __shared__ __attribute__((aligned(16))) unsigned char lds_raw[];
    LAS unsigned char* lds = (LAS unsigned char*)lds_raw;
    const int G = gridDim.x, bid = blockIdx.x, NT = G * 512, NGW = G * 8;
    const int wave_s = __builtin_amdgcn_readfirstlane((int)threadIdx.x >> 6);
    const int lo = args.ph_lo, hi = args.ph_hi;
    if (hi < 0) cg::this_grid().sync();
    unsigned n_bar = 0; (void)n_bar;
    const unsigned xcc = xb_xcc_id();
    if (hi - lo > 1) {
        if (wave_s == 0 && __builtin_amdgcn_mbcnt_hi(~0u, __builtin_amdgcn_mbcnt_lo(~0u, 0u)) == 0u) { ((volatile LAS unsigned*)(lds + 131072 + 64))[0] = 0u; ((volatile LAS unsigned*)(lds + 131072 + 64))[1] = 0u;
            (void)xb_add((unsigned*)(args.ws + OFF_BAR) + XB_XCNT(xcc), 1u); }
        __syncthreads();
    }
#ifndef PROBE_PH
#define PROBE_PH (-1)
#endif
#ifndef PROBE_MULT
#define PROBE_MULT 4
#endif
    unsigned long long pr_t0 = 0, pr_dt = 0; (void)pr_t0; (void)pr_dt;
#define PROBE_A(k) do { if (PROBE_PH == (k)) pr_t0 = __builtin_amdgcn_s_memrealtime(); } while (0)
#define PROBE_B(k) do { if (PROBE_PH == (k)) pr_dt = __builtin_amdgcn_s_memrealtime() - pr_t0; } while (0)
#ifndef PHMASK
#define PHMASK 0xFFF
#endif
#define IN(k) (((PHMASK >> (k)) & 1) && lo <= (k) && (k) < hi)
#define LEADER (wave_s == 0 && __builtin_amdgcn_mbcnt_hi(~0u, __builtin_amdgcn_mbcnt_lo(~0u, 0u)) == 0u)
#define SEAM(k) do { if (IN(k) && (IN((k) + 1) || ((k) == 2 && IN(5)))) { xcd_barrier((unsigned*)(kap->ws + OFF_BAR), xcc, (volatile LAS unsigned*)(lds + 131072 + 64), (unsigned)G, LEADER); } } while (0)
    typedef const __attribute__((address_space(4))) Args* KArgs;
    const KArgs kap = (KArgs)__builtin_amdgcn_kernarg_segment_ptr();
#define PH_BEGIN KArgs ap = kap; asm volatile("" : "+s"(ap)); unsigned char* const ws = ap->ws; float* const OUT = ap->out; (void)ws; (void)OUT; \
    int lane = (int)__builtin_amdgcn_mbcnt_hi(~0u, __builtin_amdgcn_mbcnt_lo(~0u, 0u)); asm volatile("" : "+v"(lane)); const int wave = wave_s, tid = wave * 64 + lane, gtid = bid * 512 + tid, gw = bid * 8 + wave; (void)gtid; (void)gw;
#define AIN(k) (ap->in[k])
#define WSP(T, off) ((T*)(ws + (off)))
    PROBE_A(0);
    if (IN(0)) {
        PH_BEGIN
        const bool g256 = (G == 256);
        if (g256) { if (bid < 128) s5_precompute(ap, ws, lds, bid >> 2, bid & 3, 4, tid); }
        else if (bid < 32) s5_precompute(ap, ws, lds, bid, 0, 1, tid);
        {
            const int npair = g256 ? 1024 : NGW, pr = g256 ? (gw & 1023) : gw, k_lo = g256 ? ((gw >> 10) ? 3 : 0) : 0, k_hi = g256 ? ((gw >> 10) ? 8 : 3) : (M / 2 + npair - 1) / npair;
            for (int k = k_lo; k < k_hi; ++k) { const int m = 2 * (pr + npair * k); if (m >= M) break;
                const f32x4* xr = (const f32x4*)(AIN(0) + (size_t)m * 1024) + lane; f32x4 v[8]; float s0 = 0.f, s1 = 0.f;
#pragma unroll
                for (int j = 0; j < 8; ++j) v[j] = __builtin_nontemporal_load(&xr[64 * j]);
#pragma unroll
                for (int j = 0; j < 4; ++j) { s0 += sq4(v[j]); s1 += sq4(v[4 + j]); }
                s0 = wave_sum(s0); s1 = wave_sum(s1); if (lane == 0) { WSP(float, OFF_SSQ0)[m] = s0; WSP(float, OFF_SSQ0)[m + 1] = s1; }
                u32x2* o = (u32x2*)((bf16_t*)OUT + (size_t)M * 1024   + (size_t)m * 1024) + lane;
#pragma unroll
                for (int j = 0; j < 8; ++j) { u32x2 w; w.x = cvt_pk_bf16(v[j][0], v[j][1]); w.y = cvt_pk_bf16(v[j][2], v[j][3]); o[64 * j] = w; } }
            LAS float* scr = (LAS float*)(lds + wave * 16384);
            const int wq = g256 ? gw - 1024 : gw, nW = g256 ? 1024 : NGW;
            if (wq >= 0) for (int it = wq; it < 16 * 112; it += nW) tr_item(AIN(3), 1024, INC, AIN(2), WSP(bf16_t, WS_WIN), 3, scr, it, lane);
        }
        for (int e = gtid; e < 1024; e += NT) WSP(float, OFF_SP)[e] = log1pf(expf(-AIN(21)[e]));
        for (int e = gtid; e < M; e += NT) { WSP(float, OFF_SSQ1)[e] = 0.f; WSP(float, OFF_SSQ2)[e] = 0.f; WSP(float, OFF_SSQ3)[e] = 0.f; WSP(float, OFF_SSQE)[e] = 0.f; }
    }
    SEAM(0);
    PROBE_B(0);
    PROBE_A(1);
    if (IN(1)) {
        PH_BEGIN
        pg8::Gemm g{(const bf16_t*)OUT + (size_t)M * 1024  , WSP(bf16_t, WS_WIN), 1024, 1024, 1024}; pg8::Sched S; S.init(64, 12, G, bid, (size_t)256 * 1024 * 2, 0, (size_t)256 * 1024 * 2, 0);
        EpiIn E{WSP(float, OFF_SSQ0), AIN(4), WSP(bf16_t, WS_UAS), (bf16_t*)OUT  , WSP(bf16_t, WS_GA), WSP(bf16_t, WS_GB), 0};
        pg8::gemm_phase(lds, g, S, E, tid);
    }
    SEAM(1);
    PROBE_B(1);
    PROBE_A(2);
    if (IN(2)) {
        PH_BEGIN
        if (PROBE_PH == 20) pr_t0 = __builtin_amdgcn_s_memrealtime();
        const int nL = (G >= 2) ? G / 2 : 1, nS = (G >= 2) ? G - nL : 1; const bool isL = (G < 2) || bid < nL, isS = (G < 2) || bid >= nL;
        if (isL) for (int unit = (G < 2) ? 0 : bid; unit < 128; unit += nL) lru_fused_unit(ap, ws, (const bf16_t*)OUT, lds, unit, wave);
        if (PROBE_PH == 20) pr_dt = __builtin_amdgcn_s_memrealtime() - pr_t0;
        if (PROBE_PH == 21) pr_t0 = __builtin_amdgcn_s_memrealtime();
        if (isS) for (int su = (G < 2) ? 0 : bid - nL; su < 128; su += nS) {
            const int g = su >> 2;
            int k256 = 256, k384 = 384; asm volatile("" : "+s"(k256), "+s"(k384));
            { pg8::Gemm gm{WSP(bf16_t, WS_UAS), WSP(bf16_t, WS_PM), 384, 256, k256}; pg8::OneUnit S{su, 0, (size_t)su * 256 * 384 * 2, (size_t)g * 256 * 256 * 2};
              EpiS5a E{WSP(float, WS_E)}; int lane1 = (int)__builtin_amdgcn_mbcnt_hi(~0u, __builtin_amdgcn_mbcnt_lo(~0u, 0u)); asm volatile("" : "+v"(lane1)); pg8::gemm_phase(lds, gm, S, E, wave * 64 + lane1); }
            int lane2 = (int)__builtin_amdgcn_mbcnt_hi(~0u, __builtin_amdgcn_mbcnt_lo(~0u, 0u)); asm volatile("" : "+v"(lane2));
            wg_publish(wave == 0 && lane2 == 0);
            for (int bb = 0; bb < 2; ++bb) { const int b = (su & 3) * 2 + bb, n = lane2;
                const float lr = AIN(5)[g * 64 + n], li = AIN(6)[g * 64 + n], dt = expf(AIN(7)[g]);
                const float mag = expf(16.0f * lr * dt); float sn, cs; sincosf(16.0f * (li * dt), &sn, &cs); const float ar = mag * cs, ai = mag * sn;
                const size_t row0 = (size_t)g * 1024 + b * 128 + wave * 16;
                float er[16], ei[16], lr_[16], li_[16];
#pragma unroll
                for (int j = 0; j < 16; ++j) { er[j] = WSP(float, WS_E)[(row0 + j) * 128 + n]; ei[j] = WSP(float, WS_E)[(row0 + j) * 128 + 64 + n]; }
                float sr = 0.f, si = 0.f;
#pragma unroll
                for (int j = 0; j < 16; ++j) { lr_[j] = sr; li_[j] = si; const float nr_ = ar * sr - ai * si + er[j], ni_ = ar * si + ai * sr + ei[j]; sr = nr_; si = ni_; }
                LAS float* segr = (LAS float*)lds; LAS float* segi = segr + 512;
                segr[wave * 64 + n] = sr; segi[wave * 64 + n] = si;
                float br = ar, bi = ai;
#pragma unroll
                for (int q = 0; q < 4; ++q) { const float t_ = br * br - bi * bi; bi = 2.0f * br * bi; br = t_; }
                __syncthreads();
                float cr = 0.f, ci = 0.f;
                for (int ww = 0; ww < wave; ++ww) { const float xr_ = segr[ww * 64 + n], xi_ = segi[ww * 64 + n]; const float t_ = br * cr - bi * ci + xr_; ci = br * ci + bi * cr + xi_; cr = t_; }
                float pr = 1.f, pi = 0.f;
#pragma unroll
                for (int j = 0; j < 16; ++j) { const float orr = lr_[j] + pr * cr - pi * ci, oii = li_[j] + pr * ci + pi * cr;
                    bf16_t* d = WSP(bf16_t, WS_UAS) + (row0 + j) * 384 + 256 + n; d[0] = (bf16_t)(cvt_pk_bf16(orr, 0.f) & 0xffffu); d[64] = (bf16_t)(cvt_pk_bf16(oii, 0.f) & 0xffffu);
                    const float t_ = pr * ar - pi * ai; pi = pr * ai + pi * ar; pr = t_; }
                __syncthreads();
            }
            wg_publish(wave == 0 && lane2 == 0);
            { pg8::Gemm gm{WSP(bf16_t, WS_UAS), WSP(bf16_t, WS_TQ), 384, 384, k384}; pg8::OneUnit S{su, 0, (size_t)su * 256 * 384 * 2, (size_t)g * 256 * 384 * 2};
              EpiS5b E{WSP(bf16_t, WS_ZG)}; pg8::gemm_phase(lds, gm, S, E, wave * 64 + lane2); }
        }
        if (isS) {
            int lane3 = (int)__builtin_amdgcn_mbcnt_hi(~0u, __builtin_amdgcn_mbcnt_lo(~0u, 0u)); asm volatile("" : "+v"(lane3));
            const int wq = ((G < 2) ? 0 : bid - nL) * 8 + wave, nW = nS * 8;
            LAS float* scr = (LAS float*)(lds + wave * 16384);
            constexpr int I_GLU = 8 * 16, I_A = 8 * 32, I_B = 16 * 32, I_O = 16 * 32, I_G = 16 * 88, I_U = 16 * 88, I_D = 44 * 32, I_PG = 16 * 32, I_PLE = 4 * 32;
            constexpr int NITEMS = I_GLU + I_A + I_B + I_O + I_D + I_PG + I_PLE; (void)I_G; (void)I_U;
            for (int it = wq; it < NITEMS; it += nW) {
                int r = it;
                if (r < I_GLU) { tr_item(AIN(13), 512, 512, nullptr, WSP(bf16_t, WS_WGLU), 0, scr, r, lane3); continue; } r -= I_GLU;
                if (r < I_A) { tr_item(AIN(22), 512, 1024, nullptr, WSP(bf16_t, WS_WA), 0, scr, r, lane3, 1536, 0); continue; } r -= I_A;
                if (r < I_B) { tr_item(AIN(23), 1024, 1024, nullptr, WSP(bf16_t, WS_WA), 0, scr, r, lane3, 1536, 512); continue; } r -= I_B;
                if (r < I_O) { tr_item(AIN(24), 1024, 1024, nullptr, WSP(bf16_t, WS_WO), 0, scr, r, lane3); continue; } r -= I_O;
                if (r < I_D) { tr_item(AIN(28), FFN, 1024, nullptr, WSP(bf16_t, WS_WD), 0, scr, r, lane3); continue; } r -= I_D;
                if (r < I_PG) { tr_item(AIN(30), 1024, 1024, AIN(29), WSP(bf16_t, WS_WPG), 0, scr, r, lane3); continue; } r -= I_PG;
                tr_item(AIN(32), 256, 1024, nullptr, WSP(bf16_t, WS_WPLE), 0, scr, r, lane3);
            }
            const int tq = ((G < 2) ? 0 : bid - nL) * 512 + wave * 64 + lane3, nT = nS * 512;
            for (int e = tq * 4; e < M * PLE / 8; e += nT * 4) { const f32x4* pp = (const f32x4*)(AIN(1)) + (size_t)e * 2; f32x4 v[8];
#pragma unroll
                for (int j = 0; j < 8; ++j) v[j] = __builtin_nontemporal_load(&pp[j]);
                u32x4* o = (u32x4*)(WSP(bf16_t, WS_PB) + (size_t)e * 8);
#pragma unroll
                for (int j = 0; j < 4; ++j) o[j] = pack8(v[2 * j], v[2 * j + 1]); }
        }
    }
    if (PROBE_PH == 21) pr_dt = __builtin_amdgcn_s_memrealtime() - pr_t0;
    SEAM(2);
    PROBE_B(2);
    PROBE_A(5);
    if (IN(5)) {
        PH_BEGIN
        pg8::Gemm g{WSP(bf16_t, WS_ZG), WSP(bf16_t, WS_WGLU), 512, 512, 512}; pg8::Sched S; S.init(64, 2, G, bid, (size_t)256 * 512 * 2, 0, (size_t)256 * 512 * 2, 0);
        EpiGlu E{WSP(bf16_t, WS_ZG), AIN(14), WSP(bf16_t, WS_YAB)};
        pg8::gemm_phase(lds, g, S, E, tid);
        {
            int lane5 = (int)__builtin_amdgcn_mbcnt_hi(~0u, __builtin_amdgcn_mbcnt_lo(~0u, 0u)); asm volatile("" : "+v"(lane5));
            pg8::Gemm g2{(const bf16_t*)OUT + (size_t)M * 1024  , WSP(bf16_t, WS_WIN) + (size_t)12 * 256 * 1024, 1024, 1024, 1024};
            pg8::Sched S2; S2.init(64, 2, G, (bid + G - G / 2) % G, (size_t)256 * 1024 * 2, 0, (size_t)256 * 1024 * 2, 0);
            EpiIn E2{WSP(float, OFF_SSQ0), AIN(4), WSP(bf16_t, WS_UAS), (bf16_t*)OUT, WSP(bf16_t, WS_GA), WSP(bf16_t, WS_GB), 12};
            pg8::gemm_phase(lds, g2, S2, E2, wave * 64 + lane5);
        }
        {
            const int nLo = (G >= 2) ? G / 2 : 1;
            if (bid < nLo) { int lane6 = (int)__builtin_amdgcn_mbcnt_hi(~0u, __builtin_amdgcn_mbcnt_lo(~0u, 0u)); asm volatile("" : "+v"(lane6));
                LAS float* scr = (LAS float*)(lds + wave * 16384);
                for (int it = bid * 8 + wave; it < 2 * 16 * 88; it += nLo * 8) {
                    if (it < 16 * 88) tr_item(AIN(26), 1024, FFN, AIN(25), WSP(bf16_t, WS_WGU), 1, scr, it, lane6);
                    else tr_item(AIN(27), 1024, FFN, AIN(25), WSP(bf16_t, WS_WGU), 2, scr, it - 16 * 88, lane6); } }
        }
    }
    SEAM(5);
    PROBE_B(5);
    PROBE_A(6);
    if (IN(6)) {
        PH_BEGIN
        pg8::Gemm g{WSP(bf16_t, WS_YAB), WSP(bf16_t, WS_WA), 1536, 1536, 1536}; pg8::Sched S; S.init(64, 4, G, bid, (size_t)256 * 1536 * 2, 0, (size_t)256 * 1536 * 2, 0);
        EpiMg E{WSP(bf16_t, WS_GB), WSP(bf16_t, WS_MG)}; MidGate Mh{8, WSP(bf16_t, WS_GA)  };
        pg8::gemm_phase(lds, g, S, E, tid, Mh);
    }
    SEAM(6);
    PROBE_B(6);
    PROBE_A(7);
    if (IN(7)) {
        PH_BEGIN
        pg8::Gemm g{WSP(bf16_t, WS_MG), WSP(bf16_t, WS_WO), 1024, 1024, 1024}; pg8::Sched S; S.init(64, 4, G, bid, (size_t)256 * 1024 * 2, 0, (size_t)256 * 1024 * 2, 0);
        EpiRes E{nullptr, (const bf16_t*)OUT + (size_t)M * 1024  , WSP(bf16_t, WS_XB)  , WSP(float, OFF_SSQ1)};
        pg8::gemm_phase(lds, g, S, E, tid);
    }
    SEAM(7);
    PROBE_B(7);
    PROBE_A(8);
    if (IN(8)) {
        PH_BEGIN
        pg8::Gemm g{WSP(bf16_t, WS_XB)  , WSP(bf16_t, WS_WGU), 1024, 1024, 1024}; pg8::Sched S; S.init(64, 22, G, bid, (size_t)256 * 1024 * 2, 0, (size_t)256 * 1024 * 2, 0);
        EpiFfn E{WSP(float, OFF_SSQ1), WSP(bf16_t, WS_ACT)};
        pg8::gemm_phase(lds, g, S, E, tid);
        {
            const int b0 = (G >= 2) ? G / 2 : 0, nB = G - b0;
            if (bid >= b0) { int lane4 = (int)__builtin_amdgcn_mbcnt_hi(~0u, __builtin_amdgcn_mbcnt_lo(~0u, 0u)); asm volatile("" : "+v"(lane4));
                pg8::Gemm g2{WSP(bf16_t, WS_PB), WSP(bf16_t, WS_WPLE), 256, 256, 256}; pg8::Sched S2; S2.init(64, 4, nB, bid - b0, (size_t)256 * 256 * 2, 0, (size_t)256 * 256 * 2, 0);
                EpiEraw E2{WSP(bf16_t, WS_GA), WSP(float, OFF_SSQE)}; pg8::gemm_phase(lds, g2, S2, E2, wave * 64 + lane4); }
        }
    }
    SEAM(8);
    PROBE_B(8);
    PROBE_A(9);
    if (IN(9)) {
        PH_BEGIN
        { pg8::Gemm g{WSP(bf16_t, WS_ACT), WSP(bf16_t, WS_WD), FFN, FFN, FFN}; pg8::Sched S; S.init(64, 4, G, bid, (size_t)256 * FFN * 2, 0, (size_t)256 * FFN * 2, 0);
          EpiRes E{nullptr, WSP(bf16_t, WS_XB)  , WSP(bf16_t, WS_XB)  , WSP(float, OFF_SSQ2)}; pg8::gemm_phase(lds, g, S, E, tid); }
    }
    SEAM(9);
    PROBE_B(9);
    PROBE_A(10);
    if (IN(10)) {
        PH_BEGIN
        int kq = 1024; asm volatile("" : "+s"(kq));
        pg8::Gemm g{WSP(bf16_t, WS_XB)  , WSP(bf16_t, WS_WPG), 1024, 1024, kq}; pg8::Sched S; S.init(64, 4, G, bid, (size_t)256 * 1024 * 2, 0, (size_t)256 * 1024 * 2, 0);
        EpiPg E{WSP(float, OFF_SSQ2), WSP(float, OFF_SSQE), AIN(31), AIN(33), WSP(bf16_t, WS_GA)  , WSP(bf16_t, WS_XB)  , WSP(float, OFF_SSQ3), (unsigned*)(ws + OFF_BAR + 16384), AIN(34), OUT};
        pg8::gemm_phase(lds, g, S, E, tid);
    }
    PROBE_B(10);
    if (PROBE_PH == 11) pr_dt = __builtin_amdgcn_s_memrealtime() - pr_t0;
    if (PROBE_PH == 12) { for (int i = 0; i < 16; ++i) xcd_barrier((unsigned*)(kap->ws + OFF_BAR), xcc, (volatile LAS unsigned*)(lds + 131072 + 64), (unsigned)G, LEADER); }
    if (PROBE_PH >= 0 && PROBE_PH != 12) { const unsigned long long t1 = __builtin_amdgcn_s_memrealtime(); while (__builtin_amdgcn_s_memrealtime() - t1 < (unsigned long long)PROBE_MULT * pr_dt) __builtin_amdgcn_s_sleep(8); }
#undef IN
#undef SEAM
}

constexpr int LDS_BYTES = 147456;
extern "C" void kernel_launch(void* const* d_in, const int* in_sizes, int n_in, void* d_out, int out_size, void* d_ws, size_t ws_size, hipStream_t stream) {
    static int grid = 0;
    if (grid == 0) {
        int dev = 0, cus = 0, per_cu = 0;
        hipGetDevice(&dev); hipDeviceGetAttribute(&cus, hipDeviceAttributeMultiprocessorCount, dev);
        if (hipFuncSetAttribute((const void*)fwd_kernel, hipFuncAttributeMaxDynamicSharedMemorySize, LDS_BYTES) != hipSuccess) { fprintf(stderr, "kernel_launch: hipFuncSetAttribute failed\n"); grid = -1; return; }
        if (hipOccupancyMaxActiveBlocksPerMultiprocessor(&per_cu, (const void*)fwd_kernel, 512, LDS_BYTES) != hipSuccess || per_cu < 1) { fprintf(stderr, "kernel_launch: occupancy query says %d\n", per_cu); per_cu = 1; }
        (void)hipGetLastError();
        if (cus <= 0) cus = 256;
        grid = cus * per_cu;
        if (n_in != 35 || ws_size < WS_END) { fprintf(stderr, "kernel_launch: unexpected n_in %d / ws_size %zu\n", n_in, ws_size); grid = -1; return; }
    }
    if (grid < 0) return;
    (void)hipMemsetAsync((char*)d_ws + OFF_BAR, 0, 32768, stream);
    Args a{};
    for (int i = 0; i < 35; ++i) a.in[i] = (const float*)d_in[i];
    a.out = (float*)d_out; a.ws = (unsigned char*)d_ws;
#if MK_N_LAUNCHES == 1
    a.ph_lo = 0; a.ph_hi = NPH;
    void* kargs[] = {&a};
    hipError_t e = hipLaunchCooperativeKernel((const void*)fwd_kernel, dim3(grid), dim3(512), kargs, LDS_BYTES, stream);
    if (e != hipSuccess) fprintf(stderr, "kernel_launch: cooperative launch failed: %s (grid %d)\n", hipGetErrorString(e), grid);
#else
    for (int ph = 0; ph < NPH; ++ph) { a.ph_lo = ph; a.ph_hi = ph + 1; hipLaunchKernelGGL(fwd_kernel, dim3(grid), dim3(512), LDS_BYTES, stream, a); }
#endif
}
```

```cpp
#include <hip/hip_runtime.h>
#include <hip/hip_cooperative_groups.h>
#include <cstdio>
#include <cstdint>
namespace cg = cooperative_groups;

#ifndef MK_N_LAUNCHES
#define MK_N_LAUNCHES 1
#endif

#define LAS __attribute__((address_space(3)))
typedef unsigned short bf16_t;
typedef short bf16x8 __attribute__((ext_vector_type(8)));
typedef float f32x4 __attribute__((ext_vector_type(4)));
typedef unsigned u32x4 __attribute__((ext_vector_type(4)));
typedef unsigned u32x2 __attribute__((ext_vector_type(2)));

constexpr int M = 16384, DM = 1024, SEQ = 2048, INC = 3584, FFN = 2816, PLE = 256;
constexpr float EPS = 1e-6f;
constexpr int NPH = 12;

constexpr size_t MiB = 1u << 20;
constexpr size_t WS_CTL = 0;
constexpr size_t OFF_BAR = 524288;
constexpr size_t OFF_SSQ0 = 0, OFF_SSQ1 = 65536, OFF_SSQ2 = 131072, OFF_SSQ3 = 196608, OFF_SSQE = 262144, OFF_SP = 327680;
constexpr size_t WS_WIN = 1 * MiB, WS_WGLU = 8 * MiB, WS_WPLE = 8 * MiB + 512 * 1024, WS_WA = 9 * MiB, WS_WB = 10 * MiB, WS_WO = 12 * MiB, WS_WGU = 14 * MiB,
                 WS_WD = 25 * MiB, WS_WPG = 31 * MiB, WS_PM = 33 * MiB, WS_TQ = 37 * MiB, WS_WLRU = 43 * MiB;
constexpr size_t WS_PB = 44 * MiB;
constexpr size_t WS_GA = 52 * MiB, WS_GB = 84 * MiB;
constexpr size_t WS_XB = 116 * MiB;
constexpr size_t WS_UB = 148 * MiB;
constexpr size_t WS_UAS = 180 * MiB;
constexpr size_t WS_E = 228 * MiB;
constexpr size_t WS_ZG = 204 * MiB;
constexpr size_t WS_YAB = 116 * MiB;
constexpr size_t WS_MG = 164 * MiB;
constexpr size_t WS_ACT = 148 * MiB;
constexpr size_t WS_END = 256 * MiB;

__device__ __forceinline__ unsigned cvt_pk_bf16(float lo, float hi) { unsigned r; asm volatile("v_cvt_pk_bf16_f32 %0, %1, %2" : "=v"(r) : "v"(lo), "v"(hi)); return r; }
__device__ __forceinline__ u32x4 pack8(const f32x4 a, const f32x4 b) { u32x4 w; w.x = cvt_pk_bf16(a[0], a[1]); w.y = cvt_pk_bf16(a[2], a[3]); w.z = cvt_pk_bf16(b[0], b[1]); w.w = cvt_pk_bf16(b[2], b[3]); return w; }
__device__ __forceinline__ void unpack8(const u32x4 w, f32x4& a, f32x4& b) {
    a[0] = __uint_as_float(w.x << 16); a[1] = __uint_as_float(w.x & 0xffff0000u); a[2] = __uint_as_float(w.y << 16); a[3] = __uint_as_float(w.y & 0xffff0000u);
    b[0] = __uint_as_float(w.z << 16); b[1] = __uint_as_float(w.z & 0xffff0000u); b[2] = __uint_as_float(w.w << 16); b[3] = __uint_as_float(w.w & 0xffff0000u);
}
__device__ __forceinline__ float bf2f(bf16_t h) { return __uint_as_float((unsigned)h << 16); }
__device__ __forceinline__ float sigm(float x) { return __builtin_amdgcn_rcpf(1.0f + __expf(-x)); }
__device__ __forceinline__ f32x4 sigm4(f32x4 v) { f32x4 o; o[0] = sigm(v[0]); o[1] = sigm(v[1]); o[2] = sigm(v[2]); o[3] = sigm(v[3]); return o; }
__device__ __forceinline__ float gelu_tanh(float y) { const float t = 1.5957691216057308f * (y + 0.044715f * y * y * y); return y * sigm(t); }
__device__ __forceinline__ float sq4(f32x4 v) { return (v[0] * v[0] + v[1] * v[1]) + (v[2] * v[2] + v[3] * v[3]); }
__device__ __forceinline__ float rstd_of(float ssq) { return rsqrtf(ssq * (1.0f / 1024.0f) + EPS); }
__device__ __forceinline__ float wave_sum(float v) {
#pragma unroll
    for (int o = 1; o < 64; o <<= 1) v += __shfl_xor(v, o);
    return v;
}

#define XB_TMO      128
#define XB_XCNT(j)  (256  + 64 * (j))
#define XB_XSUB(j)  (1280 + 64 * (j))
#define XB_XGEN(j)  (2304 + 64 * (j))
#define XB_TOP      3328
#define XB_TOPGEN   3392
#define XCD_BAR_WORDS 3456
#define XB_SPIN_CAP (1u << 18)
__device__ __forceinline__ unsigned xb_ld(unsigned* p)              { return __hip_atomic_load(p, __ATOMIC_RELAXED, __HIP_MEMORY_SCOPE_AGENT); }
__device__ __forceinline__ unsigned xb_add(unsigned* p, unsigned v) { return __hip_atomic_fetch_add(p, v, __ATOMIC_RELAXED, __HIP_MEMORY_SCOPE_AGENT); }
__device__ __forceinline__ unsigned xb_xcc_id() { return (unsigned)__builtin_amdgcn_s_getreg((3 << 11) | 20) & 0xFu; }
#define XB_SPIN(cond, bar) do { unsigned _sp = 0; while (cond) { __builtin_amdgcn_s_sleep(1); \
    if ((++_sp & 255u) == 0u) { if (xb_ld(&(bar)[XB_TMO])) break; if (_sp > XB_SPIN_CAP) { atomicAdd(&(bar)[XB_TMO], 1u); break; } } } } while (0)
__device__ __forceinline__ void xcd_barrier_complete(unsigned* bar, unsigned x, unsigned G, unsigned& nloc, unsigned& nx) {
    unsigned sum, cnt, mine, sp = 0u;
    for (;;) {
        sum = 0u; cnt = 0u; mine = 0u;
#pragma unroll
        for (unsigned j = 0; j < 16; ++j) { const unsigned c = xb_ld(&bar[XB_XCNT(j)]); sum += c; cnt += (c > 0u) ? 1u : 0u; mine = (j == x) ? c : mine; }
        if (sum == G) break;
        __builtin_amdgcn_s_sleep(1);
        if ((++sp & 255u) == 0u) { if (xb_ld(&bar[XB_TMO])) break; if (sp > XB_SPIN_CAP) { atomicAdd(&bar[XB_TMO], 1u); break; } }
    }
    nloc = mine > 0u ? mine : 1u; nx = cnt > 0u ? cnt : 1u;
}
__device__ __forceinline__ void xcd_barrier(unsigned* bar, unsigned x, volatile LAS unsigned* st, unsigned G, bool leader) {
    asm volatile("s_waitcnt vmcnt(0)" ::: "memory");
    __syncthreads();
    if (leader) {
        __builtin_amdgcn_s_waitcnt(0);
        unsigned nloc = st[0], nx = st[1];
        if (nloc == 0u) { xcd_barrier_complete(bar, x, G, nloc, nx); st[0] = nloc; st[1] = nx; }
        const unsigned old = xb_add(&bar[XB_XSUB(x)], 1u);
        const unsigned gen = old / nloc;
        if (old + 1u == (gen + 1u) * nloc) {
            __builtin_amdgcn_fence(__ATOMIC_RELEASE, "agent");
            asm volatile("s_waitcnt vmcnt(0)" ::: "memory");
            const unsigned og = xb_add(&bar[XB_TOP], 1u);
            const unsigned tg = og / nx;
            if (og + 1u == (tg + 1u) * nx) xb_add(&bar[XB_TOPGEN], 1u);
            else XB_SPIN(xb_ld(&bar[XB_TOPGEN]) == tg, bar);
            __builtin_amdgcn_fence(__ATOMIC_ACQUIRE, "agent");
            xb_add(&bar[XB_XGEN(x)], 1u);
            asm volatile("s_waitcnt vmcnt(0)" ::: "memory");
        } else {
            XB_SPIN(xb_ld(&bar[XB_XGEN(x)]) == gen, bar);
            __builtin_amdgcn_fence(__ATOMIC_ACQUIRE, "agent");
            asm volatile("s_waitcnt vmcnt(0)" ::: "memory");
        }
    }
    __syncthreads();
}

namespace pg8 {
constexpr int BM = 256, BK = 64, HALF = 128, HTB = HALF * BK * 2, STAGE_BYTES = 8 * HTB, NXCD = 8, WGM = 8;
__host__ __device__ __forceinline__ int lds_byte(int r, int c) { const int st = (r >> 4) * 2 + (c >> 5), rr = r & 15, cc = c & 31, ob = rr * 64 + cc * 2; return st * 1024 + (ob ^ (((ob >> 9) & 1) << 5)); }
__host__ __device__ __forceinline__ void stage_rc(int b, int& R, int& C) { const int st = b / 1024, sb = b % 1024, swz = sb ^ (((sb >> 9) & 1) << 5); R = (st >> 1) * 16 + swz / 64; C = (st & 1) * 32 + (swz % 64) / 2; }
__host__ __device__ __forceinline__ int perm32(int rho) { const int n = rho >> 4, i = rho & 15; return 8 * (i >> 2) + 4 * n + (i & 3); }

struct Unit { int pm, pn; size_t aoff, boff; };
struct Gemm { const bf16_t* A; const bf16_t* Bt; int lda, ldb, K; };

struct Sched {
    int nM, nN, nwg, G, c;
    size_t a_pm, a_pn, b_pn, b_grp; int a_pn_shift;
    __device__ __forceinline__ void init(int nM_, int nN_, int G_, int c_, size_t a_pm_, size_t a_pn_, size_t b_pn_, size_t b_grp_) {
        nM = nM_; nN = nN_; nwg = nM * nN; G = G_; c = c_; a_pm = a_pm_; a_pn = a_pn_; b_pn = b_pn_; b_grp = b_grp_; a_pn_shift = 0; }
    __device__ __forceinline__ bool next(int i, Unit& u) const {
        const long L = (long)i * G + c; if (L >= nwg) return false;
        int wgid = (int)L; { const int q = nwg / NXCD, r = nwg % NXCD, xcd = wgid % NXCD, off = wgid / NXCD; wgid = (xcd < r ? xcd * (q + 1) : r * (q + 1) + (xcd - r) * q) + off; }
        const int nig = WGM * nN, gid = wgid / nig, fm = gid * WGM, gsz = (nM - fm) < WGM ? (nM - fm) : WGM;
        u.pm = fm + ((wgid % nig) % gsz); u.pn = (wgid % nig) / gsz;
        u.aoff = (size_t)u.pm * a_pm + (size_t)(u.pn >> a_pn_shift) * a_pn; u.boff = (size_t)u.pn * b_pn + (size_t)(u.pm >> 2) * b_grp;
        return true;
    }
};

struct OneUnit {
    int pm, pn; size_t aoff, boff;
    __device__ __forceinline__ bool next(int i, Unit& u) const { if (i != 0) return false; u.pm = pm; u.pn = pn; u.aoff = aoff; u.boff = boff; return true; }
};

struct NoMid { static constexpr bool ENABLED = false; int mid_t; template <class A, class U> __device__ __forceinline__ void operator()(A&, const U&, int, int, int, int) const {} };
template <class Epi, class SchedT, class Mid = NoMid, bool ALIGN = true>
__device__ __forceinline__ void gemm_phase(LAS unsigned char* lds, const Gemm g, const SchedT& S, const Epi& E, int tid_, const Mid Mh = Mid{}) {
    asm volatile("" : "+v"(tid_));
    const int tid = tid_, wid = __builtin_amdgcn_readfirstlane(tid >> 6), lane = tid & 63, wr = wid >> 2, wc = wid & 3, fr = lane & 15, fq = lane >> 4;
    const int nt = g.K / BK;
    unsigned voffA[2], voffB[2];
#pragma unroll
    for (int i = 0; i < 2; ++i) { int R, C; stage_rc(tid * 16 + i * 8192, R, C); const int Rb = (R & ~31) + perm32(R & 31);
        voffA[i] = (unsigned)(R * g.lda + C) * 2u; voffB[i] = (unsigned)(Rb * g.ldb + C) * 2u; }
    const size_t kstep = (size_t)(BK * 2);
    const size_t hstepA = (size_t)HALF * g.lda * 2, hstepB = (size_t)HALF * g.ldb * 2;
    const unsigned ldsw = (unsigned)wid * 1024u;
    const int aoff = lds_byte(wr * 64 + fr, fq * 8), boff = lds_byte(wc * 32 + fr, fq * 8);
#define PG8_SA(b, h) (((b) * 2 + (h)) * HTB)
#define PG8_SB(b, h) ((4 + (b) * 2 + (h)) * HTB)
#define PG8_STAGE(bufoff, gbase, voff) do { _Pragma("unroll") for (int _i = 0; _i < 2; ++_i) \
        __builtin_amdgcn_global_load_lds((const unsigned*)((const char*)(gbase) + (voff)[_i]), (LAS unsigned*)(lds + (bufoff) + ldsw + _i * 8192), 16, 0, 0); } while (0)
#define PG8_LDA(dst, b, h) do { _Pragma("unroll") for (int m = 0; m < 4; ++m) _Pragma("unroll") for (int k = 0; k < 2; ++k) dst[m][k] = *(const LAS bf16x8*)(lds + PG8_SA(b, h) + aoff + m * 2048 + k * 1024); } while (0)
#define PG8_LDB(dst, b, h) do { _Pragma("unroll") for (int n = 0; n < 2; ++n) _Pragma("unroll") for (int k = 0; k < 2; ++k) dst[n][k] = *(const LAS bf16x8*)(lds + PG8_SB(b, h) + boff + n * 2048 + k * 1024); } while (0)
#define PG8_MMA(ai, bj, At, Bt) do { __builtin_amdgcn_s_setprio(1); _Pragma("unroll") for (int m = 0; m < 4; ++m) _Pragma("unroll") for (int n = 0; n < 2; ++n) _Pragma("unroll") for (int k = 0; k < 2; ++k) \
        acc[ai][bj][m][n] = __builtin_amdgcn_mfma_f32_16x16x32_bf16(Bt[n][k], At[m][k], acc[ai][bj][m][n], 0, 0, 0); __builtin_amdgcn_s_setprio(0); } while (0)
#define PG8_WAIT_V(n) asm volatile("s_waitcnt vmcnt(" #n ")" ::: "memory")
#define PG8_WAIT_L(n) asm volatile("s_waitcnt lgkmcnt(" #n ")" ::: "memory")
#define PG8_BAR __builtin_amdgcn_s_barrier()
#define PG8_SCHED __builtin_amdgcn_sched_barrier(0)
    Unit cur, nxt; int ui = 0;
    if (!S.next(0, cur)) return;
    f32x4 acc[2][2][4][2];
#pragma unroll
    for (int a = 0; a < 2; ++a)
#pragma unroll
        for (int b = 0; b < 2; ++b)
#pragma unroll
            for (int m = 0; m < 4; ++m)
#pragma unroll
                for (int n = 0; n < 2; ++n) acc[a][b][m][n] = (f32x4){0.f, 0.f, 0.f, 0.f};
    bf16x8 At[4][2], B0[2][2], B1[2][2];
    const char* cA = (const char*)g.A + cur.aoff; const char* cB = (const char*)g.Bt + cur.boff;
    PG8_STAGE(PG8_SB(0, 0), cB, voffB); PG8_STAGE(PG8_SB(0, 1), cB + hstepB, voffB); PG8_STAGE(PG8_SA(0, 0), cA, voffA); PG8_STAGE(PG8_SA(0, 1), cA + hstepA, voffA);
    if (wr == 1) PG8_BAR;
    PG8_WAIT_V(2); PG8_BAR;
    PG8_STAGE(PG8_SB(1, 0), cB + kstep, voffB); PG8_STAGE(PG8_SA(1, 0), cA + kstep, voffA); PG8_STAGE(PG8_SB(1, 1), cB + hstepB + kstep, voffB);
    PG8_WAIT_V(6); PG8_BAR;
    for (;;) {
        const bool has_next = S.next(ui + 1, nxt);
        const char* nA = has_next ? (const char*)g.A + nxt.aoff : cA; const char* nB = has_next ? (const char*)g.Bt + nxt.boff : cB;
        for (int t = 0; t < nt; t += 2) {
            if constexpr (Mid::ENABLED) { if (t == Mh.mid_t) { int fr_e = fr, fq_e = fq; asm volatile("" : "+v"(fr_e), "+v"(fq_e)); Mh(acc, cur, wr, wc, fr_e, fq_e); } }
            const bool last = (t == nt - 2);
            const char* a1 = cA + (size_t)(t + 1) * kstep;
            const char* a2 = last ? nA : cA + (size_t)(t + 2) * kstep; const char* b2 = last ? nB : cB + (size_t)(t + 2) * kstep;
            const char* a3 = a2 + kstep; const char* b3 = b2 + kstep;
            PG8_LDB(B0, 0, 0); PG8_LDB(B1, 0, 1); PG8_SCHED; PG8_LDA(At, 0, 0); PG8_STAGE(PG8_SA(1, 1), a1 + hstepA, voffA);
            PG8_WAIT_V(8); PG8_WAIT_L(0); PG8_BAR; PG8_MMA(0, 0, At, B0); PG8_MMA(0, 1, At, B1); PG8_BAR; PG8_SCHED;
            PG8_LDA(At, 0, 1); PG8_STAGE(PG8_SB(0, 0), b2, voffB); PG8_STAGE(PG8_SB(0, 1), b2 + hstepB, voffB); PG8_STAGE(PG8_SA(0, 0), a2, voffA);
            PG8_WAIT_V(8); PG8_WAIT_L(0); PG8_BAR; PG8_MMA(1, 0, At, B0); PG8_MMA(1, 1, At, B1); PG8_BAR; PG8_SCHED;
            PG8_LDB(B0, 1, 0); PG8_LDB(B1, 1, 1); PG8_SCHED; PG8_LDA(At, 1, 0); PG8_STAGE(PG8_SA(0, 1), a2 + hstepA, voffA);
            PG8_WAIT_V(8); PG8_WAIT_L(0); PG8_BAR; PG8_MMA(0, 0, At, B0); PG8_MMA(0, 1, At, B1); PG8_BAR; PG8_SCHED;
            PG8_LDA(At, 1, 1); PG8_STAGE(PG8_SB(1, 0), b3, voffB); PG8_STAGE(PG8_SB(1, 1), b3 + hstepB, voffB); PG8_STAGE(PG8_SA(1, 0), a3, voffA);
            PG8_WAIT_V(8); PG8_WAIT_L(0); PG8_BAR; PG8_MMA(1, 0, At, B0); PG8_MMA(1, 1, At, B1); PG8_BAR; PG8_SCHED;
        }
        if constexpr (ALIGN) { if (wr == 0) PG8_BAR; }
        { int fr_e = fr, fq_e = fq; asm volatile("" : "+v"(fr_e), "+v"(fq_e)); E(acc, cur, wr, wc, fr_e, fq_e); }
        if (!has_next) break;
#pragma unroll
        for (int a = 0; a < 2; ++a)
#pragma unroll
            for (int b = 0; b < 2; ++b)
#pragma unroll
                for (int m = 0; m < 4; ++m)
#pragma unroll
                    for (int n = 0; n < 2; ++n) acc[a][b][m][n] = (f32x4){0.f, 0.f, 0.f, 0.f};
        cur = nxt; cA = nA; cB = nB; ++ui;
        if constexpr (ALIGN) { if (wr == 1) PG8_BAR; }
    }
    PG8_WAIT_V(0);
    if constexpr (!ALIGN) { if (wr == 0) PG8_BAR; }
    PG8_BAR;
#undef PG8_SA
#undef PG8_SB
#undef PG8_STAGE
#undef PG8_LDA
#undef PG8_LDB
#undef PG8_MMA
#undef PG8_WAIT_V
#undef PG8_WAIT_L
#undef PG8_BAR
#undef PG8_SCHED
}
}

typedef f32x4 AccT[2][2][4][2];
#define EPI_ROWS(ai, m) _Pragma("unroll") for (int ai = 0; ai < 2; ++ai) _Pragma("unroll") for (int m = 0; m < 4; ++m)
#define EPI_ROW(u, ai, m) ((u).pm * 256 + (ai) * 128 + wr * 64 + (m) * 16 + fr)
#define EPI_LCOL(bj) ((bj) * 128 + wc * 32 + 8 * fq)
__device__ __forceinline__ void row_atomic(float* dst, float s, int fq) { s += __shfl_xor(s, 16); s += __shfl_xor(s, 32); if (fq == 0) atomicAdd(dst, s); }

struct EpiIn {
    const float* ssq0; const float* b_in; bf16_t* UAS; bf16_t* UB; bf16_t* GR; bf16_t* GB; int pn0;
    __device__ __forceinline__ void operator()(const AccT& acc, const pg8::Unit& u, int wr, int wc, int fr, int fq) const {
        const int upn = u.pn + pn0;
        if (upn >= 6) { const int ch = (upn - 6) * 128 + wc * 32 + 8 * fq; const float NL = -1.4426950408889634f;
            const f32x4 ba0 = *(const f32x4*)(b_in + 1536 + ch) * NL, ba1 = *(const f32x4*)(b_in + 1536 + ch + 4) * NL, bb0 = *(const f32x4*)(b_in + 2560 + ch) * NL, bb1 = *(const f32x4*)(b_in + 2560 + ch + 4) * NL;
            EPI_ROWS(ai, m) { const int row = EPI_ROW(u, ai, m); const float rs = rstd_of(ssq0[row]) * NL; f32x4 r0, r1, g0, g1;
#pragma unroll
                for (int j = 0; j < 4; ++j) {
                    const float ea0 = __builtin_amdgcn_exp2f(__builtin_fmaf(acc[ai][0][m][0][j], rs, ba0[j])), ea1 = __builtin_amdgcn_exp2f(__builtin_fmaf(acc[ai][0][m][1][j], rs, ba1[j]));
                    const float eb0 = fminf(__builtin_amdgcn_exp2f(__builtin_fmaf(acc[ai][1][m][0][j], rs, bb0[j])), 1e30f), eb1 = fminf(__builtin_amdgcn_exp2f(__builtin_fmaf(acc[ai][1][m][1][j], rs, bb1[j])), 1e30f);
                    g0[j] = __builtin_amdgcn_rcpf(1.0f + eb0); g1[j] = __builtin_amdgcn_rcpf(1.0f + eb1);
                    r0[j] = (1.0f + eb0) * __builtin_amdgcn_rcpf(1.0f + ea0); r1[j] = (1.0f + eb1) * __builtin_amdgcn_rcpf(1.0f + ea1); }
                *(u32x4*)(GR + (size_t)row * 1024 + ch) = pack8(r0, r1); *(u32x4*)(GB + (size_t)row * 1024 + ch) = pack8(g0, g1); }
            return; }
        EPI_ROWS(ai, m) { const int row = EPI_ROW(u, ai, m); const float rs = rstd_of(ssq0[row]);
#pragma unroll
            for (int bj = 0; bj < 2; ++bj) { const int col = upn * 256 + EPI_LCOL(bj);
                const f32x4 b0 = *(const f32x4*)(b_in + col), b1 = *(const f32x4*)(b_in + col + 4);
                const f32x4 v0 = acc[ai][bj][m][0] * rs + b0, v1 = acc[ai][bj][m][1] * rs + b1;
                bf16_t* dst;
                if (upn < 2) { const int g = col >> 4, q = col & 15, b = row >> 11, l = row & 2047, c = l >> 4, t = l & 15;
                    dst = UAS + ((size_t)(g * 1024 + b * 128 + c) * 384 + t * 16 + q); }
                else dst = UB + (size_t)row * 1024 + (col - 512);
                *(u32x4*)dst = pack8(v0, v1); } }
    }
};
struct EpiEraw {
    bf16_t* ERAW; float* ssqe;
    __device__ __forceinline__ void operator()(const AccT& acc, const pg8::Unit& u, int wr, int wc, int fr, int fq) const {
        EPI_ROWS(ai, m) { const int row = EPI_ROW(u, ai, m); float s = 0.f;
#pragma unroll
            for (int bj = 0; bj < 2; ++bj) { const int col = u.pn * 256 + EPI_LCOL(bj); const f32x4 v0 = acc[ai][bj][m][0], v1 = acc[ai][bj][m][1];
                s += sq4(v0) + sq4(v1); *(u32x4*)(ERAW + (size_t)row * 1024 + col) = pack8(v0, v1); }
            row_atomic(ssqe + row, s, fq); }
    }
};
struct EpiS5a {
    float* E;
    __device__ __forceinline__ void operator()(const AccT& acc, const pg8::Unit& u, int wr, int wc, int fr, int fq) const {
        EPI_ROWS(ai, m) { const int row = EPI_ROW(u, ai, m); float* dst = E + (size_t)row * 128 + EPI_LCOL(0);
            *(f32x4*)dst = acc[ai][0][m][0]; *(f32x4*)(dst + 4) = acc[ai][0][m][1]; }
    }
};
struct EpiS5b {
    bf16_t* ZG;
    __device__ __forceinline__ void operator()(const AccT& acc, const pg8::Unit& u, int wr, int wc, int fr, int fq) const {
        const int lc = wc * 32 + 8 * fq;
        const int t0 = lc >> 4, p = lc & 15;
        EPI_ROWS(ai, m) { const int row = EPI_ROW(u, ai, m); const int g = row >> 10, b = (row >> 7) & 7, c = row & 127;
            bf16_t* dst = ZG + (size_t)(b * 2048 + c * 16 + t0) * 512 + g * 16 + p;
#pragma unroll
            for (int bj = 0; bj < 2; ++bj) { u32x2 w[2];
#pragma unroll
                for (int n = 0; n < 2; ++n) { f32x4 v = acc[ai][bj][m][n];
#pragma unroll
                    for (int j = 0; j < 4; ++j) v[j] = gelu_tanh(v[j]);
                    w[n].x = cvt_pk_bf16(v[0], v[1]); w[n].y = cvt_pk_bf16(v[2], v[3]); }
                *(u32x4*)(dst + bj * 8 * 512) = (u32x4){w[0].x, w[0].y, w[1].x, w[1].y};
                asm volatile("" ::: "memory"); } }
    }
};
struct EpiLru {
    const float* b_r; const float* b_i; const float* sp; const bf16_t* XC; float* AA; bf16_t* BX;
    __device__ __forceinline__ void operator()(const AccT& acc, const pg8::Unit& u, int wr, int wc, int fr, int fq) const {
        const int ch = u.pn * 128 + wc * 32 + 8 * fq;
        EPI_ROWS(ai, m) { const int row = EPI_ROW(u, ai, m); const size_t off = (size_t)row * 1024 + ch;
            const u32x4 xw = *(const u32x4*)(XC + off); f32x4 xx[2]; unpack8(xw, xx[0], xx[1]); u32x2 hw[2];
#pragma unroll
            for (int n = 0; n < 2; ++n) {
                const f32x4 r = sigm4(acc[ai][0][m][n] + *(const f32x4*)(b_r + ch + 4 * n)), ig = sigm4(acc[ai][1][m][n] + *(const f32x4*)(b_i + ch + 4 * n)), s4 = *(const f32x4*)(sp + ch + 4 * n);
                f32x4 a, h;
#pragma unroll
                for (int j = 0; j < 4; ++j) { a[j] = __expf(-8.0f * r[j] * s4[j]); h[j] = sqrtf(fmaxf(1.0f - a[j] * a[j], 0.f)) * ig[j] * xx[n][j]; }
                *(f32x4*)(AA + off + 4 * n) = a; hw[n].x = cvt_pk_bf16(h[0], h[1]); hw[n].y = cvt_pk_bf16(h[2], h[3]); }
            *(u32x4*)(BX + off) = (u32x4){hw[0].x, hw[0].y, hw[1].x, hw[1].y};
            asm volatile("" ::: "memory"); }
    }
};
struct EpiGlu {
    const bf16_t* ZG; const float* b_glu; bf16_t* YA;
    __device__ __forceinline__ void operator()(const AccT& acc, const pg8::Unit& u, int wr, int wc, int fr, int fq) const {
        EPI_ROWS(ai, m) { const int row = EPI_ROW(u, ai, m);
#pragma unroll
            for (int bj = 0; bj < 2; ++bj) { const int col = u.pn * 256 + EPI_LCOL(bj); const size_t off = (size_t)row * 512 + col;
                f32x4 z0, z1; unpack8(*(const u32x4*)(ZG + off), z0, z1);
                const f32x4 s0 = sigm4(acc[ai][bj][m][0] + *(const f32x4*)(b_glu + col)), s1 = sigm4(acc[ai][bj][m][1] + *(const f32x4*)(b_glu + col + 4));
                *(u32x4*)(YA + (size_t)row * 1536 + col) = pack8(z0 * s0, z1 * s1); } }
    }
};
struct MidGate {
    static constexpr bool ENABLED = true; int mid_t; const bf16_t* GR;
    __device__ __forceinline__ void operator()(AccT& acc, const pg8::Unit& u, int wr, int wc, int fr, int fq) const {
#pragma unroll
        for (int ai = 0; ai < 2; ++ai) { u32x4 gr[4][2];
#pragma unroll
            for (int m = 0; m < 4; ++m)
#pragma unroll
                for (int bj = 0; bj < 2; ++bj) gr[m][bj] = *(const u32x4*)(GR + (size_t)EPI_ROW(u, ai, m) * 1024 + u.pn * 256 + EPI_LCOL(bj));
#pragma unroll
            for (int m = 0; m < 4; ++m)
#pragma unroll
                for (int bj = 0; bj < 2; ++bj) { f32x4 a0, a1; unpack8(gr[m][bj], a0, a1); acc[ai][bj][m][0] *= a0; acc[ai][bj][m][1] *= a1; }
            asm volatile("" ::: "memory"); }
    }
};
struct EpiMg {
    const bf16_t* GB; bf16_t* MG;
    __device__ __forceinline__ void operator()(const AccT& acc, const pg8::Unit& u, int wr, int wc, int fr, int fq) const {
#pragma unroll
        for (int ai = 0; ai < 2; ++ai) { u32x4 gb[4][2];
#pragma unroll
            for (int m = 0; m < 4; ++m)
#pragma unroll
                for (int bj = 0; bj < 2; ++bj) gb[m][bj] = *(const u32x4*)(GB + (size_t)EPI_ROW(u, ai, m) * 1024 + u.pn * 256 + EPI_LCOL(bj));
#pragma unroll
            for (int m = 0; m < 4; ++m)
#pragma unroll
                for (int bj = 0; bj < 2; ++bj) { f32x4 g0, g1; unpack8(gb[m][bj], g0, g1);
                    *(u32x4*)(MG + (size_t)EPI_ROW(u, ai, m) * 1024 + u.pn * 256 + EPI_LCOL(bj)) = pack8(g0 * acc[ai][bj][m][0], g1 * acc[ai][bj][m][1]); }
            asm volatile("" ::: "memory"); }
    }
};
struct EpiRes {
    const float* xi; const bf16_t* xib; bf16_t* XBo; float* ssq;
    __device__ __forceinline__ void operator()(const AccT& acc, const pg8::Unit& u, int wr, int wc, int fr, int fq) const {
#pragma unroll
        for (int ai = 0; ai < 2; ++ai) { u32x4 rw[4][2];
#pragma unroll
            for (int m = 0; m < 4; ++m)
#pragma unroll
                for (int bj = 0; bj < 2; ++bj) rw[m][bj] = *(const u32x4*)(xib + (size_t)EPI_ROW(u, ai, m) * 1024 + u.pn * 256 + EPI_LCOL(bj));
#pragma unroll
            for (int m = 0; m < 4; ++m) { const int row = EPI_ROW(u, ai, m); float s = 0.f;
#pragma unroll
                for (int bj = 0; bj < 2; ++bj) { const size_t off = (size_t)row * 1024 + u.pn * 256 + EPI_LCOL(bj);
                    f32x4 r0, r1; unpack8(rw[m][bj], r0, r1);
                    const f32x4 v0 = r0 + acc[ai][bj][m][0], v1 = r1 + acc[ai][bj][m][1];
                    s += sq4(v0) + sq4(v1);
                    *(u32x4*)(XBo + off) = pack8(v0, v1); }
                row_atomic(ssq + row, s, fq); }
            asm volatile("" ::: "memory"); }
    }
};
struct EpiFfn {
    const float* ssq1; bf16_t* ACT;
    __device__ __forceinline__ void operator()(const AccT& acc, const pg8::Unit& u, int wr, int wc, int fr, int fq) const {
        const int hc = u.pn * 128 + wc * 32 + 8 * fq;
        EPI_ROWS(ai, m) { const int row = EPI_ROW(u, ai, m); const float rs = rstd_of(ssq1[row]);
            f32x4 g0 = acc[ai][0][m][0] * rs, g1 = acc[ai][0][m][1] * rs; const f32x4 u0 = acc[ai][1][m][0] * rs, u1 = acc[ai][1][m][1] * rs;
            g0 = g0 * sigm4(g0) * u0; g1 = g1 * sigm4(g1) * u1;
            *(u32x4*)(ACT + (size_t)row * FFN + hc) = pack8(g0, g1); }
    }
};
struct EpiPg {
    const float* ssq2; const float* ssqe; const float* b_pg; const float* g_ple; const bf16_t* ERAW; const bf16_t* X2B; float* ssq3; unsigned* cnt; const float* g_final; float* out;
    __device__ __forceinline__ void operator()(AccT& acc, const pg8::Unit& u, int wr, int wc, int fr, int fq) const {
#pragma unroll
        for (int ai = 0; ai < 2; ++ai)
#pragma unroll
        for (int mp = 0; mp < 2; ++mp) { u32x4 ew[2][2], xw[2][2];
#pragma unroll
            for (int mm = 0; mm < 2; ++mm)
#pragma unroll
                for (int bj = 0; bj < 2; ++bj) { const size_t off = (size_t)EPI_ROW(u, ai, mp * 2 + mm) * 1024 + u.pn * 256 + EPI_LCOL(bj); ew[mm][bj] = *(const u32x4*)(ERAW + off); xw[mm][bj] = *(const u32x4*)(X2B + off); }
#pragma unroll
            for (int mm = 0; mm < 2; ++mm) { const int m = mp * 2 + mm; const int row = EPI_ROW(u, ai, m); const float rs = rstd_of(ssq2[row]), re = rstd_of(ssqe[row]); float s = 0.f;
#pragma unroll
                for (int bj = 0; bj < 2; ++bj) { const int col = u.pn * 256 + EPI_LCOL(bj);
                    f32x4 e0, e1, x0, x1; unpack8(ew[mm][bj], e0, e1); unpack8(xw[mm][bj], x0, x1);
                    const f32x4 gt0 = sigm4(acc[ai][bj][m][0] * rs + *(const f32x4*)(b_pg + col)), gt1 = sigm4(acc[ai][bj][m][1] * rs + *(const f32x4*)(b_pg + col + 4));
                    const f32x4 v0 = x0 + gt0 * (e0 * re * *(const f32x4*)(g_ple + col)), v1 = x1 + gt1 * (e1 * re * *(const f32x4*)(g_ple + col + 4));
                    s += sq4(v0) + sq4(v1);
                    acc[ai][bj][m][0] = v0; acc[ai][bj][m][1] = v1; }
                s += __shfl_xor(s, 16); s += __shfl_xor(s, 32);
                if (fq == 0) { const float old = __hip_atomic_fetch_add(ssq3 + row, s, __ATOMIC_RELAXED, __HIP_MEMORY_SCOPE_AGENT); asm volatile("" :: "v"(old)); } }
            asm volatile("" ::: "memory"); }
        asm volatile("s_waitcnt vmcnt(0)" ::: "memory");
        unsigned* c = cnt + 64 * u.pm;
        if (__builtin_amdgcn_mbcnt_hi(~0u, __builtin_amdgcn_mbcnt_lo(~0u, 0u)) == 0u) (void)__hip_atomic_fetch_add(c, 1u, __ATOMIC_RELAXED, __HIP_MEMORY_SCOPE_AGENT);
        { unsigned spins = 0; while ((unsigned)__builtin_amdgcn_readfirstlane((int)__hip_atomic_load(c, __ATOMIC_RELAXED, __HIP_MEMORY_SCOPE_AGENT)) < 32u) { __builtin_amdgcn_s_sleep(2); if (++spins > (1u << 22)) break; } }
#pragma unroll
        for (int ai = 0; ai < 2; ++ai)
#pragma unroll
            for (int m = 0; m < 4; ++m) { const int row = EPI_ROW(u, ai, m); const float rs = rstd_of(__hip_atomic_load(ssq3 + row, __ATOMIC_RELAXED, __HIP_MEMORY_SCOPE_AGENT));
#pragma unroll
                for (int bj = 0; bj < 2; ++bj) { const int col = u.pn * 256 + EPI_LCOL(bj); float* o = out + (size_t)row * 1024 + col;
                    *(f32x4*)o = acc[ai][bj][m][0] * rs * *(const f32x4*)(g_final + col); *(f32x4*)(o + 4) = acc[ai][bj][m][1] * rs * *(const f32x4*)(g_final + col + 4); } }
    }
};

__device__ __forceinline__ void tr_item(const float* W, int K, int N, const float* gk, bf16_t* WT, int mode, LAS float* scr, int item, int lane, int ldd = 0, int koff = 0) {
    if (ldd == 0) ldd = K;
    const int nblk = N / 32, kb = item / nblk, nb = item % nblk, k0 = 64 * kb, n0 = 32 * nb;
    float tv[32];
#pragma unroll
    for (int i = 0; i < 32; ++i) { const int kk = 2 * i + (lane >> 5); tv[i] = __builtin_nontemporal_load(&W[(size_t)(k0 + kk) * N + n0 + (lane & 31)]); }
#pragma unroll
    for (int i = 0; i < 32; ++i) { const int kk = 2 * i + (lane >> 5); float v = tv[i]; if (gk) v *= gk[k0 + kk]; scr[kk * 33 + (lane & 31)] = v; }
    asm volatile("s_waitcnt lgkmcnt(0)" ::: "memory");
    const int c = lane & 7;
#pragma unroll
    for (int j = 0; j < 4; ++j) { const int n = (lane >> 3) + 8 * j; const LAS float* s = scr + (8 * c) * 33 + n;
        u32x4 o; o.x = cvt_pk_bf16(s[0 * 33], s[1 * 33]); o.y = cvt_pk_bf16(s[2 * 33], s[3 * 33]); o.z = cvt_pk_bf16(s[4 * 33], s[5 * 33]); o.w = cvt_pk_bf16(s[6 * 33], s[7 * 33]);
        const int nn = n0 + n; int drow;
        if (mode == 0) drow = nn; else if (mode == 3) { if (nn < 1536) drow = nn; else { const int gbs = nn >= 2560, c_ = nn - (gbs ? 2560 : 1536); drow = 1536 + 256 * (c_ >> 7) + gbs * 128 + (c_ & 127); } }
        else drow = 256 * (nn >> 7) + (mode - 1) * 128 + (nn & 127);
        *(u32x4*)(WT + (size_t)drow * ldd + koff + k0 + 8 * c) = o; }
    asm volatile("s_waitcnt lgkmcnt(0)" ::: "memory");
}

struct Args { const float* in[35]; float* out; unsigned char* ws; int ph_lo, ph_hi; };

template <class KA> __device__ __forceinline__ void s5_precompute(KA a, unsigned char* ws, LAS unsigned char* lds, int g, int part, int nparts, int tid) {
    const int tau_lo = part * (16 / nparts), tau_hi = tau_lo + 16 / nparts, row_lo = part * (256 / nparts), row_hi = row_lo + 256 / nparts;
    LAS float* PWr = (LAS float*)lds;
    LAS float* PWi = PWr + 17 * 64;
    LAS float* BBr = PWi + 17 * 64;
    LAS float* BBi = BBr + 1024;
    LAS float* Cr = BBi + 1024;
    LAS float* Ci = Cr + 1024;
    LAS float* Kt = Ci + 1024;
    const float* lam_re = a->in[5] + g * 64; const float* lam_im = a->in[6] + g * 64; const float dt = expf(a->in[7][g]);
    const float* b_re = a->in[8] + g * 1024; const float* b_im = a->in[9] + g * 1024; const float* c_re = a->in[10] + g * 1024; const float* c_im = a->in[11] + g * 1024;
    const float* dsk = a->in[12] + g * 16;
    for (int e = tid; e < 17 * 64; e += 512) { const int k = e >> 6, n = e & 63; const float lr = lam_re[n], li = lam_im[n];
        const float mag = expf((float)k * lr * dt); float s, c; sincosf((float)k * (li * dt), &s, &c); PWr[e] = mag * c; PWi[e] = mag * s; }
    for (int e = tid; e < 1024; e += 512) { const int n = e >> 4; const float lr = lam_re[n], li = lam_im[n];
        const float mag = expf(lr * dt); float s, c; sincosf(li * dt, &s, &c); const float ar = mag * c, ai = mag * s, den = lr * lr + li * li, nr = ar - 1.0f;
        const float fr = (nr * lr + ai * li) / den, fi = (ai * lr - nr * li) / den; const float br = b_re[e], bi = b_im[e];
        BBr[e] = fr * br - fi * bi; BBi[e] = fr * bi + fi * br; Cr[e] = c_re[e]; Ci[e] = c_im[e]; }
    __syncthreads();
    for (int e = tau_lo * 256 + tid; e < tau_hi * 256; e += 512) { const int tau = e >> 8, p = (e >> 4) & 15, q = e & 15; float s = 0.f;
        for (int n = 0; n < 64; ++n) { const float pr = PWr[tau * 64 + n], pi = PWi[tau * 64 + n], br = BBr[n * 16 + q], bi = BBi[n * 16 + q];
            const float wr_ = pr * br - pi * bi, wi_ = pr * bi + pi * br; s += Cr[p * 64 + n] * wr_ - Ci[p * 64 + n] * wi_; }
        if (tau == 0 && p == q) s += dsk[p];
        Kt[e] = s; }
    __syncthreads();
    bf16_t* PMg = (bf16_t*)(ws + WS_PM) + (size_t)g * 256 * 256;
    bf16_t* TQg = (bf16_t*)(ws + WS_TQ) + (size_t)g * 256 * 384;
    for (int e = tid; e < 256 * 32; e += 512) { const int row = e >> 5, cgp = e & 31, t = row >> 4, p = row & 15, s = cgp >> 1, q0 = (cgp & 1) * 8;
        f32x4 v0 = {0.f, 0.f, 0.f, 0.f}, v1 = v0;
        if (s <= t ? (t - s < tau_lo || t - s >= tau_hi) : (part != 0)) continue;
        if (s <= t) { const LAS float* kp = Kt + (t - s) * 256 + p * 16 + q0; v0 = (f32x4){kp[0], kp[1], kp[2], kp[3]}; v1 = (f32x4){kp[4], kp[5], kp[6], kp[7]}; }
        *(u32x4*)(TQg + (size_t)row * 384 + s * 16 + q0) = pack8(v0, v1); }
    for (int e = row_lo * 16 + tid; e < row_hi * 16; e += 512) { const int row = e >> 4, cgp = e & 15, t = row >> 4, p = row & 15, half = cgp >> 3, n0 = (cgp & 7) * 8;
        float v[8];
#pragma unroll
        for (int j = 0; j < 8; ++j) { const int n = n0 + j; const float cr = Cr[p * 64 + n], ci = Ci[p * 64 + n], pr = PWr[(t + 1) * 64 + n], pi = PWi[(t + 1) * 64 + n];
            v[j] = half == 0 ? (cr * pr - ci * pi) : -(cr * pi + ci * pr); }
        *(u32x4*)(TQg + (size_t)row * 384 + 256 + half * 64 + n0) = pack8((f32x4){v[0], v[1], v[2], v[3]}, (f32x4){v[4], v[5], v[6], v[7]}); }
    for (int e = row_lo * 32 + tid; e < row_hi * 32; e += 512) { const int row = e >> 5, cgp = e & 31, s = cgp >> 1, q0 = (cgp & 1) * 8;
        float v[8];
#pragma unroll
        for (int j = 0; j < 8; ++j) v[j] = 0.f;
        if (row < 128) { const int n = row & 63, im = row >> 6; const float pr = PWr[(15 - s) * 64 + n], pi = PWi[(15 - s) * 64 + n];
#pragma unroll
            for (int j = 0; j < 8; ++j) { const float br = BBr[n * 16 + q0 + j], bi = BBi[n * 16 + q0 + j]; v[j] = im == 0 ? (pr * br - pi * bi) : (pr * bi + pi * br); } }
        *(u32x4*)(PMg + (size_t)row * 256 + s * 16 + q0) = pack8((f32x4){v[0], v[1], v[2], v[3]}, (f32x4){v[4], v[5], v[6], v[7]}); }
    __syncthreads();
}

__device__ __forceinline__ bf16x8 pack8s(const float (&t)[8]) { u32x4 w; w.x = cvt_pk_bf16(t[0], t[1]); w.y = cvt_pk_bf16(t[2], t[3]); w.z = cvt_pk_bf16(t[4], t[5]); w.w = cvt_pk_bf16(t[6], t[7]); return __builtin_bit_cast(bf16x8, w); }
__device__ __forceinline__ void wg_publish(bool leader) {
    asm volatile("s_waitcnt vmcnt(0)" ::: "memory"); __syncthreads();
    if (leader) { __builtin_amdgcn_fence(__ATOMIC_ACQUIRE, "agent"); asm volatile("s_waitcnt vmcnt(0)" ::: "memory"); }
    __syncthreads();
}

template <class KA>
__device__ __forceinline__ void lru_fused_unit(KA ap, unsigned char* ws, const bf16_t* UBg, LAS unsigned char* lds, int unit, int wave) {
    int lane = (int)__builtin_amdgcn_mbcnt_hi(~0u, __builtin_amdgcn_mbcnt_lo(~0u, 0u)); asm volatile("" : "+v"(lane));
    const int b = unit >> 4, h = unit & 15, ch0 = h * 64;
    const int r = lane & 15, q = lane >> 4;
    LAS float* xb = (LAS float*)(lds + wave * 10368);
    LAS float* aL = xb + 16 * 65;
    LAS bf16_t* hL = (LAS bf16_t*)(aL + 16 * 65);
    LAS float* agg = (LAS float*)(lds + 83968);
    LAS float* cwL = (LAS float*)(lds + 92160); LAS float* cbL = cwL + 256;
    LAS u32x4* BtL = (LAS u32x4*)(lds + 93696);
    LAS u32x4* IdL = (LAS u32x4*)(lds + 110080);
    const bf16_t* UBp = UBg + (size_t)b * 2048 * 1024 + ch0 + 8 * q;
    bf16_t* YBp = (bf16_t*)(ws + WS_YAB) + (size_t)b * 2048 * 1536 + 512 + ch0;
    u32x4 raw[2][4], rawn[2][4];
#define LRU_LOAD(dst, blk_) do { const int l0_ = (blk_) * 128 + wave * 16 + r - 3; _Pragma("unroll") for (int ks = 0; ks < 2; ++ks) _Pragma("unroll") for (int tp = 0; tp < 4; ++tp) { \
        const int l_ = l0_ + tp; dst[ks][tp] = (l_ >= 0) ? *(const u32x4*)(UBp + (size_t)(l_ < 0 ? 0 : l_) * 1024 + 32 * ks) : (u32x4){0u, 0u, 0u, 0u}; } } while (0)
    LRU_LOAD(raw, 0);
    { const int t_ = wave * 64 + lane; if (t_ < 256) cwL[t_] = ap->in[15][(t_ >> 6) * 1024 + ch0 + (t_ & 63)]; else if (t_ < 320) cbL[t_ - 256] = ap->in[16][ch0 + (t_ - 256)];
#pragma unroll
      for (int e2 = 0; e2 < 2; ++e2) { const int e = t_ + 512 * e2, c = e >> 7, ks = (e >> 6) & 1, ln = e & 63, rr = ln & 15, qq = ln >> 4;
          const float* w = ((c < 4) ? ap->in[17] : ap->in[19]) + h * 4096 + (c & 3) * 16 + rr; float t[8];
#pragma unroll
          for (int j = 0; j < 8; ++j) t[j] = w[(32 * ks + 8 * qq + j) * 64];
          BtL[e] = __builtin_bit_cast(u32x4, pack8s(t)); }
      { const int c = t_ >> 7, ks = (t_ >> 6) & 1, ln = t_ & 63, rr = ln & 15, qq = ln >> 4; float t[8];
#pragma unroll
        for (int j = 0; j < 8; ++j) t[j] = (32 * ks + 8 * qq + j == 16 * c + rr) ? 1.0f : 0.0f;
        IdL[t_] = __builtin_bit_cast(u32x4, pack8s(t)); } }
    float brc[4], bic[4], spc[4];
#pragma unroll
    for (int c = 0; c < 4; ++c) { const int ch = ch0 + c * 16 + r; const float L2E = 1.4426950408889634f; brc[c] = -L2E * ap->in[18][ch]; bic[c] = -L2E * ap->in[20][ch]; spc[c] = -8.0f * L2E * ((const float*)(ws + OFF_SP))[ch]; }
    __syncthreads();
    bf16x8 Bg[4][2];
#pragma unroll
    for (int c = 0; c < 4; ++c)
#pragma unroll
        for (int ks = 0; ks < 2; ++ks) Bg[c][ks] = __builtin_bit_cast(bf16x8, BtL[(c * 2 + ks) * 64 + lane]);
    float hprev = 0.f;
    for (int blk = 0; blk < 16; ++blk) {
        if (blk + 1 < 16) LRU_LOAD(rawn, blk + 1);
        bf16x8 Af[2];
#pragma unroll
        for (int ks = 0; ks < 2; ++ks) { const int cc = 32 * ks + 8 * q; f32x4 a0 = *(const LAS f32x4*)(cbL + cc), a1 = *(const LAS f32x4*)(cbL + cc + 4);
#pragma unroll
            for (int tp = 0; tp < 4; ++tp) { f32x4 u0, u1; unpack8(raw[ks][tp], u0, u1); a0 += u0 * *(const LAS f32x4*)(cwL + tp * 64 + cc); a1 += u1 * *(const LAS f32x4*)(cwL + tp * 64 + cc + 4); }
            Af[ks] = __builtin_bit_cast(bf16x8, pack8(a0, a1));
}
#pragma unroll
        for (int c = 0; c < 4; ++c) {
            f32x4 Dr = __builtin_amdgcn_mfma_f32_16x16x32_bf16(Af[0], Bg[c][0], (f32x4){0.f, 0.f, 0.f, 0.f}, 0, 0, 0);
            Dr = __builtin_amdgcn_mfma_f32_16x16x32_bf16(Af[1], Bg[c][1], Dr, 0, 0, 0);
            f32x4 Di = __builtin_amdgcn_mfma_f32_16x16x32_bf16(Af[0], __builtin_bit_cast(bf16x8, BtL[((c + 4) * 2 + 0) * 64 + lane]), (f32x4){0.f, 0.f, 0.f, 0.f}, 0, 0, 0);
            Di = __builtin_amdgcn_mfma_f32_16x16x32_bf16(Af[1], __builtin_bit_cast(bf16x8, BtL[((c + 4) * 2 + 1) * 64 + lane]), Di, 0, 0, 0);
            f32x4 Dx = __builtin_amdgcn_mfma_f32_16x16x32_bf16(Af[0], __builtin_bit_cast(bf16x8, IdL[(c * 2 + 0) * 64 + lane]), (f32x4){0.f, 0.f, 0.f, 0.f}, 0, 0, 0);
            Dx = __builtin_amdgcn_mfma_f32_16x16x32_bf16(Af[1], __builtin_bit_cast(bf16x8, IdL[(c * 2 + 1) * 64 + lane]), Dx, 0, 0, 0);
#pragma unroll
            for (int i = 0; i < 4; ++i) { const int o = (4 * q + i) * 65 + c * 16 + r;
                const float rg = __builtin_amdgcn_rcpf(1.0f + __builtin_amdgcn_exp2f(__builtin_fmaf(Dr[i], -1.4426950408889634f, brc[c]))), ig = __builtin_amdgcn_rcpf(1.0f + __builtin_amdgcn_exp2f(__builtin_fmaf(Di[i], -1.4426950408889634f, bic[c])));
                const float a = __builtin_amdgcn_exp2f(rg * spc[c]); const float xv = Dx[i];
                aL[o] = a; xb[o] = __builtin_amdgcn_sqrtf(fmaxf(1.0f - a * a, 0.f)) * ig * xv; } }
        LAS float* ag = agg + (blk & 1) * 1024;
        float av[16], bv[16];
        {
#pragma unroll
          for (int tt = 0; tt < 16; ++tt) { av[tt] = aL[tt * 65 + lane]; bv[tt] = xb[tt * 65 + lane]; }
          float P = 1.f, H = 0.f;
#pragma unroll
          for (int tt = 0; tt < 16; ++tt) { H = av[tt] * H + bv[tt]; P *= av[tt]; }
          ag[(wave * 64 + lane) * 2] = P; ag[(wave * 64 + lane) * 2 + 1] = H; }
        __syncthreads();
        { float c = hprev, cin = 0.f;
#pragma unroll
          for (int ww = 0; ww < 8; ++ww) { if (ww == wave) cin = c; c = ag[(ww * 64 + lane) * 2] * c + ag[(ww * 64 + lane) * 2 + 1]; }
          hprev = c;
          float hh = cin;
#pragma unroll
          for (int tt = 0; tt < 16; ++tt) { hh = av[tt] * hh + bv[tt]; hL[tt * 64 + lane] = (bf16_t)(cvt_pk_bf16(hh, 0.f) & 0xffffu); } }
        { const int tt = lane >> 2, g16 = lane & 3; const LAS u32x4* hp = (const LAS u32x4*)(hL + tt * 64 + 16 * g16); const u32x4 h0 = hp[0], h1 = hp[1];
          u32x4* yo = (u32x4*)(YBp + (size_t)(blk * 128 + wave * 16 + tt) * 1536 + 16 * g16); yo[0] = h0; yo[1] = h1; }
#pragma unroll
        for (int ks = 0; ks < 2; ++ks)
#pragma unroll
            for (int tp = 0; tp < 4; ++tp) raw[ks][tp] = rawn[ks][tp];
    }
#undef LRU_LOAD
    __syncthreads();
}

__global__ void __launch_bounds__(512, 2) fwd_kernel(Args args) {
    extern __shared__ __attribute__((aligned(16))) unsigned char lds_raw[];
    LAS unsigned char* lds = (LAS unsigned char*)lds_raw;
    const int G = gridDim.x, bid = blockIdx.x, NT = G * 512, NGW = G * 8;
    const int wave_s = __builtin_amdgcn_readfirstlane((int)threadIdx.x >> 6);
    const int lo = args.ph_lo, hi = args.ph_hi;
    if (hi < 0) cg::this_grid().sync();
    unsigned n_bar = 0; (void)n_bar;
    const unsigned xcc = xb_xcc_id();
    if (hi - lo > 1) {
        if (wave_s == 0 && __builtin_amdgcn_mbcnt_hi(~0u, __builtin_amdgcn_mbcnt_lo(~0u, 0u)) == 0u) { ((volatile LAS unsigned*)(lds + 131072 + 64))[0] = 0u; ((volatile LAS unsigned*)(lds + 131072 + 64))[1] = 0u;
            (void)xb_add((unsigned*)(args.ws + OFF_BAR) + XB_XCNT(xcc), 1u); }
        __syncthreads();
    }
#ifndef PROBE_PH
#define PROBE_PH (-1)
#endif
#ifndef PROBE_MULT
#define PROBE_MULT 4
#endif
    unsigned long long pr_t0 = 0, pr_dt = 0; (void)pr_t0; (void)pr_dt;
#define PROBE_A(k) do { if (PROBE_PH == (k)) pr_t0 = __builtin_amdgcn_s_memrealtime(); } while (0)
#define PROBE_B(k) do { if (PROBE_PH == (k)) pr_dt = __builtin_amdgcn_s_memrealtime() - pr_t0; } while (0)
#ifndef PHMASK
#define PHMASK 0xFFF
#endif
#define IN(k) (((PHMASK >> (k)) & 1) && lo <= (k) && (k) < hi)
#define LEADER (wave_s == 0 && __builtin_amdgcn_mbcnt_hi(~0u, __builtin_amdgcn_mbcnt_lo(~0u, 0u)) == 0u)
#define SEAM(k) do { if (IN(k) && (IN((k) + 1) || ((k) == 2 && IN(5)))) { xcd_barrier((unsigned*)(kap->ws + OFF_BAR), xcc, (volatile LAS unsigned*)(lds + 131072 + 64), (unsigned)G, LEADER); } } while (0)
    typedef const __attribute__((address_space(4))) Args* KArgs;
    const KArgs kap = (KArgs)__builtin_amdgcn_kernarg_segment_ptr();
#define PH_BEGIN KArgs ap = kap; asm volatile("" : "+s"(ap)); unsigned char* const ws = ap->ws; float* const OUT = ap->out; (void)ws; (void)OUT; \
    int lane = (int)__builtin_amdgcn_mbcnt_hi(~0u, __builtin_amdgcn_mbcnt_lo(~0u, 0u)); asm volatile("" : "+v"(lane)); const int wave = wave_s, tid = wave * 64 + lane, gtid = bid * 512 + tid, gw = bid * 8 + wave; (void)gtid; (void)gw;
#define AIN(k) (ap->in[k])
#define WSP(T, off) ((T*)(ws + (off)))
    PROBE_A(0);
    if (IN(0)) {
        PH_BEGIN
        const bool g256 = (G == 256);
        if (g256) { if (bid < 128) s5_precompute(ap, ws, lds, bid >> 2, bid & 3, 4, tid); }
        else if (bid < 32) s5_precompute(ap, ws, lds, bid, 0, 1, tid);
        {
            const int npair = g256 ? 1024 : NGW, pr = g256 ? (gw & 1023) : gw, k_lo = g256 ? ((gw >> 10) ? 3 : 0) : 0, k_hi = g256 ? ((gw >> 10) ? 8 : 3) : (M / 2 + npair - 1) / npair;
            for (int k = k_lo; k < k_hi; ++k) { const int m = 2 * (pr + npair * k); if (m >= M) break;
                const f32x4* xr = (const f32x4*)(AIN(0) + (size_t)m * 1024) + lane; f32x4 v[8]; float s0 = 0.f, s1 = 0.f;
#pragma unroll
                for (int j = 0; j < 8; ++j) v[j] = __builtin_nontemporal_load(&xr[64 * j]);
#pragma unroll
                for (int j = 0; j < 4; ++j) { s0 += sq4(v[j]); s1 += sq4(v[4 + j]); }
                s0 = wave_sum(s0); s1 = wave_sum(s1); if (lane == 0) { WSP(float, OFF_SSQ0)[m] = s0; WSP(float, OFF_SSQ0)[m + 1] = s1; }
                u32x2* o = (u32x2*)((bf16_t*)OUT + (size_t)M * 1024   + (size_t)m * 1024) + lane;
#pragma unroll
                for (int j = 0; j < 8; ++j) { u32x2 w; w.x = cvt_pk_bf16(v[j][0], v[j][1]); w.y = cvt_pk_bf16(v[j][2], v[j][3]); o[64 * j] = w; } }
            LAS float* scr = (LAS float*)(lds + wave * 16384);
            const int wq = g256 ? gw - 1024 : gw, nW = g256 ? 1024 : NGW;
            if (wq >= 0) for (int it = wq; it < 16 * 112; it += nW) tr_item(AIN(3), 1024, INC, AIN(2), WSP(bf16_t, WS_WIN), 3, scr, it, lane);
        }
        for (int e = gtid; e < 1024; e += NT) WSP(float, OFF_SP)[e] = log1pf(expf(-AIN(21)[e]));
        for (int e = gtid; e < M; e += NT) { WSP(float, OFF_SSQ1)[e] = 0.f; WSP(float, OFF_SSQ2)[e] = 0.f; WSP(float, OFF_SSQ3)[e] = 0.f; WSP(float, OFF_SSQE)[e] = 0.f; }
    }
    SEAM(0);
    PROBE_B(0);
    PROBE_A(1);
    if (IN(1)) {
        PH_BEGIN
        pg8::Gemm g{(const bf16_t*)OUT + (size_t)M * 1024  , WSP(bf16_t, WS_WIN), 1024, 1024, 1024}; pg8::Sched S; S.init(64, 12, G, bid, (size_t)256 * 1024 * 2, 0, (size_t)256 * 1024 * 2, 0);
        EpiIn E{WSP(float, OFF_SSQ0), AIN(4), WSP(bf16_t, WS_UAS), (bf16_t*)OUT  , WSP(bf16_t, WS_GA), WSP(bf16_t, WS_GB), 0};
        pg8::gemm_phase(lds, g, S, E, tid);
    }
    SEAM(1);
    PROBE_B(1);
    PROBE_A(2);
    if (IN(2)) {
        PH_BEGIN
        if (PROBE_PH == 20) pr_t0 = __builtin_amdgcn_s_memrealtime();
        const int nL = (G >= 2) ? G / 2 : 1, nS = (G >= 2) ? G - nL : 1; const bool isL = (G < 2) || bid < nL, isS = (G < 2) || bid >= nL;
        if (isL) for (int unit = (G < 2) ? 0 : bid; unit < 128; unit += nL) lru_fused_unit(ap, ws, (const bf16_t*)OUT, lds, unit, wave);
        if (PROBE_PH == 20) pr_dt = __builtin_amdgcn_s_memrealtime() - pr_t0;
        if (PROBE_PH == 21) pr_t0 = __builtin_amdgcn_s_memrealtime();
        if (isS) for (int su = (G < 2) ? 0 : bid - nL; su < 128; su += nS) {
            const int g = su >> 2;
            int k256 = 256, k384 = 384; asm volatile("" : "+s"(k256), "+s"(k384));
            { pg8::Gemm gm{WSP(bf16_t, WS_UAS), WSP(bf16_t, WS_PM), 384, 256, k256}; pg8::OneUnit S{su, 0, (size_t)su * 256 * 384 * 2, (size_t)g * 256 * 256 * 2};
              EpiS5a E{WSP(float, WS_E)}; int lane1 = (int)__builtin_amdgcn_mbcnt_hi(~0u, __builtin_amdgcn_mbcnt_lo(~0u, 0u)); asm volatile("" : "+v"(lane1)); pg8::gemm_phase(lds, gm, S, E, wave * 64 + lane1); }
            int lane2 = (int)__builtin_amdgcn_mbcnt_hi(~0u, __builtin_amdgcn_mbcnt_lo(~0u, 0u)); asm volatile("" : "+v"(lane2));
            wg_publish(wave == 0 && lane2 == 0);
            for (int bb = 0; bb < 2; ++bb) { const int b = (su & 3) * 2 + bb, n = lane2;
                const float lr = AIN(5)[g * 64 + n], li = AIN(6)[g * 64 + n], dt = expf(AIN(7)[g]);
                const float mag = expf(16.0f * lr * dt); float sn, cs; sincosf(16.0f * (li * dt), &sn, &cs); const float ar = mag * cs, ai = mag * sn;
                const size_t row0 = (size_t)g * 1024 + b * 128 + wave * 16;
                float er[16], ei[16], lr_[16], li_[16];
#pragma unroll
                for (int j = 0; j < 16; ++j) { er[j] = WSP(float, WS_E)[(row0 + j) * 128 + n]; ei[j] = WSP(float, WS_E)[(row0 + j) * 128 + 64 + n]; }
                float sr = 0.f, si = 0.f;
#pragma unroll
                for (int j = 0; j < 16; ++j) { lr_[j] = sr; li_[j] = si; const float nr_ = ar * sr - ai * si + er[j], ni_ = ar * si + ai * sr + ei[j]; sr = nr_; si = ni_; }
                LAS float* segr = (LAS float*)lds; LAS float* segi = segr + 512;
                segr[wave * 64 + n] = sr; segi[wave * 64 + n] = si;
                float br = ar, bi = ai;
#pragma unroll
                for (int q = 0; q < 4; ++q) { const float t_ = br * br - bi * bi; bi = 2.0f * br * bi; br = t_; }
                __syncthreads();
                float cr = 0.f, ci = 0.f;
                for (int ww = 0; ww < wave; ++ww) { const float xr_ = segr[ww * 64 + n], xi_ = segi[ww * 64 + n]; const float t_ = br * cr - bi * ci + xr_; ci = br * ci + bi * cr + xi_; cr = t_; }
                float pr = 1.f, pi = 0.f;
#pragma unroll
                for (int j = 0; j < 16; ++j) { const float orr = lr_[j] + pr * cr - pi * ci, oii = li_[j] + pr * ci + pi * cr;
                    bf16_t* d = WSP(bf16_t, WS_UAS) + (row0 + j) * 384 + 256 + n; d[0] = (bf16_t)(cvt_pk_bf16(orr, 0.f) & 0xffffu); d[64] = (bf16_t)(cvt_pk_bf16(oii, 0.f) & 0xffffu);
                    const float t_ = pr * ar - pi * ai; pi = pr * ai + pi * ar; pr = t_; }
                __syncthreads();
            }
            wg_publish(wave == 0 && lane2 == 0);
            { pg8::Gemm gm{WSP(bf16_t, WS_UAS), WSP(bf16_t, WS_TQ), 384, 384, k384}; pg8::OneUnit S{su, 0, (size_t)su * 256 * 384 * 2, (size_t)g * 256 * 384 * 2};
              EpiS5b E{WSP(bf16_t, WS_ZG)}; pg8::gemm_phase(lds, gm, S, E, wave * 64 + lane2); }
        }
        if (isS) {
            int lane3 = (int)__builtin_amdgcn_mbcnt_hi(~0u, __builtin_amdgcn_mbcnt_lo(~0u, 0u)); asm volatile("" : "+v"(lane3));
            const int wq = ((G < 2) ? 0 : bid - nL) * 8 + wave, nW = nS * 8;
            LAS float* scr = (LAS float*)(lds + wave * 16384);
            constexpr int I_GLU = 8 * 16, I_A = 8 * 32, I_B = 16 * 32, I_O = 16 * 32, I_G = 16 * 88, I_U = 16 * 88, I_D = 44 * 32, I_PG = 16 * 32, I_PLE = 4 * 32;
            constexpr int NITEMS = I_GLU + I_A + I_B + I_O + I_D + I_PG + I_PLE; (void)I_G; (void)I_U;
            for (int it = wq; it < NITEMS; it += nW) {
                int r = it;
                if (r < I_GLU) { tr_item(AIN(13), 512, 512, nullptr, WSP(bf16_t, WS_WGLU), 0, scr, r, lane3); continue; } r -= I_GLU;
                if (r < I_A) { tr_item(AIN(22), 512, 1024, nullptr, WSP(bf16_t, WS_WA), 0, scr, r, lane3, 1536, 0); continue; } r -= I_A;
                if (r < I_B) { tr_item(AIN(23), 1024, 1024, nullptr, WSP(bf16_t, WS_WA), 0, scr, r, lane3, 1536, 512); continue; } r -= I_B;
                if (r < I_O) { tr_item(AIN(24), 1024, 1024, nullptr, WSP(bf16_t, WS_WO), 0, scr, r, lane3); continue; } r -= I_O;
                if (r < I_D) { tr_item(AIN(28), FFN, 1024, nullptr, WSP(bf16_t, WS_WD), 0, scr, r, lane3); continue; } r -= I_D;
                if (r < I_PG) { tr_item(AIN(30), 1024, 1024, AIN(29), WSP(bf16_t, WS_WPG), 0, scr, r, lane3); continue; } r -= I_PG;
                tr_item(AIN(32), 256, 1024, nullptr, WSP(bf16_t, WS_WPLE), 0, scr, r, lane3);
            }
            const int tq = ((G < 2) ? 0 : bid - nL) * 512 + wave * 64 + lane3, nT = nS * 512;
            for (int e = tq * 4; e < M * PLE / 8; e += nT * 4) { const f32x4* pp = (const f32x4*)(AIN(1)) + (size_t)e * 2; f32x4 v[8];
#pragma unroll
                for (int j = 0; j < 8; ++j) v[j] = __builtin_nontemporal_load(&pp[j]);
                u32x4* o = (u32x4*)(WSP(bf16_t, WS_PB) + (size_t)e * 8);
#pragma unroll
                for (int j = 0; j < 4; ++j) o[j] = pack8(v[2 * j], v[2 * j + 1]); }
        }
    }
    if (PROBE_PH == 21) pr_dt = __builtin_amdgcn_s_memrealtime() - pr_t0;
    SEAM(2);
    PROBE_B(2);
    PROBE_A(5);
    if (IN(5)) {
        PH_BEGIN
        pg8::Gemm g{WSP(bf16_t, WS_ZG), WSP(bf16_t, WS_WGLU), 512, 512, 512}; pg8::Sched S; S.init(64, 2, G, bid, (size_t)256 * 512 * 2, 0, (size_t)256 * 512 * 2, 0);
        EpiGlu E{WSP(bf16_t, WS_ZG), AIN(14), WSP(bf16_t, WS_YAB)};
        pg8::gemm_phase(lds, g, S, E, tid);
        {
            int lane5 = (int)__builtin_amdgcn_mbcnt_hi(~0u, __builtin_amdgcn_mbcnt_lo(~0u, 0u)); asm volatile("" : "+v"(lane5));
            pg8::Gemm g2{(const bf16_t*)OUT + (size_t)M * 1024  , WSP(bf16_t, WS_WIN) + (size_t)12 * 256 * 1024, 1024, 1024, 1024};
            pg8::Sched S2; S2.init(64, 2, G, (bid + G - G / 2) % G, (size_t)256 * 1024 * 2, 0, (size_t)256 * 1024 * 2, 0);
            EpiIn E2{WSP(float, OFF_SSQ0), AIN(4), WSP(bf16_t, WS_UAS), (bf16_t*)OUT, WSP(bf16_t, WS_GA), WSP(bf16_t, WS_GB), 12};
            pg8::gemm_phase(lds, g2, S2, E2, wave * 64 + lane5);
        }
        {
            const int nLo = (G >= 2) ? G / 2 : 1;
            if (bid < nLo) { int lane6 = (int)__builtin_amdgcn_mbcnt_hi(~0u, __builtin_amdgcn_mbcnt_lo(~0u, 0u)); asm volatile("" : "+v"(lane6));
                LAS float* scr = (LAS float*)(lds + wave * 16384);
                for (int it = bid * 8 + wave; it < 2 * 16 * 88; it += nLo * 8) {
                    if (it < 16 * 88) tr_item(AIN(26), 1024, FFN, AIN(25), WSP(bf16_t, WS_WGU), 1, scr, it, lane6);
                    else tr_item(AIN(27), 1024, FFN, AIN(25), WSP(bf16_t, WS_WGU), 2, scr, it - 16 * 88, lane6); } }
        }
    }
    SEAM(5);
    PROBE_B(5);
    PROBE_A(6);
    if (IN(6)) {
        PH_BEGIN
        pg8::Gemm g{WSP(bf16_t, WS_YAB), WSP(bf16_t, WS_WA), 1536, 1536, 1536}; pg8::Sched S; S.init(64, 4, G, bid, (size_t)256 * 1536 * 2, 0, (size_t)256 * 1536 * 2, 0);
        EpiMg E{WSP(bf16_t, WS_GB), WSP(bf16_t, WS_MG)}; MidGate Mh{8, WSP(bf16_t, WS_GA)  };
        pg8::gemm_phase<EpiMg, pg8::Sched, MidGate, false>(lds, g, S, E, tid, Mh);
    }
    SEAM(6);
    PROBE_B(6);
    PROBE_A(7);
    if (IN(7)) {
        PH_BEGIN
        pg8::Gemm g{WSP(bf16_t, WS_MG), WSP(bf16_t, WS_WO), 1024, 1024, 1024}; pg8::Sched S; S.init(64, 4, G, bid, (size_t)256 * 1024 * 2, 0, (size_t)256 * 1024 * 2, 0);
        EpiRes E{nullptr, (const bf16_t*)OUT + (size_t)M * 1024  , WSP(bf16_t, WS_XB)  , WSP(float, OFF_SSQ1)};
        pg8::gemm_phase<EpiRes, pg8::Sched, pg8::NoMid, false>(lds, g, S, E, tid);
    }
    SEAM(7);
    PROBE_B(7);
    PROBE_A(8);
    if (IN(8)) {
        PH_BEGIN
        pg8::Gemm g{WSP(bf16_t, WS_XB)  , WSP(bf16_t, WS_WGU), 1024, 1024, 1024}; pg8::Sched S; S.init(64, 22, G, bid, (size_t)256 * 1024 * 2, 0, (size_t)256 * 1024 * 2, 0);
        EpiFfn E{WSP(float, OFF_SSQ1), WSP(bf16_t, WS_ACT)};
        pg8::gemm_phase(lds, g, S, E, tid);
        {
            const int b0 = (G >= 2) ? G / 2 : 0, nB = G - b0;
            if (bid >= b0) { int lane4 = (int)__builtin_amdgcn_mbcnt_hi(~0u, __builtin_amdgcn_mbcnt_lo(~0u, 0u)); asm volatile("" : "+v"(lane4));
                pg8::Gemm g2{WSP(bf16_t, WS_PB), WSP(bf16_t, WS_WPLE), 256, 256, 256}; pg8::Sched S2; S2.init(64, 4, nB, bid - b0, (size_t)256 * 256 * 2, 0, (size_t)256 * 256 * 2, 0);
                EpiEraw E2{WSP(bf16_t, WS_GA), WSP(float, OFF_SSQE)}; pg8::gemm_phase(lds, g2, S2, E2, wave * 64 + lane4); }
        }
    }
    SEAM(8);
    PROBE_B(8);
    PROBE_A(9);
    if (IN(9)) {
        PH_BEGIN
        { pg8::Gemm g{WSP(bf16_t, WS_ACT), WSP(bf16_t, WS_WD), FFN, FFN, FFN}; pg8::Sched S; S.init(64, 4, G, bid, (size_t)256 * FFN * 2, 0, (size_t)256 * FFN * 2, 0);
          EpiRes E{nullptr, WSP(bf16_t, WS_XB)  , WSP(bf16_t, WS_XB)  , WSP(float, OFF_SSQ2)}; pg8::gemm_phase<EpiRes, pg8::Sched, pg8::NoMid, false>(lds, g, S, E, tid); }
    }
    SEAM(9);
    PROBE_B(9);
    PROBE_A(10);
    if (IN(10)) {
        PH_BEGIN
        int kq = 1024; asm volatile("" : "+s"(kq));
        pg8::Gemm g{WSP(bf16_t, WS_XB)  , WSP(bf16_t, WS_WPG), 1024, 1024, kq}; pg8::Sched S; S.init(64, 4, G, bid, (size_t)256 * 1024 * 2, 0, (size_t)256 * 1024 * 2, 0);
        EpiPg E{WSP(float, OFF_SSQ2), WSP(float, OFF_SSQE), AIN(31), AIN(33), WSP(bf16_t, WS_GA)  , WSP(bf16_t, WS_XB)  , WSP(float, OFF_SSQ3), (unsigned*)(ws + OFF_BAR + 16384), AIN(34), OUT};
        pg8::gemm_phase(lds, g, S, E, tid);
    }
    PROBE_B(10);
    if (PROBE_PH == 11) pr_dt = __builtin_amdgcn_s_memrealtime() - pr_t0;
    if (PROBE_PH == 12) { for (int i = 0; i < 16; ++i) xcd_barrier((unsigned*)(kap->ws + OFF_BAR), xcc, (volatile LAS unsigned*)(lds + 131072 + 64), (unsigned)G, LEADER); }
    if (PROBE_PH >= 0 && PROBE_PH != 12) { const unsigned long long t1 = __builtin_amdgcn_s_memrealtime(); while (__builtin_amdgcn_s_memrealtime() - t1 < (unsigned long long)PROBE_MULT * pr_dt) __builtin_amdgcn_s_sleep(8); }
#undef IN
#undef SEAM
}

constexpr int LDS_BYTES = 147456;
extern "C" void kernel_launch(void* const* d_in, const int* in_sizes, int n_in, void* d_out, int out_size, void* d_ws, size_t ws_size, hipStream_t stream) {
    static int grid = 0;
    if (grid == 0) {
        int dev = 0, cus = 0, per_cu = 0;
        hipGetDevice(&dev); hipDeviceGetAttribute(&cus, hipDeviceAttributeMultiprocessorCount, dev);
        if (hipFuncSetAttribute((const void*)fwd_kernel, hipFuncAttributeMaxDynamicSharedMemorySize, LDS_BYTES) != hipSuccess) { fprintf(stderr, "kernel_launch: hipFuncSetAttribute failed\n"); grid = -1; return; }
        if (hipOccupancyMaxActiveBlocksPerMultiprocessor(&per_cu, (const void*)fwd_kernel, 512, LDS_BYTES) != hipSuccess || per_cu < 1) { fprintf(stderr, "kernel_launch: occupancy query says %d\n", per_cu); per_cu = 1; }
        (void)hipGetLastError();
        if (cus <= 0) cus = 256;
        grid = cus * per_cu;
        if (n_in != 35 || ws_size < WS_END) { fprintf(stderr, "kernel_launch: unexpected n_in %d / ws_size %zu\n", n_in, ws_size); grid = -1; return; }
    }
    if (grid < 0) return;
    (void)hipMemsetAsync((char*)d_ws + OFF_BAR, 0, 32768, stream);
    Args a{};
    for (int i = 0; i < 35; ++i) a.in[i] = (const float*)d_in[i];
    a.out = (float*)d_out; a.ws = (unsigned char*)d_ws;
#if MK_N_LAUNCHES == 1
    a.ph_lo = 0; a.ph_hi = NPH;
    void* kargs[] = {&a};
    hipError_t e = hipLaunchCooperativeKernel((const void*)fwd_kernel, dim3(grid), dim3(512), kargs, LDS_BYTES, stream);
    if (e != hipSuccess) fprintf(stderr, "kernel_launch: cooperative launch failed: %s (grid %d)\n", hipGetErrorString(e), grid);
#else
    for (int ph = 0; ph < NPH; ++ph) { a.ph_lo = ph; a.ph_hi = ph + 1; hipLaunchKernelGGL(fwd_kernel, dim3(grid), dim3(512), LDS_BYTES, stream, a); }
#endif
}
```

```cpp
#include <hip/hip_runtime.h>
#include <hip/hip_cooperative_groups.h>
#include <cstdio>
#include <cstdint>
namespace cg = cooperative_groups;

#ifndef MK_N_LAUNCHES
#define MK_N_LAUNCHES 1
#endif

#define LAS __attribute__((address_space(3)))
typedef unsigned short bf16_t;
typedef short bf16x8 __attribute__((ext_vector_type(8)));
typedef float f32x4 __attribute__((ext_vector_type(4)));
typedef unsigned u32x4 __attribute__((ext_vector_type(4)));
typedef unsigned u32x2 __attribute__((ext_vector_type(2)));

constexpr int M = 16384, DM = 1024, SEQ = 2048, INC = 3584, FFN = 2816, PLE = 256;
constexpr float EPS = 1e-6f;
constexpr int NPH = 12;

constexpr size_t MiB = 1u << 20;
constexpr size_t WS_CTL = 0;
constexpr size_t OFF_BAR = 524288;
constexpr size_t OFF_SSQ0 = 0, OFF_SSQ1 = 65536, OFF_SSQ2 = 131072, OFF_SSQ3 = 196608, OFF_SSQE = 262144, OFF_SP = 327680;
constexpr size_t WS_WIN = 1 * MiB, WS_WGLU = 8 * MiB, WS_WPLE = 8 * MiB + 512 * 1024, WS_WA = 9 * MiB, WS_WB = 10 * MiB, WS_WO = 12 * MiB, WS_WGU = 14 * MiB,
                 WS_WD = 25 * MiB, WS_WPG = 31 * MiB, WS_PM = 33 * MiB, WS_TQ = 37 * MiB, WS_WLRU = 43 * MiB;
constexpr size_t WS_PB = 44 * MiB;
constexpr size_t WS_GA = 52 * MiB, WS_GB = 84 * MiB;
constexpr size_t WS_XB = 116 * MiB;
constexpr size_t WS_UB = 148 * MiB;
constexpr size_t WS_UAS = 180 * MiB;
constexpr size_t WS_E = 228 * MiB;
constexpr size_t WS_ZG = 204 * MiB;
constexpr size_t WS_YAB = 116 * MiB;
constexpr size_t WS_MG = 164 * MiB;
constexpr size_t WS_ACT = 148 * MiB;
constexpr size_t WS_END = 256 * MiB;

__device__ __forceinline__ unsigned cvt_pk_bf16(float lo, float hi) { unsigned r; asm volatile("v_cvt_pk_bf16_f32 %0, %1, %2" : "=v"(r) : "v"(lo), "v"(hi)); return r; }
__device__ __forceinline__ u32x4 pack8(const f32x4 a, const f32x4 b) { u32x4 w; w.x = cvt_pk_bf16(a[0], a[1]); w.y = cvt_pk_bf16(a[2], a[3]); w.z = cvt_pk_bf16(b[0], b[1]); w.w = cvt_pk_bf16(b[2], b[3]); return w; }
__device__ __forceinline__ void unpack8(const u32x4 w, f32x4& a, f32x4& b) {
    a[0] = __uint_as_float(w.x << 16); a[1] = __uint_as_float(w.x & 0xffff0000u); a[2] = __uint_as_float(w.y << 16); a[3] = __uint_as_float(w.y & 0xffff0000u);
    b[0] = __uint_as_float(w.z << 16); b[1] = __uint_as_float(w.z & 0xffff0000u); b[2] = __uint_as_float(w.w << 16); b[3] = __uint_as_float(w.w & 0xffff0000u);
}
__device__ __forceinline__ float bf2f(bf16_t h) { return __uint_as_float((unsigned)h << 16); }
__device__ __forceinline__ float sigm(float x) { return __builtin_amdgcn_rcpf(1.0f + __expf(-x)); }
__device__ __forceinline__ f32x4 sigm4(f32x4 v) { f32x4 o; o[0] = sigm(v[0]); o[1] = sigm(v[1]); o[2] = sigm(v[2]); o[3] = sigm(v[3]); return o; }
__device__ __forceinline__ float gelu_tanh(float y) { const float t = 1.5957691216057308f * (y + 0.044715f * y * y * y); return y * sigm(t); }
__device__ __forceinline__ float sq4(f32x4 v) { return (v[0] * v[0] + v[1] * v[1]) + (v[2] * v[2] + v[3] * v[3]); }
__device__ __forceinline__ float rstd_of(float ssq) { return rsqrtf(ssq * (1.0f / 1024.0f) + EPS); }
__device__ __forceinline__ float wave_sum(float v) {
#pragma unroll
    for (int o = 1; o < 64; o <<= 1) v += __shfl_xor(v, o);
    return v;
}

#define XB_TMO      128
#define XB_XCNT(j)  (256  + 64 * (j))
#define XB_XSUB(j)  (1280 + 64 * (j))
#define XB_XGEN(j)  (2304 + 64 * (j))
#define XB_TOP      3328
#define XB_TOPGEN   3392
#define XCD_BAR_WORDS 3456
#define XB_SPIN_CAP (1u << 18)
__device__ __forceinline__ unsigned xb_ld(unsigned* p)              { return __hip_atomic_load(p, __ATOMIC_RELAXED, __HIP_MEMORY_SCOPE_AGENT); }
__device__ __forceinline__ unsigned xb_add(unsigned* p, unsigned v) { return __hip_atomic_fetch_add(p, v, __ATOMIC_RELAXED, __HIP_MEMORY_SCOPE_AGENT); }
__device__ __forceinline__ unsigned xb_xcc_id() { return (unsigned)__builtin_amdgcn_s_getreg((3 << 11) | 20) & 0xFu; }
#define XB_SPIN(cond, bar) do { unsigned _sp = 0; while (cond) { __builtin_amdgcn_s_sleep(1); \
    if ((++_sp & 255u) == 0u) { if (xb_ld(&(bar)[XB_TMO])) break; if (_sp > XB_SPIN_CAP) { atomicAdd(&(bar)[XB_TMO], 1u); break; } } } } while (0)
__device__ __forceinline__ void xcd_barrier_complete(unsigned* bar, unsigned x, unsigned G, unsigned& nloc, unsigned& nx) {
    unsigned sum, cnt, mine, sp = 0u;
    for (;;) {
        sum = 0u; cnt = 0u; mine = 0u;
#pragma unroll
        for (unsigned j = 0; j < 16; ++j) { const unsigned c = xb_ld(&bar[XB_XCNT(j)]); sum += c; cnt += (c > 0u) ? 1u : 0u; mine = (j == x) ? c : mine; }
        if (sum == G) break;
        __builtin_amdgcn_s_sleep(1);
        if ((++sp & 255u) == 0u) { if (xb_ld(&bar[XB_TMO])) break; if (sp > XB_SPIN_CAP) { atomicAdd(&bar[XB_TMO], 1u); break; } }
    }
    nloc = mine > 0u ? mine : 1u; nx = cnt > 0u ? cnt : 1u;
}
__device__ __forceinline__ void xcd_barrier(unsigned* bar, unsigned x, volatile LAS unsigned* st, unsigned G, bool leader) {
    asm volatile("s_waitcnt vmcnt(0)" ::: "memory");
    __syncthreads();
    if (leader) {
        __builtin_amdgcn_s_waitcnt(0);
        unsigned nloc = st[0], nx = st[1];
        if (nloc == 0u) { xcd_barrier_complete(bar, x, G, nloc, nx); st[0] = nloc; st[1] = nx; }
        const unsigned old = xb_add(&bar[XB_XSUB(x)], 1u);
        const unsigned gen = old / nloc;
        if (old + 1u == (gen + 1u) * nloc) {
            __builtin_amdgcn_fence(__ATOMIC_RELEASE, "agent");
            asm volatile("s_waitcnt vmcnt(0)" ::: "memory");
            const unsigned og = xb_add(&bar[XB_TOP], 1u);
            const unsigned tg = og / nx;
            if (og + 1u == (tg + 1u) * nx) xb_add(&bar[XB_TOPGEN], 1u);
            else XB_SPIN(xb_ld(&bar[XB_TOPGEN]) == tg, bar);
            __builtin_amdgcn_fence(__ATOMIC_ACQUIRE, "agent");
            xb_add(&bar[XB_XGEN(x)], 1u);
            asm volatile("s_waitcnt vmcnt(0)" ::: "memory");
        } else {
            XB_SPIN(xb_ld(&bar[XB_XGEN(x)]) == gen, bar);
            __builtin_amdgcn_fence(__ATOMIC_ACQUIRE, "agent");
            asm volatile("s_waitcnt vmcnt(0)" ::: "memory");
        }
    }
    __syncthreads();
}

namespace pg8 {
constexpr int BM = 256, BK = 64, HALF = 128, HTB = HALF * BK * 2, STAGE_BYTES = 8 * HTB, NXCD = 8, WGM = 8;
__host__ __device__ __forceinline__ int lds_byte(int r, int c) { const int st = (r >> 4) * 2 + (c >> 5), rr = r & 15, cc = c & 31, ob = rr * 64 + cc * 2; return st * 1024 + (ob ^ (((ob >> 9) & 1) << 5)); }
__host__ __device__ __forceinline__ void stage_rc(int b, int& R, int& C) { const int st = b / 1024, sb = b % 1024, swz = sb ^ (((sb >> 9) & 1) << 5); R = (st >> 1) * 16 + swz / 64; C = (st & 1) * 32 + (swz % 64) / 2; }
__host__ __device__ __forceinline__ int perm32(int rho) { const int n = rho >> 4, i = rho & 15; return 8 * (i >> 2) + 4 * n + (i & 3); }

struct Unit { int pm, pn; size_t aoff, boff; };
struct Gemm { const bf16_t* A; const bf16_t* Bt; int lda, ldb, K; };

struct Sched {
    int nM, nN, nwg, G, c;
    size_t a_pm, a_pn, b_pn, b_grp; int a_pn_shift;
    __device__ __forceinline__ void init(int nM_, int nN_, int G_, int c_, size_t a_pm_, size_t a_pn_, size_t b_pn_, size_t b_grp_) {
        nM = nM_; nN = nN_; nwg = nM * nN; G = G_; c = c_; a_pm = a_pm_; a_pn = a_pn_; b_pn = b_pn_; b_grp = b_grp_; a_pn_shift = 0; }
    __device__ __forceinline__ bool next(int i, Unit& u) const {
        const long L = (long)i * G + c; if (L >= nwg) return false;
        int wgid = (int)L; { const int q = nwg / NXCD, r = nwg % NXCD, xcd = wgid % NXCD, off = wgid / NXCD; wgid = (xcd < r ? xcd * (q + 1) : r * (q + 1) + (xcd - r) * q) + off; }
        const int nig = WGM * nN, gid = wgid / nig, fm = gid * WGM, gsz = (nM - fm) < WGM ? (nM - fm) : WGM;
        u.pm = fm + ((wgid % nig) % gsz); u.pn = (wgid % nig) / gsz;
        u.aoff = (size_t)u.pm * a_pm + (size_t)(u.pn >> a_pn_shift) * a_pn; u.boff = (size_t)u.pn * b_pn + (size_t)(u.pm >> 2) * b_grp;
        return true;
    }
};

struct OneUnit {
    int pm, pn; size_t aoff, boff;
    __device__ __forceinline__ bool next(int i, Unit& u) const { if (i != 0) return false; u.pm = pm; u.pn = pn; u.aoff = aoff; u.boff = boff; return true; }
};

struct NoMid { static constexpr bool ENABLED = false; int mid_t; template <class A, class U> __device__ __forceinline__ void operator()(A&, const U&, int, int, int, int) const {} };
template <class Epi, class SchedT, class Mid = NoMid>
__device__ __forceinline__ void gemm_phase(LAS unsigned char* lds, const Gemm g, const SchedT& S, const Epi& E, int tid_, const Mid Mh = Mid{}) {
    asm volatile("" : "+v"(tid_));
    const int tid = tid_, wid = __builtin_amdgcn_readfirstlane(tid >> 6), lane = tid & 63, wr = wid >> 2, wc = wid & 3, fr = lane & 15, fq = lane >> 4;
    const int nt = g.K / BK;
    unsigned voffA[2], voffB[2];
#pragma unroll
    for (int i = 0; i < 2; ++i) { int R, C; stage_rc(tid * 16 + i * 8192, R, C); const int Rb = (R & ~31) + perm32(R & 31);
        voffA[i] = (unsigned)(R * g.lda + C) * 2u; voffB[i] = (unsigned)(Rb * g.ldb + C) * 2u; }
    const size_t kstep = (size_t)(BK * 2);
    const size_t hstepA = (size_t)HALF * g.lda * 2, hstepB = (size_t)HALF * g.ldb * 2;
    const unsigned ldsw = (unsigned)wid * 1024u;
    const int aoff = lds_byte(wr * 64 + fr, fq * 8), boff = lds_byte(wc * 32 + fr, fq * 8);
#define PG8_SA(b, h) (((b) * 2 + (h)) * HTB)
#define PG8_SB(b, h) ((4 + (b) * 2 + (h)) * HTB)
#define PG8_STAGE(bufoff, gbase, voff) do { _Pragma("unroll") for (int _i = 0; _i < 2; ++_i) \
        __builtin_amdgcn_global_load_lds((const unsigned*)((const char*)(gbase) + (voff)[_i]), (LAS unsigned*)(lds + (bufoff) + ldsw + _i * 8192), 16, 0, 0); } while (0)
#define PG8_LDA(dst, b, h) do { _Pragma("unroll") for (int m = 0; m < 4; ++m) _Pragma("unroll") for (int k = 0; k < 2; ++k) dst[m][k] = *(const LAS bf16x8*)(lds + PG8_SA(b, h) + aoff + m * 2048 + k * 1024); } while (0)
#define PG8_LDB(dst, b, h) do { _Pragma("unroll") for (int n = 0; n < 2; ++n) _Pragma("unroll") for (int k = 0; k < 2; ++k) dst[n][k] = *(const LAS bf16x8*)(lds + PG8_SB(b, h) + boff + n * 2048 + k * 1024); } while (0)
#define PG8_MMA(ai, bj, At, Bt) do { __builtin_amdgcn_s_setprio(1); _Pragma("unroll") for (int m = 0; m < 4; ++m) _Pragma("unroll") for (int n = 0; n < 2; ++n) _Pragma("unroll") for (int k = 0; k < 2; ++k) \
        acc[ai][bj][m][n] = __builtin_amdgcn_mfma_f32_16x16x32_bf16(Bt[n][k], At[m][k], acc[ai][bj][m][n], 0, 0, 0); __builtin_amdgcn_s_setprio(0); } while (0)
#define PG8_WAIT_V(n) asm volatile("s_waitcnt vmcnt(" #n ")" ::: "memory")
#define PG8_WAIT_L(n) asm volatile("s_waitcnt lgkmcnt(" #n ")" ::: "memory")
#define PG8_BAR __builtin_amdgcn_s_barrier()
#define PG8_SCHED __builtin_amdgcn_sched_barrier(0)
    Unit cur, nxt; int ui = 0;
    if (!S.next(0, cur)) return;
    f32x4 acc[2][2][4][2];
#pragma unroll
    for (int a = 0; a < 2; ++a)
#pragma unroll
        for (int b = 0; b < 2; ++b)
#pragma unroll
            for (int m = 0; m < 4; ++m)
#pragma unroll
                for (int n = 0; n < 2; ++n) acc[a][b][m][n] = (f32x4){0.f, 0.f, 0.f, 0.f};
    bf16x8 At[4][2], B0[2][2], B1[2][2];
    const char* cA = (const char*)g.A + cur.aoff; const char* cB = (const char*)g.Bt + cur.boff;
    PG8_STAGE(PG8_SB(0, 0), cB, voffB); PG8_STAGE(PG8_SB(0, 1), cB + hstepB, voffB); PG8_STAGE(PG8_SA(0, 0), cA, voffA); PG8_STAGE(PG8_SA(0, 1), cA + hstepA, voffA);
    if (wr == 1) PG8_BAR;
    PG8_WAIT_V(2); PG8_BAR;
    PG8_STAGE(PG8_SB(1, 0), cB + kstep, voffB); PG8_STAGE(PG8_SA(1, 0), cA + kstep, voffA); PG8_STAGE(PG8_SB(1, 1), cB + hstepB + kstep, voffB);
    PG8_WAIT_V(6); PG8_BAR;
    for (;;) {
        const bool has_next = S.next(ui + 1, nxt);
        const char* nA = has_next ? (const char*)g.A + nxt.aoff : cA; const char* nB = has_next ? (const char*)g.Bt + nxt.boff : cB;
        for (int t = 0; t < nt; t += 2) {
            if constexpr (Mid::ENABLED) { if (t == Mh.mid_t) { int fr_e = fr, fq_e = fq; asm volatile("" : "+v"(fr_e), "+v"(fq_e)); Mh(acc, cur, wr, wc, fr_e, fq_e); } }
            const bool last = (t == nt - 2);
            const char* a1 = cA + (size_t)(t + 1) * kstep;
            const char* a2 = last ? nA : cA + (size_t)(t + 2) * kstep; const char* b2 = last ? nB : cB + (size_t)(t + 2) * kstep;
            const char* a3 = a2 + kstep; const char* b3 = b2 + kstep;
            PG8_LDB(B0, 0, 0); PG8_LDB(B1, 0, 1); PG8_SCHED; PG8_LDA(At, 0, 0); PG8_STAGE(PG8_SA(1, 1), a1 + hstepA, voffA);
            PG8_WAIT_V(8); PG8_WAIT_L(0); PG8_BAR; PG8_MMA(0, 0, At, B0); PG8_MMA(0, 1, At, B1); PG8_BAR; PG8_SCHED;
            PG8_LDA(At, 0, 1); PG8_STAGE(PG8_SB(0, 0), b2, voffB); PG8_STAGE(PG8_SB(0, 1), b2 + hstepB, voffB); PG8_STAGE(PG8_SA(0, 0), a2, voffA);
            PG8_WAIT_V(8); PG8_WAIT_L(0); PG8_BAR; PG8_MMA(1, 0, At, B0); PG8_MMA(1, 1, At, B1); PG8_BAR; PG8_SCHED;
            PG8_LDB(B0, 1, 0); PG8_LDB(B1, 1, 1); PG8_SCHED; PG8_LDA(At, 1, 0); PG8_STAGE(PG8_SA(0, 1), a2 + hstepA, voffA);
            PG8_WAIT_V(8); PG8_WAIT_L(0); PG8_BAR; PG8_MMA(0, 0, At, B0); PG8_MMA(0, 1, At, B1); PG8_BAR; PG8_SCHED;
            PG8_LDA(At, 1, 1); PG8_STAGE(PG8_SB(1, 0), b3, voffB); PG8_STAGE(PG8_SB(1, 1), b3 + hstepB, voffB); PG8_STAGE(PG8_SA(1, 0), a3, voffA);
            PG8_WAIT_V(8); PG8_WAIT_L(0); PG8_BAR; PG8_MMA(1, 0, At, B0); PG8_MMA(1, 1, At, B1); PG8_BAR; PG8_SCHED;
        }
        if (wr == 0) PG8_BAR;
        { int fr_e = fr, fq_e = fq; asm volatile("" : "+v"(fr_e), "+v"(fq_e)); E(acc, cur, wr, wc, fr_e, fq_e); }
        if (!has_next) break;
#pragma unroll
        for (int a = 0; a < 2; ++a)
#pragma unroll
            for (int b = 0; b < 2; ++b)
#pragma unroll
                for (int m = 0; m < 4; ++m)
#pragma unroll
                    for (int n = 0; n < 2; ++n) acc[a][b][m][n] = (f32x4){0.f, 0.f, 0.f, 0.f};
        cur = nxt; cA = nA; cB = nB; ++ui;
        if (wr == 1) PG8_BAR;
    }
    PG8_WAIT_V(0);
    PG8_BAR;
#undef PG8_SA
#undef PG8_SB
#undef PG8_STAGE
#undef PG8_LDA
#undef PG8_LDB
#undef PG8_MMA
#undef PG8_WAIT_V
#undef PG8_WAIT_L
#undef PG8_BAR
#undef PG8_SCHED
}
}

typedef f32x4 AccT[2][2][4][2];
#define EPI_ROWS(ai, m) _Pragma("unroll") for (int ai = 0; ai < 2; ++ai) _Pragma("unroll") for (int m = 0; m < 4; ++m)
#define EPI_ROW(u, ai, m) ((u).pm * 256 + (ai) * 128 + wr * 64 + (m) * 16 + fr)
#define EPI_LCOL(bj) ((bj) * 128 + wc * 32 + 8 * fq)
__device__ __forceinline__ void row_atomic(float* dst, float s, int fq) { s += __shfl_xor(s, 16); s += __shfl_xor(s, 32); if (fq == 0) atomicAdd(dst, s); }

struct EpiIn {
    const float* ssq0; const float* b_in; bf16_t* UAS; bf16_t* UB; bf16_t* GR; bf16_t* GB; int pn0;
    __device__ __forceinline__ void operator()(const AccT& acc, const pg8::Unit& u, int wr, int wc, int fr, int fq) const {
        const int upn = u.pn + pn0;
        if (upn >= 6) { const int ch = (upn - 6) * 128 + wc * 32 + 8 * fq; const float NL = -1.4426950408889634f;
            const f32x4 ba0 = *(const f32x4*)(b_in + 1536 + ch) * NL, ba1 = *(const f32x4*)(b_in + 1536 + ch + 4) * NL, bb0 = *(const f32x4*)(b_in + 2560 + ch) * NL, bb1 = *(const f32x4*)(b_in + 2560 + ch + 4) * NL;
            EPI_ROWS(ai, m) { const int row = EPI_ROW(u, ai, m); const float rs = rstd_of(ssq0[row]) * NL; f32x4 r0, r1, g0, g1;
#pragma unroll
                for (int j = 0; j < 4; ++j) {
                    const float ea0 = __builtin_amdgcn_exp2f(__builtin_fmaf(acc[ai][0][m][0][j], rs, ba0[j])), ea1 = __builtin_amdgcn_exp2f(__builtin_fmaf(acc[ai][0][m][1][j], rs, ba1[j]));
                    const float eb0 = fminf(__builtin_amdgcn_exp2f(__builtin_fmaf(acc[ai][1][m][0][j], rs, bb0[j])), 1e30f), eb1 = fminf(__builtin_amdgcn_exp2f(__builtin_fmaf(acc[ai][1][m][1][j], rs, bb1[j])), 1e30f);
                    g0[j] = __builtin_amdgcn_rcpf(1.0f + eb0); g1[j] = __builtin_amdgcn_rcpf(1.0f + eb1);
                    r0[j] = (1.0f + eb0) * __builtin_amdgcn_rcpf(1.0f + ea0); r1[j] = (1.0f + eb1) * __builtin_amdgcn_rcpf(1.0f + ea1); }
                *(u32x4*)(GR + (size_t)row * 1024 + ch) = pack8(r0, r1); *(u32x4*)(GB + (size_t)row * 1024 + ch) = pack8(g0, g1); }
            return; }
        EPI_ROWS(ai, m) { const int row = EPI_ROW(u, ai, m); const float rs = rstd_of(ssq0[row]);
#pragma unroll
            for (int bj = 0; bj < 2; ++bj) { const int col = upn * 256 + EPI_LCOL(bj);
                const f32x4 b0 = *(const f32x4*)(b_in + col), b1 = *(const f32x4*)(b_in + col + 4);
                const f32x4 v0 = acc[ai][bj][m][0] * rs + b0, v1 = acc[ai][bj][m][1] * rs + b1;
                bf16_t* dst;
                if (upn < 2) { const int g = col >> 4, q = col & 15, b = row >> 11, l = row & 2047, c = l >> 4, t = l & 15;
                    dst = UAS + ((size_t)(g * 1024 + b * 128 + c) * 384 + t * 16 + q); }
                else dst = UB + (size_t)row * 1024 + (col - 512);
                *(u32x4*)dst = pack8(v0, v1); } }
    }
};
struct EpiEraw {
    bf16_t* ERAW; float* ssqe;
    __device__ __forceinline__ void operator()(const AccT& acc, const pg8::Unit& u, int wr, int wc, int fr, int fq) const {
        EPI_ROWS(ai, m) { const int row = EPI_ROW(u, ai, m); float s = 0.f;
#pragma unroll
            for (int bj = 0; bj < 2; ++bj) { const int col = u.pn * 256 + EPI_LCOL(bj); const f32x4 v0 = acc[ai][bj][m][0], v1 = acc[ai][bj][m][1];
                s += sq4(v0) + sq4(v1); *(u32x4*)(ERAW + (size_t)row * 1024 + col) = pack8(v0, v1); }
            row_atomic(ssqe + row, s, fq); }
    }
};
struct EpiS5a {
    float* E;
    __device__ __forceinline__ void operator()(const AccT& acc, const pg8::Unit& u, int wr, int wc, int fr, int fq) const {
        EPI_ROWS(ai, m) { const int row = EPI_ROW(u, ai, m); float* dst = E + (size_t)row * 128 + EPI_LCOL(0);
            *(f32x4*)dst = acc[ai][0][m][0]; *(f32x4*)(dst + 4) = acc[ai][0][m][1]; }
    }
};
struct EpiS5b {
    bf16_t* ZG;
    __device__ __forceinline__ void operator()(const AccT& acc, const pg8::Unit& u, int wr, int wc, int fr, int fq) const {
        const int lc = wc * 32 + 8 * fq;
        const int t0 = lc >> 4, p = lc & 15;
        EPI_ROWS(ai, m) { const int row = EPI_ROW(u, ai, m); const int g = row >> 10, b = (row >> 7) & 7, c = row & 127;
            bf16_t* dst = ZG + (size_t)(b * 2048 + c * 16 + t0) * 512 + g * 16 + p;
#pragma unroll
            for (int bj = 0; bj < 2; ++bj) { u32x2 w[2];
#pragma unroll
                for (int n = 0; n < 2; ++n) { f32x4 v = acc[ai][bj][m][n];
#pragma unroll
                    for (int j = 0; j < 4; ++j) v[j] = gelu_tanh(v[j]);
                    w[n].x = cvt_pk_bf16(v[0], v[1]); w[n].y = cvt_pk_bf16(v[2], v[3]); }
                *(u32x4*)(dst + bj * 8 * 512) = (u32x4){w[0].x, w[0].y, w[1].x, w[1].y};
                asm volatile("" ::: "memory"); } }
    }
};
struct EpiLru {
    const float* b_r; const float* b_i; const float* sp; const bf16_t* XC; float* AA; bf16_t* BX;
    __device__ __forceinline__ void operator()(const AccT& acc, const pg8::Unit& u, int wr, int wc, int fr, int fq) const {
        const int ch = u.pn * 128 + wc * 32 + 8 * fq;
        EPI_ROWS(ai, m) { const int row = EPI_ROW(u, ai, m); const size_t off = (size_t)row * 1024 + ch;
            const u32x4 xw = *(const u32x4*)(XC + off); f32x4 xx[2]; unpack8(xw, xx[0], xx[1]); u32x2 hw[2];
#pragma unroll
            for (int n = 0; n < 2; ++n) {
                const f32x4 r = sigm4(acc[ai][0][m][n] + *(const f32x4*)(b_r + ch + 4 * n)), ig = sigm4(acc[ai][1][m][n] + *(const f32x4*)(b_i + ch + 4 * n)), s4 = *(const f32x4*)(sp + ch + 4 * n);
                f32x4 a, h;
#pragma unroll
                for (int j = 0; j < 4; ++j) { a[j] = __expf(-8.0f * r[j] * s4[j]); h[j] = sqrtf(fmaxf(1.0f - a[j] * a[j], 0.f)) * ig[j] * xx[n][j]; }
                *(f32x4*)(AA + off + 4 * n) = a; hw[n].x = cvt_pk_bf16(h[0], h[1]); hw[n].y = cvt_pk_bf16(h[2], h[3]); }
            *(u32x4*)(BX + off) = (u32x4){hw[0].x, hw[0].y, hw[1].x, hw[1].y};
            asm volatile("" ::: "memory"); }
    }
};
struct EpiGlu {
    const bf16_t* ZG; const float* b_glu; bf16_t* YA;
    __device__ __forceinline__ void operator()(const AccT& acc, const pg8::Unit& u, int wr, int wc, int fr, int fq) const {
        EPI_ROWS(ai, m) { const int row = EPI_ROW(u, ai, m);
#pragma unroll
            for (int bj = 0; bj < 2; ++bj) { const int col = u.pn * 256 + EPI_LCOL(bj); const size_t off = (size_t)row * 512 + col;
                f32x4 z0, z1; unpack8(*(const u32x4*)(ZG + off), z0, z1);
                const f32x4 s0 = sigm4(acc[ai][bj][m][0] + *(const f32x4*)(b_glu + col)), s1 = sigm4(acc[ai][bj][m][1] + *(const f32x4*)(b_glu + col + 4));
                *(u32x4*)(YA + (size_t)row * 1536 + col) = pack8(z0 * s0, z1 * s1); } }
    }
};
struct MidGate {
    static constexpr bool ENABLED = true; int mid_t; const bf16_t* GR;
    __device__ __forceinline__ void operator()(AccT& acc, const pg8::Unit& u, int wr, int wc, int fr, int fq) const {
#pragma unroll
        for (int ai = 0; ai < 2; ++ai) { u32x4 gr[4][2];
#pragma unroll
            for (int m = 0; m < 4; ++m)
#pragma unroll
                for (int bj = 0; bj < 2; ++bj) gr[m][bj] = *(const u32x4*)(GR + (size_t)EPI_ROW(u, ai, m) * 1024 + u.pn * 256 + EPI_LCOL(bj));
#pragma unroll
            for (int m = 0; m < 4; ++m)
#pragma unroll
                for (int bj = 0; bj < 2; ++bj) { f32x4 a0, a1; unpack8(gr[m][bj], a0, a1); acc[ai][bj][m][0] *= a0; acc[ai][bj][m][1] *= a1; }
            asm volatile("" ::: "memory"); }
    }
};
struct EpiMg {
    const bf16_t* GB; bf16_t* MG;
    __device__ __forceinline__ void operator()(const AccT& acc, const pg8::Unit& u, int wr, int wc, int fr, int fq) const {
#pragma unroll
        for (int ai = 0; ai < 2; ++ai) { u32x4 gb[4][2];
#pragma unroll
            for (int m = 0; m < 4; ++m)
#pragma unroll
                for (int bj = 0; bj < 2; ++bj) gb[m][bj] = *(const u32x4*)(GB + (size_t)EPI_ROW(u, ai, m) * 1024 + u.pn * 256 + EPI_LCOL(bj));
#pragma unroll
            for (int m = 0; m < 4; ++m)
#pragma unroll
                for (int bj = 0; bj < 2; ++bj) { f32x4 g0, g1; unpack8(gb[m][bj], g0, g1);
                    *(u32x4*)(MG + (size_t)EPI_ROW(u, ai, m) * 1024 + u.pn * 256 + EPI_LCOL(bj)) = pack8(g0 * acc[ai][bj][m][0], g1 * acc[ai][bj][m][1]); }
            asm volatile("" ::: "memory"); }
    }
};
struct EpiRes {
    const float* xi; const bf16_t* xib; bf16_t* XBo; float* ssq;
    __device__ __forceinline__ void operator()(const AccT& acc, const pg8::Unit& u, int wr, int wc, int fr, int fq) const {
#pragma unroll
        for (int ai = 0; ai < 2; ++ai) { u32x4 rw[4][2];
#pragma unroll
            for (int m = 0; m < 4; ++m)
#pragma unroll
                for (int bj = 0; bj < 2; ++bj) rw[m][bj] = *(const u32x4*)(xib + (size_t)EPI_ROW(u, ai, m) * 1024 + u.pn * 256 + EPI_LCOL(bj));
#pragma unroll
            for (int m = 0; m < 4; ++m) { const int row = EPI_ROW(u, ai, m); float s = 0.f;
#pragma unroll
                for (int bj = 0; bj < 2; ++bj) { const size_t off = (size_t)row * 1024 + u.pn * 256 + EPI_LCOL(bj);
                    f32x4 r0, r1; unpack8(rw[m][bj], r0, r1);
                    const f32x4 v0 = r0 + acc[ai][bj][m][0], v1 = r1 + acc[ai][bj][m][1];
                    s += sq4(v0) + sq4(v1);
                    *(u32x4*)(XBo + off) = pack8(v0, v1); }
                row_atomic(ssq + row, s, fq); }
            asm volatile("" ::: "memory"); }
    }
};
struct EpiFfn {
    const float* ssq1; bf16_t* ACT;
    __device__ __forceinline__ void operator()(const AccT& acc, const pg8::Unit& u, int wr, int wc, int fr, int fq) const {
        const int hc = u.pn * 128 + wc * 32 + 8 * fq;
        EPI_ROWS(ai, m) { const int row = EPI_ROW(u, ai, m); const float rs = rstd_of(ssq1[row]);
            f32x4 g0 = acc[ai][0][m][0] * rs, g1 = acc[ai][0][m][1] * rs; const f32x4 u0 = acc[ai][1][m][0] * rs, u1 = acc[ai][1][m][1] * rs;
            g0 = g0 * sigm4(g0) * u0; g1 = g1 * sigm4(g1) * u1;
            *(u32x4*)(ACT + (size_t)row * FFN + hc) = pack8(g0, g1); }
    }
};
struct EpiPg {
    const float* ssq2; const float* ssqe; const float* b_pg; const float* g_ple; const bf16_t* ERAW; const bf16_t* X2B; float* ssq3; unsigned* cnt; const float* g_final; float* out;
    __device__ __forceinline__ void operator()(AccT& acc, const pg8::Unit& u, int wr, int wc, int fr, int fq) const {
#pragma unroll
        for (int ai = 0; ai < 2; ++ai)
#pragma unroll
        for (int mp = 0; mp < 2; ++mp) { u32x4 ew[2][2], xw[2][2];
#pragma unroll
            for (int mm = 0; mm < 2; ++mm)
#pragma unroll
                for (int bj = 0; bj < 2; ++bj) { const size_t off = (size_t)EPI_ROW(u, ai, mp * 2 + mm) * 1024 + u.pn * 256 + EPI_LCOL(bj); ew[mm][bj] = *(const u32x4*)(ERAW + off); xw[mm][bj] = *(const u32x4*)(X2B + off); }
#pragma unroll
            for (int mm = 0; mm < 2; ++mm) { const int m = mp * 2 + mm; const int row = EPI_ROW(u, ai, m); const float rs = rstd_of(ssq2[row]), re = rstd_of(ssqe[row]); float s = 0.f;
#pragma unroll
                for (int bj = 0; bj < 2; ++bj) { const int col = u.pn * 256 + EPI_LCOL(bj);
                    f32x4 e0, e1, x0, x1; unpack8(ew[mm][bj], e0, e1); unpack8(xw[mm][bj], x0, x1);
                    const f32x4 gt0 = sigm4(acc[ai][bj][m][0] * rs + *(const f32x4*)(b_pg + col)), gt1 = sigm4(acc[ai][bj][m][1] * rs + *(const f32x4*)(b_pg + col + 4));
                    const f32x4 v0 = x0 + gt0 * (e0 * re * *(const f32x4*)(g_ple + col)), v1 = x1 + gt1 * (e1 * re * *(const f32x4*)(g_ple + col + 4));
                    s += sq4(v0) + sq4(v1);
                    acc[ai][bj][m][0] = v0; acc[ai][bj][m][1] = v1; }
                s += __shfl_xor(s, 16); s += __shfl_xor(s, 32);
                if (fq == 0) { const float old = __hip_atomic_fetch_add(ssq3 + row, s, __ATOMIC_RELAXED, __HIP_MEMORY_SCOPE_AGENT); asm volatile("" :: "v"(old)); } }
            asm volatile("" ::: "memory"); }
        asm volatile("s_waitcnt vmcnt(0)" ::: "memory");
        unsigned* c = cnt + 64 * u.pm;
        if (__builtin_amdgcn_mbcnt_hi(~0u, __builtin_amdgcn_mbcnt_lo(~0u, 0u)) == 0u) (void)__hip_atomic_fetch_add(c, 1u, __ATOMIC_RELAXED, __HIP_MEMORY_SCOPE_AGENT);
        { unsigned spins = 0; while ((unsigned)__builtin_amdgcn_readfirstlane((int)__hip_atomic_load(c, __ATOMIC_RELAXED, __HIP_MEMORY_SCOPE_AGENT)) < 32u) { __builtin_amdgcn_s_sleep(2); if (++spins > (1u << 22)) break; } }
#pragma unroll
        for (int ai = 0; ai < 2; ++ai)
#pragma unroll
            for (int m = 0; m < 4; ++m) { const int row = EPI_ROW(u, ai, m); const float rs = rstd_of(__hip_atomic_load(ssq3 + row, __ATOMIC_RELAXED, __HIP_MEMORY_SCOPE_AGENT));
#pragma unroll
                for (int bj = 0; bj < 2; ++bj) { const int col = u.pn * 256 + EPI_LCOL(bj); float* o = out + (size_t)row * 1024 + col;
                    *(f32x4*)o = acc[ai][bj][m][0] * rs * *(const f32x4*)(g_final + col); *(f32x4*)(o + 4) = acc[ai][bj][m][1] * rs * *(const f32x4*)(g_final + col + 4); } }
    }
};

__device__ __forceinline__ void tr_item(const float* W, int K, int N, const float* gk, bf16_t* WT, int mode, LAS float* scr, int item, int lane, int ldd = 0, int koff = 0) {
    if (ldd == 0) ldd = K;
    const int nblk = N / 32, kb = item / nblk, nb = item % nblk, k0 = 64 * kb, n0 = 32 * nb;
    float tv[32];
#pragma unroll
    for (int i = 0; i < 32; ++i) { const int kk = 2 * i + (lane >> 5); tv[i] = __builtin_nontemporal_load(&W[(size_t)(k0 + kk) * N + n0 + (lane & 31)]); }
#pragma unroll
    for (int i = 0; i < 32; ++i) { const int kk = 2 * i + (lane >> 5); float v = tv[i]; if (gk) v *= gk[k0 + kk]; scr[kk * 33 + (lane & 31)] = v; }
    asm volatile("s_waitcnt lgkmcnt(0)" ::: "memory");
    const int c = lane & 7;
#pragma unroll
    for (int j = 0; j < 4; ++j) { const int n = (lane >> 3) + 8 * j; const LAS float* s = scr + (8 * c) * 33 + n;
        u32x4 o; o.x = cvt_pk_bf16(s[0 * 33], s[1 * 33]); o.y = cvt_pk_bf16(s[2 * 33], s[3 * 33]); o.z = cvt_pk_bf16(s[4 * 33], s[5 * 33]); o.w = cvt_pk_bf16(s[6 * 33], s[7 * 33]);
        const int nn = n0 + n; int drow;
        if (mode == 0) drow = nn; else if (mode == 3) { if (nn < 1536) drow = nn; else { const int gbs = nn >= 2560, c_ = nn - (gbs ? 2560 : 1536); drow = 1536 + 256 * (c_ >> 7) + gbs * 128 + (c_ & 127); } }
        else drow = 256 * (nn >> 7) + (mode - 1) * 128 + (nn & 127);
        *(u32x4*)(WT + (size_t)drow * ldd + koff + k0 + 8 * c) = o; }
    asm volatile("s_waitcnt lgkmcnt(0)" ::: "memory");
}

struct Args { const float* in[35]; float* out; unsigned char* ws; int ph_lo, ph_hi; };

template <class KA> __device__ __forceinline__ void s5_precompute(KA a, unsigned char* ws, LAS unsigned char* lds, int g, int part, int nparts, int tid) {
    const int tau_lo = part * (16 / nparts), tau_hi = tau_lo + 16 / nparts, row_lo = part * (256 / nparts), row_hi = row_lo + 256 / nparts;
    LAS float* PWr = (LAS float*)lds;
    LAS float* PWi = PWr + 17 * 64;
    LAS float* BBr = PWi + 17 * 64;
    LAS float* BBi = BBr + 1024;
    LAS float* Cr = BBi + 1024;
    LAS float* Ci = Cr + 1024;
    LAS float* Kt = Ci + 1024;
    const float* lam_re = a->in[5] + g * 64; const float* lam_im = a->in[6] + g * 64; const float dt = expf(a->in[7][g]);
    const float* b_re = a->in[8] + g * 1024; const float* b_im = a->in[9] + g * 1024; const float* c_re = a->in[10] + g * 1024; const float* c_im = a->in[11] + g * 1024;
    const float* dsk = a->in[12] + g * 16;
    for (int e = tid; e < 17 * 64; e += 512) { const int k = e >> 6, n = e & 63; const float lr = lam_re[n], li = lam_im[n];
        const float mag = expf((float)k * lr * dt); float s, c; sincosf((float)k * (li * dt), &s, &c); PWr[e] = mag * c; PWi[e] = mag * s; }
    for (int e = tid; e < 1024; e += 512) { const int n = e >> 4; const float lr = lam_re[n], li = lam_im[n];
        const float mag = expf(lr * dt); float s, c; sincosf(li * dt, &s, &c); const float ar = mag * c, ai = mag * s, den = lr * lr + li * li, nr = ar - 1.0f;
        const float fr = (nr * lr + ai * li) / den, fi = (ai * lr - nr * li) / den; const float br = b_re[e], bi = b_im[e];
        BBr[e] = fr * br - fi * bi; BBi[e] = fr * bi + fi * br; Cr[e] = c_re[e]; Ci[e] = c_im[e]; }
    __syncthreads();
    for (int e = tau_lo * 256 + tid; e < tau_hi * 256; e += 512) { const int tau = e >> 8, p = (e >> 4) & 15, q = e & 15; float s = 0.f;
        for (int n = 0; n < 64; ++n) { const float pr = PWr[tau * 64 + n], pi = PWi[tau * 64 + n], br = BBr[n * 16 + q], bi = BBi[n * 16 + q];
            const float wr_ = pr * br - pi * bi, wi_ = pr * bi + pi * br; s += Cr[p * 64 + n] * wr_ - Ci[p * 64 + n] * wi_; }
        if (tau == 0 && p == q) s += dsk[p];
        Kt[e] = s; }
    __syncthreads();
    bf16_t* PMg = (bf16_t*)(ws + WS_PM) + (size_t)g * 256 * 256;
    bf16_t* TQg = (bf16_t*)(ws + WS_TQ) + (size_t)g * 256 * 384;
    for (int e = tid; e < 256 * 32; e += 512) { const int row = e >> 5, cgp = e & 31, t = row >> 4, p = row & 15, s = cgp >> 1, q0 = (cgp & 1) * 8;
        f32x4 v0 = {0.f, 0.f, 0.f, 0.f}, v1 = v0;
        if (s <= t ? (t - s < tau_lo || t - s >= tau_hi) : (part != 0)) continue;
        if (s <= t) { const LAS float* kp = Kt + (t - s) * 256 + p * 16 + q0; v0 = (f32x4){kp[0], kp[1], kp[2], kp[3]}; v1 = (f32x4){kp[4], kp[5], kp[6], kp[7]}; }
        *(u32x4*)(TQg + (size_t)row * 384 + s * 16 + q0) = pack8(v0, v1); }
    for (int e = row_lo * 16 + tid; e < row_hi * 16; e += 512) { const int row = e >> 4, cgp = e & 15, t = row >> 4, p = row & 15, half = cgp >> 3, n0 = (cgp & 7) * 8;
        float v[8];
#pragma unroll
        for (int j = 0; j < 8; ++j) { const int n = n0 + j; const float cr = Cr[p * 64 + n], ci = Ci[p * 64 + n], pr = PWr[(t + 1) * 64 + n], pi = PWi[(t + 1) * 64 + n];
            v[j] = half == 0 ? (cr * pr - ci * pi) : -(cr * pi + ci * pr); }
        *(u32x4*)(TQg + (size_t)row * 384 + 256 + half * 64 + n0) = pack8((f32x4){v[0], v[1], v[2], v[3]}, (f32x4){v[4], v[5], v[6], v[7]}); }
    for (int e = row_lo * 32 + tid; e < row_hi * 32; e += 512) { const int row = e >> 5, cgp = e & 31, s = cgp >> 1, q0 = (cgp & 1) * 8;
        float v[8];
#pragma unroll
        for (int j = 0; j < 8; ++j) v[j] = 0.f;
        if (row < 128) { const int n = row & 63, im = row >> 6; const float pr = PWr[(15 - s) * 64 + n], pi = PWi[(15 - s) * 64 + n];
#pragma unroll
            for (int j = 0; j < 8; ++j) { const float br = BBr[n * 16 + q0 + j], bi = BBi[n * 16 + q0 + j]; v[j] = im == 0 ? (pr * br - pi * bi) : (pr * bi + pi * br); } }
        *(u32x4*)(PMg + (size_t)row * 256 + s * 16 + q0) = pack8((f32x4){v[0], v[1], v[2], v[3]}, (f32x4){v[4], v[5], v[6], v[7]}); }
    __syncthreads();
}

__device__ __forceinline__ bf16x8 pack8s(const float (&t)[8]) { u32x4 w; w.x = cvt_pk_bf16(t[0], t[1]); w.y = cvt_pk_bf16(t[2], t[3]); w.z = cvt_pk_bf16(t[4], t[5]); w.w = cvt_pk_bf16(t[6], t[7]); return __builtin_bit_cast(bf16x8, w); }
__device__ __forceinline__ void wg_publish(bool leader) {
    asm volatile("s_waitcnt vmcnt(0)" ::: "memory"); __syncthreads();
    if (leader) { __builtin_amdgcn_fence(__ATOMIC_ACQUIRE, "agent"); asm volatile("s_waitcnt vmcnt(0)" ::: "memory"); }
    __syncthreads();
}

template <class KA>
__device__ __forceinline__ void lru_fused_unit(KA ap, unsigned char* ws, const bf16_t* UBg, LAS unsigned char* lds, int unit, int wave) {
    int lane = (int)__builtin_amdgcn_mbcnt_hi(~0u, __builtin_amdgcn_mbcnt_lo(~0u, 0u)); asm volatile("" : "+v"(lane));
    const int b = unit >> 4, h = unit & 15, ch0 = h * 64;
    const int r = lane & 15, q = lane >> 4;
    LAS float* xb = (LAS float*)(lds + wave * 10496);
    LAS float* aL = xb + 16 * 66;
    LAS bf16_t* hL = (LAS bf16_t*)(aL + 16 * 66);
    LAS float* agg = (LAS float*)(lds + 83968);
    LAS float* cwL = (LAS float*)(lds + 92160); LAS float* cbL = cwL + 256;
    LAS u32x4* BtL = (LAS u32x4*)(lds + 93696);
    LAS u32x4* IdL = (LAS u32x4*)(lds + 110080);
    const bf16_t* UBp = UBg + (size_t)b * 2048 * 1024 + ch0 + 8 * q;
    bf16_t* YBp = (bf16_t*)(ws + WS_YAB) + (size_t)b * 2048 * 1536 + 512 + ch0;
    u32x4 raw[2][4], rawn[2][4];
#define LRU_LOAD(dst, blk_) do { const int l0_ = (blk_) * 128 + wave * 16 + r - 3; _Pragma("unroll") for (int ks = 0; ks < 2; ++ks) _Pragma("unroll") for (int tp = 0; tp < 4; ++tp) { \
        const int l_ = l0_ + tp; dst[ks][tp] = (l_ >= 0) ? *(const u32x4*)(UBp + (size_t)(l_ < 0 ? 0 : l_) * 1024 + 32 * ks) : (u32x4){0u, 0u, 0u, 0u}; } } while (0)
    LRU_LOAD(raw, 0);
    { const int t_ = wave * 64 + lane; if (t_ < 256) cwL[t_] = ap->in[15][(t_ >> 6) * 1024 + ch0 + (t_ & 63)]; else if (t_ < 320) cbL[t_ - 256] = ap->in[16][ch0 + (t_ - 256)];
#pragma unroll
      for (int e2 = 0; e2 < 2; ++e2) { const int e = t_ + 512 * e2, c = e >> 7, ks = (e >> 6) & 1, ln = e & 63, rr = ln & 15, qq = ln >> 4;
          const float* w = ((c < 4) ? ap->in[17] : ap->in[19]) + h * 4096 + (c & 3) * 16 + rr; float t[8];
#pragma unroll
          for (int j = 0; j < 8; ++j) t[j] = w[(32 * ks + 8 * qq + j) * 64];
          BtL[e] = __builtin_bit_cast(u32x4, pack8s(t)); }
      { const int c = t_ >> 7, ks = (t_ >> 6) & 1, ln = t_ & 63, rr = ln & 15, qq = ln >> 4; float t[8];
#pragma unroll
        for (int j = 0; j < 8; ++j) t[j] = (32 * ks + 8 * qq + j == 16 * c + rr) ? 1.0f : 0.0f;
        IdL[t_] = __builtin_bit_cast(u32x4, pack8s(t)); } }
    float brc[4], bic[4], spc[4];
#pragma unroll
    for (int c = 0; c < 4; ++c) { const int ch = ch0 + c * 16 + r; const float L2E = 1.4426950408889634f; brc[c] = -L2E * ap->in[18][ch]; bic[c] = -L2E * ap->in[20][ch]; spc[c] = -8.0f * L2E * ((const float*)(ws + OFF_SP))[ch]; }
    __syncthreads();
    bf16x8 Bg[4][2];
#pragma unroll
    for (int c = 0; c < 4; ++c)
#pragma unroll
        for (int ks = 0; ks < 2; ++ks) Bg[c][ks] = __builtin_bit_cast(bf16x8, BtL[(c * 2 + ks) * 64 + lane]);
    float hprev = 0.f;
    for (int blk = 0; blk < 16; ++blk) {
        if (blk + 1 < 16) LRU_LOAD(rawn, blk + 1);
        bf16x8 Af[2];
#pragma unroll
        for (int ks = 0; ks < 2; ++ks) { const int cc = 32 * ks + 8 * q; f32x4 a0 = *(const LAS f32x4*)(cbL + cc), a1 = *(const LAS f32x4*)(cbL + cc + 4);
#pragma unroll
            for (int tp = 0; tp < 4; ++tp) { f32x4 u0, u1; unpack8(raw[ks][tp], u0, u1); a0 += u0 * *(const LAS f32x4*)(cwL + tp * 64 + cc); a1 += u1 * *(const LAS f32x4*)(cwL + tp * 64 + cc + 4); }
            Af[ks] = __builtin_bit_cast(bf16x8, pack8(a0, a1));
}
#pragma unroll
        for (int c = 0; c < 4; ++c) {
            f32x4 Dr = __builtin_amdgcn_mfma_f32_16x16x32_bf16(Af[0], Bg[c][0], (f32x4){0.f, 0.f, 0.f, 0.f}, 0, 0, 0);
            Dr = __builtin_amdgcn_mfma_f32_16x16x32_bf16(Af[1], Bg[c][1], Dr, 0, 0, 0);
            f32x4 Di = __builtin_amdgcn_mfma_f32_16x16x32_bf16(Af[0], __builtin_bit_cast(bf16x8, BtL[((c + 4) * 2 + 0) * 64 + lane]), (f32x4){0.f, 0.f, 0.f, 0.f}, 0, 0, 0);
            Di = __builtin_amdgcn_mfma_f32_16x16x32_bf16(Af[1], __builtin_bit_cast(bf16x8, BtL[((c + 4) * 2 + 1) * 64 + lane]), Di, 0, 0, 0);
            f32x4 Dx = __builtin_amdgcn_mfma_f32_16x16x32_bf16(Af[0], __builtin_bit_cast(bf16x8, IdL[(c * 2 + 0) * 64 + lane]), (f32x4){0.f, 0.f, 0.f, 0.f}, 0, 0, 0);
            Dx = __builtin_amdgcn_mfma_f32_16x16x32_bf16(Af[1], __builtin_bit_cast(bf16x8, IdL[(c * 2 + 1) * 64 + lane]), Dx, 0, 0, 0);
#pragma unroll
            for (int i = 0; i < 4; ++i) { const int o = (4 * q + i) * 66 + c * 16 + r;
                const float rg = __builtin_amdgcn_rcpf(1.0f + __builtin_amdgcn_exp2f(__builtin_fmaf(Dr[i], -1.4426950408889634f, brc[c]))), ig = __builtin_amdgcn_rcpf(1.0f + __builtin_amdgcn_exp2f(__builtin_fmaf(Di[i], -1.4426950408889634f, bic[c])));
                const float a = __builtin_amdgcn_exp2f(rg * spc[c]); const float xv = Dx[i];
                aL[o] = a; xb[o] = __builtin_amdgcn_sqrtf(fmaxf(1.0f - a * a, 0.f)) * ig * xv; } }
        LAS float* ag = agg + (blk & 1) * 1024;
        float av[16], bv[16];
        {
#pragma unroll
          for (int tt = 0; tt < 16; ++tt) { av[tt] = aL[tt * 66 + lane]; bv[tt] = xb[tt * 66 + lane]; }
          float P = 1.f, H = 0.f;
#pragma unroll
          for (int tt = 0; tt < 16; ++tt) { H = av[tt] * H + bv[tt]; P *= av[tt]; }
          ag[(wave * 64 + lane) * 2] = P; ag[(wave * 64 + lane) * 2 + 1] = H; }
        __syncthreads();
        { float c = hprev, cin = 0.f;
#pragma unroll
          for (int ww = 0; ww < 8; ++ww) { if (ww == wave) cin = c; c = ag[(ww * 64 + lane) * 2] * c + ag[(ww * 64 + lane) * 2 + 1]; }
          hprev = c;
          float hh = cin;
#pragma unroll
          for (int tt = 0; tt < 16; ++tt) { hh = av[tt] * hh + bv[tt]; hL[tt * 64 + lane] = (bf16_t)(cvt_pk_bf16(hh, 0.f) & 0xffffu); } }
        { const int tt = lane >> 2, g16 = lane & 3; const LAS u32x4* hp = (const LAS u32x4*)(hL + tt * 64 + 16 * g16); const u32x4 h0 = hp[0], h1 = hp[1];
          u32x4* yo = (u32x4*)(YBp + (size_t)(blk * 128 + wave * 16 + tt) * 1536 + 16 * g16); yo[0] = h0; yo[1] = h1; }
#pragma unroll
        for (int ks = 0; ks < 2; ++ks)
#pragma unroll
            for (int tp = 0; tp < 4; ++tp) raw[ks][tp] = rawn[ks][tp];
    }
#undef LRU_LOAD
    __syncthreads();
}

__global__ void __launch_bounds__(512, 2) fwd_kernel(Args args) {
    extern __shared__ __attribute__((aligned(16))) unsigned char lds_raw[];
    LAS unsigned char* lds = (LAS unsigned char*)lds_raw;
    const int G = gridDim.x, bid = blockIdx.x, NT = G * 512, NGW = G * 8;
    const int wave_s = __builtin_amdgcn_readfirstlane((int)threadIdx.x >> 6);
    const int lo = args.ph_lo, hi = args.ph_hi;
    if (hi < 0) cg::this_grid().sync();
    unsigned n_bar = 0; (void)n_bar;
    const unsigned xcc = xb_xcc_id();
    if (hi - lo > 1) {
        if (wave_s == 0 && __builtin_amdgcn_mbcnt_hi(~0u, __builtin_amdgcn_mbcnt_lo(~0u, 0u)) == 0u) { ((volatile LAS unsigned*)(lds + 131072 + 64))[0] = 0u; ((volatile LAS unsigned*)(lds + 131072 + 64))[1] = 0u;
            (void)xb_add((unsigned*)(args.ws + OFF_BAR) + XB_XCNT(xcc), 1u); }
        __syncthreads();
    }
#ifndef PROBE_PH
#define PROBE_PH (-1)
#endif
#ifndef PROBE_MULT
#define PROBE_MULT 4
#endif
    unsigned long long pr_t0 = 0, pr_dt = 0; (void)pr_t0; (void)pr_dt;
#define PROBE_A(k) do { if (PROBE_PH == (k)) pr_t0 = __builtin_amdgcn_s_memrealtime(); } while (0)
#define PROBE_B(k) do { if (PROBE_PH == (k)) pr_dt = __builtin_amdgcn_s_memrealtime() - pr_t0; } while (0)
#ifndef PHMASK
#define PHMASK 0xFFF
#endif
#define IN(k) (((PHMASK >> (k)) & 1) && lo <= (k) && (k) < hi)
#define LEADER (wave_s == 0 && __builtin_amdgcn_mbcnt_hi(~0u, __builtin_amdgcn_mbcnt_lo(~0u, 0u)) == 0u)
#define SEAM(k) do { if (IN(k) && (IN((k) + 1) || ((k) == 2 && IN(5)))) { xcd_barrier((unsigned*)(kap->ws + OFF_BAR), xcc, (volatile LAS unsigned*)(lds + 131072 + 64), (unsigned)G, LEADER); } } while (0)
    typedef const __attribute__((address_space(4))) Args* KArgs;
    const KArgs kap = (KArgs)__builtin_amdgcn_kernarg_segment_ptr();
#define PH_BEGIN KArgs ap = kap; asm volatile("" : "+s"(ap)); unsigned char* const ws = ap->ws; float* const OUT = ap->out; (void)ws; (void)OUT; \
    int lane = (int)__builtin_amdgcn_mbcnt_hi(~0u, __builtin_amdgcn_mbcnt_lo(~0u, 0u)); asm volatile("" : "+v"(lane)); const int wave = wave_s, tid = wave * 64 + lane, gtid = bid * 512 + tid, gw = bid * 8 + wave; (void)gtid; (void)gw;
#define AIN(k) (ap->in[k])
#define WSP(T, off) ((T*)(ws + (off)))
    PROBE_A(0);
    if (IN(0)) {
        PH_BEGIN
        const bool g256 = (G == 256);
        if (g256) { if (bid < 128) s5_precompute(ap, ws, lds, bid >> 2, bid & 3, 4, tid); }
        else if (bid < 32) s5_precompute(ap, ws, lds, bid, 0, 1, tid);
        {
            const int npair = g256 ? 1024 : NGW, pr = g256 ? (gw & 1023) : gw, k_lo = g256 ? ((gw >> 10) ? 3 : 0) : 0, k_hi = g256 ? ((gw >> 10) ? 8 : 3) : (M / 2 + npair - 1) / npair;
            for (int k = k_lo; k < k_hi; ++k) { const int m = 2 * (pr + npair * k); if (m >= M) break;
                const f32x4* xr = (const f32x4*)(AIN(0) + (size_t)m * 1024) + lane; f32x4 v[8]; float s0 = 0.f, s1 = 0.f;
#pragma unroll
                for (int j = 0; j < 8; ++j) v[j] = __builtin_nontemporal_load(&xr[64 * j]);
#pragma unroll
                for (int j = 0; j < 4; ++j) { s0 += sq4(v[j]); s1 += sq4(v[4 + j]); }
                s0 = wave_sum(s0); s1 = wave_sum(s1); if (lane == 0) { WSP(float, OFF_SSQ0)[m] = s0; WSP(float, OFF_SSQ0)[m + 1] = s1; }
                u32x2* o = (u32x2*)((bf16_t*)OUT + (size_t)M * 1024   + (size_t)m * 1024) + lane;
#pragma unroll
                for (int j = 0; j < 8; ++j) { u32x2 w; w.x = cvt_pk_bf16(v[j][0], v[j][1]); w.y = cvt_pk_bf16(v[j][2], v[j][3]); o[64 * j] = w; } }
            LAS float* scr = (LAS float*)(lds + wave * 16384);
            const int wq = g256 ? gw - 1024 : gw, nW = g256 ? 1024 : NGW;
            if (wq >= 0) for (int it = wq; it < 16 * 112; it += nW) tr_item(AIN(3), 1024, INC, AIN(2), WSP(bf16_t, WS_WIN), 3, scr, it, lane);
        }
        for (int e = gtid; e < 1024; e += NT) WSP(float, OFF_SP)[e] = log1pf(expf(-AIN(21)[e]));
        for (int e = gtid; e < M; e += NT) { WSP(float, OFF_SSQ1)[e] = 0.f; WSP(float, OFF_SSQ2)[e] = 0.f; WSP(float, OFF_SSQ3)[e] = 0.f; WSP(float, OFF_SSQE)[e] = 0.f; }
    }
    SEAM(0);
    PROBE_B(0);
    PROBE_A(1);
    if (IN(1)) {
        PH_BEGIN
        pg8::Gemm g{(const bf16_t*)OUT + (size_t)M * 1024  , WSP(bf16_t, WS_WIN), 1024, 1024, 1024}; pg8::Sched S; S.init(64, 12, G, bid, (size_t)256 * 1024 * 2, 0, (size_t)256 * 1024 * 2, 0);
        EpiIn E{WSP(float, OFF_SSQ0), AIN(4), WSP(bf16_t, WS_UAS), (bf16_t*)OUT  , WSP(bf16_t, WS_GA), WSP(bf16_t, WS_GB), 0};
        pg8::gemm_phase(lds, g, S, E, tid);
    }
    SEAM(1);
    PROBE_B(1);
    PROBE_A(2);
    if (IN(2)) {
        PH_BEGIN
        if (PROBE_PH == 20) pr_t0 = __builtin_amdgcn_s_memrealtime();
        const int nL = (G >= 2) ? G / 2 : 1, nS = (G >= 2) ? G - nL : 1; const bool isL = (G < 2) || bid < nL, isS = (G < 2) || bid >= nL;
        if (isL) for (int unit = (G < 2) ? 0 : bid; unit < 128; unit += nL) lru_fused_unit(ap, ws, (const bf16_t*)OUT, lds, unit, wave);
        if (PROBE_PH == 20) pr_dt = __builtin_amdgcn_s_memrealtime() - pr_t0;
        if (PROBE_PH == 21) pr_t0 = __builtin_amdgcn_s_memrealtime();
        if (isS) for (int su = (G < 2) ? 0 : bid - nL; su < 128; su += nS) {
            const int g = su >> 2;
            int k256 = 256, k384 = 384; asm volatile("" : "+s"(k256), "+s"(k384));
            { pg8::Gemm gm{WSP(bf16_t, WS_UAS), WSP(bf16_t, WS_PM), 384, 256, k256}; pg8::OneUnit S{su, 0, (size_t)su * 256 * 384 * 2, (size_t)g * 256 * 256 * 2};
              EpiS5a E{WSP(float, WS_E)}; int lane1 = (int)__builtin_amdgcn_mbcnt_hi(~0u, __builtin_amdgcn_mbcnt_lo(~0u, 0u)); asm volatile("" : "+v"(lane1)); pg8::gemm_phase(lds, gm, S, E, wave * 64 + lane1); }
            int lane2 = (int)__builtin_amdgcn_mbcnt_hi(~0u, __builtin_amdgcn_mbcnt_lo(~0u, 0u)); asm volatile("" : "+v"(lane2));
            wg_publish(wave == 0 && lane2 == 0);
            for (int bb = 0; bb < 2; ++bb) { const int b = (su & 3) * 2 + bb, n = lane2;
                const float lr = AIN(5)[g * 64 + n], li = AIN(6)[g * 64 + n], dt = expf(AIN(7)[g]);
                const float mag = expf(16.0f * lr * dt); float sn, cs; sincosf(16.0f * (li * dt), &sn, &cs); const float ar = mag * cs, ai = mag * sn;
                const size_t row0 = (size_t)g * 1024 + b * 128 + wave * 16;
                float er[16], ei[16], lr_[16], li_[16];
#pragma unroll
                for (int j = 0; j < 16; ++j) { er[j] = WSP(float, WS_E)[(row0 + j) * 128 + n]; ei[j] = WSP(float, WS_E)[(row0 + j) * 128 + 64 + n]; }
                float sr = 0.f, si = 0.f;
#pragma unroll
                for (int j = 0; j < 16; ++j) { lr_[j] = sr; li_[j] = si; const float nr_ = ar * sr - ai * si + er[j], ni_ = ar * si + ai * sr + ei[j]; sr = nr_; si = ni_; }
                LAS float* segr = (LAS float*)lds; LAS float* segi = segr + 512;
                segr[wave * 64 + n] = sr; segi[wave * 64 + n] = si;
                float br = ar, bi = ai;
#pragma unroll
                for (int q = 0; q < 4; ++q) { const float t_ = br * br - bi * bi; bi = 2.0f * br * bi; br = t_; }
                __syncthreads();
                float cr = 0.f, ci = 0.f;
                for (int ww = 0; ww < wave; ++ww) { const float xr_ = segr[ww * 64 + n], xi_ = segi[ww * 64 + n]; const float t_ = br * cr - bi * ci + xr_; ci = br * ci + bi * cr + xi_; cr = t_; }
                float pr = 1.f, pi = 0.f;
#pragma unroll
                for (int j = 0; j < 16; ++j) { const float orr = lr_[j] + pr * cr - pi * ci, oii = li_[j] + pr * ci + pi * cr;
                    bf16_t* d = WSP(bf16_t, WS_UAS) + (row0 + j) * 384 + 256 + n; d[0] = (bf16_t)(cvt_pk_bf16(orr, 0.f) & 0xffffu); d[64] = (bf16_t)(cvt_pk_bf16(oii, 0.f) & 0xffffu);
                    const float t_ = pr * ar - pi * ai; pi = pr * ai + pi * ar; pr = t_; }
                __syncthreads();
            }
            wg_publish(wave == 0 && lane2 == 0);
            { pg8::Gemm gm{WSP(bf16_t, WS_UAS), WSP(bf16_t, WS_TQ), 384, 384, k384}; pg8::OneUnit S{su, 0, (size_t)su * 256 * 384 * 2, (size_t)g * 256 * 384 * 2};
              EpiS5b E{WSP(bf16_t, WS_ZG)}; pg8::gemm_phase(lds, gm, S, E, wave * 64 + lane2); }
        }
        if (isS) {
            int lane3 = (int)__builtin_amdgcn_mbcnt_hi(~0u, __builtin_amdgcn_mbcnt_lo(~0u, 0u)); asm volatile("" : "+v"(lane3));
            const int wq = ((G < 2) ? 0 : bid - nL) * 8 + wave, nW = nS * 8;
            LAS float* scr = (LAS float*)(lds + wave * 16384);
            constexpr int I_GLU = 8 * 16, I_A = 8 * 32, I_B = 16 * 32, I_O = 16 * 32, I_G = 16 * 88, I_U = 16 * 88, I_D = 44 * 32, I_PG = 16 * 32, I_PLE = 4 * 32;
            constexpr int NITEMS = I_GLU + I_A + I_B + I_O + I_D + I_PG + I_PLE; (void)I_G; (void)I_U;
            for (int it = wq; it < NITEMS; it += nW) {
                int r = it;
                if (r < I_GLU) { tr_item(AIN(13), 512, 512, nullptr, WSP(bf16_t, WS_WGLU), 0, scr, r, lane3); continue; } r -= I_GLU;
                if (r < I_A) { tr_item(AIN(22), 512, 1024, nullptr, WSP(bf16_t, WS_WA), 0, scr, r, lane3, 1536, 0); continue; } r -= I_A;
                if (r < I_B) { tr_item(AIN(23), 1024, 1024, nullptr, WSP(bf16_t, WS_WA), 0, scr, r, lane3, 1536, 512); continue; } r -= I_B;
                if (r < I_O) { tr_item(AIN(24), 1024, 1024, nullptr, WSP(bf16_t, WS_WO), 0, scr, r, lane3); continue; } r -= I_O;
                if (r < I_D) { tr_item(AIN(28), FFN, 1024, nullptr, WSP(bf16_t, WS_WD), 0, scr, r, lane3); continue; } r -= I_D;
                if (r < I_PG) { tr_item(AIN(30), 1024, 1024, AIN(29), WSP(bf16_t, WS_WPG), 0, scr, r, lane3); continue; } r -= I_PG;
                tr_item(AIN(32), 256, 1024, nullptr, WSP(bf16_t, WS_WPLE), 0, scr, r, lane3);
            }
            const int tq = ((G < 2) ? 0 : bid - nL) * 512 + wave * 64 + lane3, nT = nS * 512;
            for (int e = tq * 4; e < M * PLE / 8; e += nT * 4) { const f32x4* pp = (const f32x4*)(AIN(1)) + (size_t)e * 2; f32x4 v[8];
#pragma unroll
                for (int j = 0; j < 8; ++j) v[j] = __builtin_nontemporal_load(&pp[j]);
                u32x4* o = (u32x4*)(WSP(bf16_t, WS_PB) + (size_t)e * 8);
#pragma unroll
                for (int j = 0; j < 4; ++j) o[j] = pack8(v[2 * j], v[2 * j + 1]); }
        }
    }
    if (PROBE_PH == 21) pr_dt = __builtin_amdgcn_s_memrealtime() - pr_t0;
    SEAM(2);
    PROBE_B(2);
    PROBE_A(5);
    if (IN(5)) {
        PH_BEGIN
        pg8::Gemm g{WSP(bf16_t, WS_ZG), WSP(bf16_t, WS_WGLU), 512, 512, 512}; pg8::Sched S; S.init(64, 2, G, bid, (size_t)256 * 512 * 2, 0, (size_t)256 * 512 * 2, 0);
        EpiGlu E{WSP(bf16_t, WS_ZG), AIN(14), WSP(bf16_t, WS_YAB)};
        pg8::gemm_phase(lds, g, S, E, tid);
        {
            int lane5 = (int)__builtin_amdgcn_mbcnt_hi(~0u, __builtin_amdgcn_mbcnt_lo(~0u, 0u)); asm volatile("" : "+v"(lane5));
            pg8::Gemm g2{(const bf16_t*)OUT + (size_t)M * 1024  , WSP(bf16_t, WS_WIN) + (size_t)12 * 256 * 1024, 1024, 1024, 1024};
            pg8::Sched S2; S2.init(64, 2, G, (bid + G - G / 2) % G, (size_t)256 * 1024 * 2, 0, (size_t)256 * 1024 * 2, 0);
            EpiIn E2{WSP(float, OFF_SSQ0), AIN(4), WSP(bf16_t, WS_UAS), (bf16_t*)OUT, WSP(bf16_t, WS_GA), WSP(bf16_t, WS_GB), 12};
            pg8::gemm_phase(lds, g2, S2, E2, wave * 64 + lane5);
        }
        {
            const int nLo = (G >= 2) ? G / 2 : 1;
            if (bid < nLo) { int lane6 = (int)__builtin_amdgcn_mbcnt_hi(~0u, __builtin_amdgcn_mbcnt_lo(~0u, 0u)); asm volatile("" : "+v"(lane6));
                LAS float* scr = (LAS float*)(lds + wave * 16384);
                for (int it = bid * 8 + wave; it < 2 * 16 * 88; it += nLo * 8) {
                    if (it < 16 * 88) tr_item(AIN(26), 1024, FFN, AIN(25), WSP(bf16_t, WS_WGU), 1, scr, it, lane6);
                    else tr_item(AIN(27), 1024, FFN, AIN(25), WSP(bf16_t, WS_WGU), 2, scr, it - 16 * 88, lane6); } }
        }
    }
    SEAM(5);
    PROBE_B(5);
    PROBE_A(6);
    if (IN(6)) {
        PH_BEGIN
        pg8::Gemm g{WSP(bf16_t, WS_YAB), WSP(bf16_t, WS_WA), 1536, 1536, 1536}; pg8::Sched S; S.init(64, 4, G, bid, (size_t)256 * 1536 * 2, 0, (size_t)256 * 1536 * 2, 0);
        EpiMg E{WSP(bf16_t, WS_GB), WSP(bf16_t, WS_MG)}; MidGate Mh{8, WSP(bf16_t, WS_GA)  };
        pg8::gemm_phase(lds, g, S, E, tid, Mh);
    }
    SEAM(6);
    PROBE_B(6);
    PROBE_A(7);
    if (IN(7)) {
        PH_BEGIN
        pg8::Gemm g{WSP(bf16_t, WS_MG), WSP(bf16_t, WS_WO), 1024, 1024, 1024}; pg8::Sched S; S.init(64, 4, G, bid, (size_t)256 * 1024 * 2, 0, (size_t)256 * 1024 * 2, 0);
        EpiRes E{nullptr, (const bf16_t*)OUT + (size_t)M * 1024  , WSP(bf16_t, WS_XB)  , WSP(float, OFF_SSQ1)};
        pg8::gemm_phase(lds, g, S, E, tid);
    }
    SEAM(7);
    PROBE_B(7);
    PROBE_A(8);
    if (IN(8)) {
        PH_BEGIN
        pg8::Gemm g{WSP(bf16_t, WS_XB)  , WSP(bf16_t, WS_WGU), 1024, 1024, 1024}; pg8::Sched S; S.init(64, 22, G, bid, (size_t)256 * 1024 * 2, 0, (size_t)256 * 1024 * 2, 0);
        EpiFfn E{WSP(float, OFF_SSQ1), WSP(bf16_t, WS_ACT)};
        pg8::gemm_phase(lds, g, S, E, tid);
        {
            const int b0 = (G >= 2) ? G / 2 : 0, nB = G - b0;
            if (bid >= b0) { int lane4 = (int)__builtin_amdgcn_mbcnt_hi(~0u, __builtin_amdgcn_mbcnt_lo(~0u, 0u)); asm volatile("" : "+v"(lane4));
                pg8::Gemm g2{WSP(bf16_t, WS_PB), WSP(bf16_t, WS_WPLE), 256, 256, 256}; pg8::Sched S2; S2.init(64, 4, nB, bid - b0, (size_t)256 * 256 * 2, 0, (size_t)256 * 256 * 2, 0);
                EpiEraw E2{WSP(bf16_t, WS_GA), WSP(float, OFF_SSQE)}; pg8::gemm_phase(lds, g2, S2, E2, wave * 64 + lane4); }
        }
    }
    SEAM(8);
    PROBE_B(8);
    PROBE_A(9);
    if (IN(9)) {
        PH_BEGIN
        { pg8::Gemm g{WSP(bf16_t, WS_ACT), WSP(bf16_t, WS_WD), FFN, FFN, FFN}; pg8::Sched S; S.init(64, 4, G, bid, (size_t)256 * FFN * 2, 0, (size_t)256 * FFN * 2, 0);
          EpiRes E{nullptr, WSP(bf16_t, WS_XB)  , WSP(bf16_t, WS_XB)  , WSP(float, OFF_SSQ2)}; pg8::gemm_phase(lds, g, S, E, tid); }
    }
    SEAM(9);
    PROBE_B(9);
    PROBE_A(10);
    if (IN(10)) {
        PH_BEGIN
        int kq = 1024; asm volatile("" : "+s"(kq));
        pg8::Gemm g{WSP(bf16_t, WS_XB)  , WSP(bf16_t, WS_WPG), 1024, 1024, kq}; pg8::Sched S; S.init(64, 4, G, bid, (size_t)256 * 1024 * 2, 0, (size_t)256 * 1024 * 2, 0);
        EpiPg E{WSP(float, OFF_SSQ2), WSP(float, OFF_SSQE), AIN(31), AIN(33), WSP(bf16_t, WS_GA)  , WSP(bf16_t, WS_XB)  , WSP(float, OFF_SSQ3), (unsigned*)(ws + OFF_BAR + 16384), AIN(34), OUT};
        pg8::gemm_phase(lds, g, S, E, tid);
    }
    PROBE_B(10);
    if (PROBE_PH == 11) pr_dt = __builtin_amdgcn_s_memrealtime() - pr_t0;
    if (PROBE_PH == 12) { for (int i = 0; i < 16; ++i) xcd_barrier((unsigned*)(kap->ws + OFF_BAR), xcc, (volatile LAS unsigned*)(lds + 131072 + 64), (unsigned)G, LEADER); }
    if (PROBE_PH >= 0 && PROBE_PH != 12) { const unsigned long long t1 = __builtin_amdgcn_s_memrealtime(); while (__builtin_amdgcn_s_memrealtime() - t1 < (unsigned long long)PROBE_MULT * pr_dt) __builtin_amdgcn_s_sleep(8); }
#undef IN
#undef SEAM
}

constexpr int LDS_BYTES = 147456;
extern "C" void kernel_launch(void* const* d_in, const int* in_sizes, int n_in, void* d_out, int out_size, void* d_ws, size_t ws_size, hipStream_t stream) {
    static int grid = 0;
    if (grid == 0) {
        int dev = 0, cus = 0, per_cu = 0;
        hipGetDevice(&dev); hipDeviceGetAttribute(&cus, hipDeviceAttributeMultiprocessorCount, dev);
        if (hipFuncSetAttribute((const void*)fwd_kernel, hipFuncAttributeMaxDynamicSharedMemorySize, LDS_BYTES) != hipSuccess) { fprintf(stderr, "kernel_launch: hipFuncSetAttribute failed\n"); grid = -1; return; }
        if (hipOccupancyMaxActiveBlocksPerMultiprocessor(&per_cu, (const void*)fwd_kernel, 512, LDS_BYTES) != hipSuccess || per_cu < 1) { fprintf(stderr, "kernel_launch: occupancy query says %d\n", per_cu); per_cu = 1; }
        (void)hipGetLastError();
        if (cus <= 0) cus = 256;
        grid = cus * per_cu;
        if (n_in != 35 || ws_size < WS_END) { fprintf(stderr, "kernel_launch: unexpected n_in %d / ws_size %zu\n", n_in, ws_size); grid = -1; return; }
    }
    if (grid < 0) return;
    (void)hipMemsetAsync((char*)d_ws + OFF_BAR, 0, 32768, stream);
    Args a{};
    for (int i = 0; i < 35; ++i) a.in[i] = (const float*)d_in[i];
    a.out = (float*)d_out; a.ws = (unsigned char*)d_ws;
#if MK_N_LAUNCHES == 1
    a.ph_lo = 0; a.ph_hi = NPH;
    void* kargs[] = {&a};
    hipError_t e = hipLaunchCooperativeKernel((const void*)fwd_kernel, dim3(grid), dim3(512), kargs, LDS_BYTES, stream);
    if (e != hipSuccess) fprintf(stderr, "kernel_launch: cooperative launch failed: %s (grid %d)\n", hipGetErrorString(e), grid);
#else
    for (int ph = 0; ph < NPH; ++ph) { a.ph_lo = ph; a.ph_hi = ph + 1; hipLaunchKernelGGL(fwd_kernel, dim3(grid), dim3(512), LDS_BYTES, stream, a); }
#endif
}
```
